# Optimizing an MI355X kernel written in HIP

```python
import math
import jax, jax.numpy as jnp
from jax import lax
import numpy as np


D_MODEL = 2048
BATCH = 2
SEQ = 4096
DEPTH = 2

MLA_HEADS = 8
MLA_Q_RANK = 512
MLA_KV_RANK = 256
MLA_NOPE_DIM = 128
MLA_ROPE_DIM = 64
MLA_V_DIM = 128
ROPE_THETA = 10000.0
GMLP_GROUPS = 4
GMLP_GROUP_DIM = 128
GMLP_WIDTH = GMLP_GROUPS * GMLP_GROUP_DIM
CHUNK = 128
DIFF_HEADS = 4
DIFF_QK_DIM = 64
DIFF_V_DIM = 128
REL_BUCKETS = 32
REL_MAX_EXACT = 16
REL_MAX_DIST = 128
Q_BLOCK = 128
MIX_WIDTH = MLA_HEADS * MLA_V_DIM + GMLP_WIDTH + DIFF_HEADS * DIFF_V_DIM
IN_SPLITS = (MLA_Q_RANK, MLA_KV_RANK, MLA_ROPE_DIM, GMLP_WIDTH, GMLP_WIDTH,
             DIFF_HEADS * 2 * DIFF_QK_DIM, DIFF_HEADS * 2 * DIFF_QK_DIM, DIFF_HEADS * DIFF_V_DIM)
IN_WIDTH = sum(IN_SPLITS)
IN_SPLIT_POINTS = tuple(int(v) for v in np.cumsum(IN_SPLITS)[:-1])
N_EXPERTS = 64
N_EXPERT_GROUPS = 8
TOPK_GROUPS = 4
TOP_K = 8
EXPERT_DIM = 512
SHARED_DIM = 512
ROUTED_SCALE = 2.5
MOE_BLOCK = 128
DEEPNORM_ALPHA = (2 * DEPTH) ** 0.25
DEEPNORM_BETA = (8 * DEPTH) ** -0.25

kernel_name = 'hybrid_mla_gmlp_diffattn_moe_deepnorm'


def layer_norm(x, g, b, eps=1e-5):
    xf = x.astype(jnp.float32)
    mu = jnp.mean(xf, axis=-1, keepdims=True)
    var = jnp.mean(jnp.square(xf - mu), axis=-1, keepdims=True)
    return ((xf - mu) * lax.rsqrt(var + eps) * g.astype(jnp.float32) + b.astype(jnp.float32)).astype(x.dtype)


def rms_norm(x, g, eps=1e-6):
    xf = x.astype(jnp.float32)
    ms = jnp.mean(jnp.square(xf), axis=-1, keepdims=True)
    return (xf * lax.rsqrt(ms + eps) * g.astype(jnp.float32)).astype(x.dtype)


def rope(x, pos):
    half = x.shape[-1] // 2
    inv = ROPE_THETA ** (-jnp.arange(half, dtype=jnp.float32) / half)
    ang = pos.astype(jnp.float32)[:, None] * inv[None, :]
    cos = jnp.cos(ang)[None, :, None, :]
    sin = jnp.sin(ang)[None, :, None, :]
    x1 = x[..., :half].astype(jnp.float32)
    x2 = x[..., half:].astype(jnp.float32)
    return jnp.concatenate([x1 * cos - x2 * sin, x2 * cos + x1 * sin], axis=-1).astype(x.dtype)


def t5_causal_bucket(n):
    is_small = n < REL_MAX_EXACT
    nf = jnp.maximum(n, 1).astype(jnp.float32)
    large = REL_MAX_EXACT + (jnp.log(nf / REL_MAX_EXACT) / math.log(REL_MAX_DIST / REL_MAX_EXACT)
                             * (REL_BUCKETS - REL_MAX_EXACT)).astype(jnp.int32)
    large = jnp.minimum(large, REL_BUCKETS - 1)
    return jnp.where(is_small, n, large)


def mla_mixer(c_q, c_kv, k_rope_raw, q_norm_g, w_uq, kv_norm_g, w_ukv, pos):
    B, S, _ = c_q.shape
    q = (rms_norm(c_q, q_norm_g) @ w_uq).reshape(B, S, MLA_HEADS, MLA_NOPE_DIM + MLA_ROPE_DIM)
    q_nope = q[..., :MLA_NOPE_DIM]
    q_rope = rope(q[..., MLA_NOPE_DIM:], pos)
    kv = (rms_norm(c_kv, kv_norm_g) @ w_ukv).reshape(B, S, MLA_HEADS, MLA_NOPE_DIM + MLA_V_DIM)
    k_nope = kv[..., :MLA_NOPE_DIM]
    v = kv[..., MLA_NOPE_DIM:]
    k_rope = rope(k_rope_raw[:, :, None, :], pos)[:, :, 0, :]
    scale = (MLA_NOPE_DIM + MLA_ROPE_DIM) ** -0.5
    k_pos = jnp.arange(S, dtype=jnp.int32)

    def block(i):
        start = i * Q_BLOCK
        qn = lax.dynamic_slice_in_dim(q_nope, start, Q_BLOCK, axis=1)
        qr = lax.dynamic_slice_in_dim(q_rope, start, Q_BLOCK, axis=1)
        s = jnp.einsum('bqhd,bkhd->bhqk', qn, k_nope) + jnp.einsum('bqhr,bkr->bhqk', qr, k_rope)
        s = s.astype(jnp.float32) * scale
        q_pos = start + jnp.arange(Q_BLOCK, dtype=jnp.int32)
        causal = k_pos[None, :] <= q_pos[:, None]
        p = jax.nn.softmax(jnp.where(causal, s, -jnp.inf), axis=-1).astype(v.dtype)
        return jnp.einsum('bhqk,bkhd->bqhd', p, v)

    o = lax.map(block, jnp.arange(S // Q_BLOCK, dtype=jnp.int32))
    return o.transpose(1, 0, 2, 3, 4).reshape(B, S, MLA_HEADS * MLA_V_DIM)


def gmlp_mixer(u, v, ln_g, ln_b, w_s, b_s):
    B, S, _ = u.shape
    u = jax.nn.gelu(u)
    v = layer_norm(jax.nn.gelu(v), ln_g, ln_b)
    vc = v.reshape(B, S // CHUNK, CHUNK, GMLP_GROUPS, GMLP_GROUP_DIM)
    causal = jnp.tril(jnp.ones((CHUNK, CHUNK), dtype=bool))
    ws = jnp.where(causal[None], w_s, 0.0).astype(v.dtype)
    mixed = jnp.einsum('gts,bcsgd->bctgd', ws, vc) + b_s.T[None, None, :, :, None]
    return u * mixed.reshape(B, S, GMLP_WIDTH)


def diff_mixer(q, k, v, lq1, lk1, lq2, lk2, subln_g, rel_table, lambda_init):
    B, S, _ = q.shape
    q = q.reshape(B, S, DIFF_HEADS, 2, DIFF_QK_DIM)
    k = k.reshape(B, S, DIFF_HEADS, 2, DIFF_QK_DIM)
    v = v.reshape(B, S, DIFF_HEADS, DIFF_V_DIM)
    lam = (jnp.exp(jnp.sum(lq1.astype(jnp.float32) * lk1.astype(jnp.float32)))
           - jnp.exp(jnp.sum(lq2.astype(jnp.float32) * lk2.astype(jnp.float32))) + lambda_init)
    scale = DIFF_QK_DIM ** -0.5
    k_pos = jnp.arange(S, dtype=jnp.int32)

    def block(i):
        start = i * Q_BLOCK
        qb = lax.dynamic_slice_in_dim(q, start, Q_BLOCK, axis=1)
        s = jnp.einsum('bqhmd,bkhmd->bhmqk', qb, k).astype(jnp.float32) * scale
        q_pos = start + jnp.arange(Q_BLOCK, dtype=jnp.int32)
        rel = q_pos[:, None] - k_pos[None, :]
        bias = rel_table.astype(jnp.float32)[t5_causal_bucket(jnp.maximum(rel, 0))]
        s = s + bias.transpose(2, 0, 1)[None, :, None, :, :]
        s = jnp.where((rel >= 0)[None, None, None], s, -jnp.inf)
        p = jax.nn.softmax(s, axis=-1)
        a = (p[:, :, 0] - lam * p[:, :, 1]).astype(v.dtype)
        return jnp.einsum('bhqk,bkhd->bqhd', a, v)

    o = lax.map(block, jnp.arange(S // Q_BLOCK, dtype=jnp.int32))
    o = o.transpose(1, 0, 2, 3, 4).reshape(B, S, DIFF_HEADS, DIFF_V_DIM)
    o = rms_norm(o, subln_g) * (1.0 - lambda_init)
    return o.reshape(B, S, DIFF_HEADS * DIFF_V_DIM)


def moe(x, router_w, router_bias, e_gate, e_up, e_down, s_gate, s_up, s_down):
    B, S, D = x.shape
    t = x.reshape(B * S, D)
    T = t.shape[0]
    scores = jax.nn.sigmoid((t @ router_w).astype(jnp.float32))
    biased = scores + router_bias.astype(jnp.float32)
    grouped = biased.reshape(T, N_EXPERT_GROUPS, N_EXPERTS // N_EXPERT_GROUPS)
    group_score = jnp.sum(lax.top_k(grouped, 2)[0], axis=-1)
    _, gidx = lax.top_k(group_score, TOPK_GROUPS)
    gmask = jnp.sum(jax.nn.one_hot(gidx, N_EXPERT_GROUPS, dtype=jnp.float32), axis=1) > 0
    emask = jnp.repeat(gmask, N_EXPERTS // N_EXPERT_GROUPS, axis=1)
    _, eidx = lax.top_k(jnp.where(emask, biased, -jnp.inf), TOP_K)
    w = jnp.take_along_axis(scores, eidx, axis=1)
    w = w / jnp.sum(w, axis=-1, keepdims=True) * ROUTED_SCALE
    gates = jnp.sum(jax.nn.one_hot(eidx, N_EXPERTS, dtype=jnp.float32) * w[..., None], axis=1).astype(x.dtype)

    def block(args):
        tb, gb = args
        g = jnp.einsum('td,edf->tef', tb, e_gate)
        u = jnp.einsum('td,edf->tef', tb, e_up)
        h = jax.nn.silu(g) * u * gb[:, :, None]
        return jnp.einsum('tef,efd->td', h, e_down)

    routed = lax.map(block, (t.reshape(-1, MOE_BLOCK, D), gates.reshape(-1, MOE_BLOCK, N_EXPERTS)))
    shared = (jax.nn.silu(t @ s_gate) * (t @ s_up)) @ s_down
    return (routed.reshape(T, D) + shared).reshape(B, S, D)


def setup_inputs(seed: int = 0) -> dict:
    key = jax.random.key(seed)
    ks = jax.random.split(key, 32)
    L = DEPTH
    D = D_MODEL

    def n(k, shape, scale):
        return scale * jax.random.normal(k, shape, jnp.float32)

    return {
        'x': n(ks[0], (BATCH, SEQ, D), 1.0),
        'rel_bias': n(ks[1], (REL_BUCKETS, DIFF_HEADS), 0.5),
        'w_in': n(ks[2], (L, D, IN_WIDTH), D ** -0.5),
        'mla_q_norm': 1.0 + n(ks[3], (L, MLA_Q_RANK), 0.01),
        'mla_w_uq': n(ks[4], (L, MLA_Q_RANK, MLA_HEADS * (MLA_NOPE_DIM + MLA_ROPE_DIM)), MLA_Q_RANK ** -0.5),
        'mla_kv_norm': 1.0 + n(ks[5], (L, MLA_KV_RANK), 0.01),
        'mla_w_ukv': n(ks[6], (L, MLA_KV_RANK, MLA_HEADS * (MLA_NOPE_DIM + MLA_V_DIM)), MLA_KV_RANK ** -0.5),
        'gmlp_ln_g': 1.0 + n(ks[7], (L, GMLP_WIDTH), 0.01),
        'gmlp_ln_b': n(ks[8], (L, GMLP_WIDTH), 0.01),
        'gmlp_w_s': n(ks[9], (L, GMLP_GROUPS, CHUNK, CHUNK), CHUNK ** -0.5),
        'gmlp_b_s': 1.0 + n(ks[10], (L, GMLP_GROUPS, CHUNK), 0.01),
        'diff_lq1': n(ks[11], (L, DIFF_QK_DIM), 0.1),
        'diff_lk1': n(ks[12], (L, DIFF_QK_DIM), 0.1),
        'diff_lq2': n(ks[13], (L, DIFF_QK_DIM), 0.1),
        'diff_lk2': n(ks[14], (L, DIFF_QK_DIM), 0.1),
        'diff_subln': 1.0 + n(ks[15], (L, DIFF_V_DIM), 0.01),
        'w_o': n(ks[16], (L, MIX_WIDTH, D), MIX_WIDTH ** -0.5 * DEEPNORM_BETA),
        'ln1_g': 1.0 + n(ks[17], (L, D), 0.01),
        'ln1_b': n(ks[18], (L, D), 0.01),
        'router_w': n(ks[19], (L, D, N_EXPERTS), D ** -0.5),
        'router_bias': n(ks[20], (L, N_EXPERTS), 0.01),
        'exp_w_gate': n(ks[21], (L, N_EXPERTS, D, EXPERT_DIM), D ** -0.5),
        'exp_w_up': n(ks[22], (L, N_EXPERTS, D, EXPERT_DIM), D ** -0.5),
        'exp_w_down': n(ks[23], (L, N_EXPERTS, EXPERT_DIM, D), EXPERT_DIM ** -0.5 * DEEPNORM_BETA),
        'shared_w_gate': n(ks[24], (L, D, SHARED_DIM), D ** -0.5),
        'shared_w_up': n(ks[25], (L, D, SHARED_DIM), D ** -0.5),
        'shared_w_down': n(ks[26], (L, SHARED_DIM, D), SHARED_DIM ** -0.5 * DEEPNORM_BETA),
        'ln2_g': 1.0 + n(ks[27], (L, D), 0.01),
        'ln2_b': n(ks[28], (L, D), 0.01),
    }


def reference(x, rel_bias, w_in, mla_q_norm, mla_w_uq, mla_kv_norm, mla_w_ukv,
              gmlp_ln_g, gmlp_ln_b, gmlp_w_s, gmlp_b_s,
              diff_lq1, diff_lk1, diff_lq2, diff_lk2, diff_subln,
              w_o, ln1_g, ln1_b, router_w, router_bias,
              exp_w_gate, exp_w_up, exp_w_down,
              shared_w_gate, shared_w_up, shared_w_down, ln2_g, ln2_b):
    S = x.shape[1]
    pos = jnp.arange(S, dtype=jnp.int32)
    for l in range(DEPTH):
        lambda_init = 0.8 - 0.6 * math.exp(-0.3 * l)
        h = x @ w_in[l]
        c_q, c_kv, k_r, g_u, g_v, d_q, d_k, d_v = jnp.split(h, IN_SPLIT_POINTS, axis=-1)
        o_mla = mla_mixer(c_q, c_kv, k_r, mla_q_norm[l], mla_w_uq[l], mla_kv_norm[l], mla_w_ukv[l], pos)
        o_gmlp = gmlp_mixer(g_u, g_v, gmlp_ln_g[l], gmlp_ln_b[l], gmlp_w_s[l], gmlp_b_s[l])
        o_diff = diff_mixer(d_q, d_k, d_v, diff_lq1[l], diff_lk1[l], diff_lq2[l], diff_lk2[l],
                            diff_subln[l], rel_bias, lambda_init)
        mix = jnp.concatenate([o_mla, o_gmlp, o_diff], axis=-1) @ w_o[l]
        x = layer_norm(DEEPNORM_ALPHA * x + mix, ln1_g[l], ln1_b[l])
        ffn = moe(x, router_w[l], router_bias[l], exp_w_gate[l], exp_w_up[l], exp_w_down[l],
                  shared_w_gate[l], shared_w_up[l], shared_w_down[l])
        x = layer_norm(DEEPNORM_ALPHA * x + ffn, ln2_g[l], ln2_b[l])
    return x
```

```cpp
#include <hip/hip_runtime.h>
#include <cstdio>
#include <cstdint>
#include <cmath>

#define LAS __attribute__((address_space(3)))
#define GAS __attribute__((address_space(1)))
typedef unsigned short bf16_t;
typedef short bf16x8 __attribute__((ext_vector_type(8)));
typedef short s16x4 __attribute__((ext_vector_type(4)));
typedef float f32x2 __attribute__((ext_vector_type(2)));
typedef float f32x4 __attribute__((ext_vector_type(4)));
typedef float f32x16 __attribute__((ext_vector_type(16)));
typedef unsigned u32x2 __attribute__((ext_vector_type(2)));
typedef unsigned u32x4 __attribute__((ext_vector_type(4)));
typedef __bf16 bf16x2_t __attribute__((ext_vector_type(2)));

constexpr int NB = 2, SEQ = 4096, T = NB * SEQ, DM = 2048, NLAYER = 2;
constexpr int IN_W = 3392;
constexpr int HW = 3584;
constexpr int HC_CQ = 0, HC_CKV = 512, HC_GU = 768, HC_GV = 1280, HC_DQ = 1792, HC_DK = 2304, HC_DV = 2816, HC_KR = 3328;
constexpr int NEXP = 64, NEXP1 = 65, EDIM = 512, TOPK = 8;
constexpr int MAXTILES = 352, NSLOT = MAXTILES * 256;
constexpr int NWAVES = 8, NTHREADS = 512;
constexpr float LOG2E = 1.4426950408889634f;
constexpr float DN_ALPHA = 1.4142135623730951f;
constexpr int RT_TOK = 16, RT_UNITS = T / RT_TOK;

__device__ __forceinline__ unsigned cvtpk(float lo, float hi) { f32x2 v = {lo, hi}; bf16x2_t b = __builtin_convertvector(v, bf16x2_t); return __builtin_bit_cast(unsigned, b); }
__device__ __forceinline__ float bf2f(unsigned short h) { return __uint_as_float(((unsigned)h) << 16); }
__device__ __forceinline__ float bflo(unsigned w) { return __uint_as_float(w << 16); }
__device__ __forceinline__ float bfhi(unsigned w) { return __uint_as_float(w & 0xffff0000u); }
__device__ __forceinline__ float wave_sum(float v) {
#pragma unroll
    for (int o = 1; o < 64; o <<= 1) v += __shfl_xor(v, o);
    return v;
}
__device__ __forceinline__ float wave_max(float v) {
#pragma unroll
    for (int o = 1; o < 64; o <<= 1) v = fmaxf(v, __shfl_xor(v, o));
    return v;
}
__device__ __forceinline__ float gelu_tanh(float x) {
    const float u = 0.7978845608028654f * (x + 0.044715f * x * x * x);
    const float e = __builtin_amdgcn_exp2f(u * (2.0f * LOG2E));
    const float th = 1.0f - 2.0f * __builtin_amdgcn_rcpf(e + 1.0f);
    return 0.5f * x * (1.0f + th);
}
__device__ __forceinline__ float sigmoidf_(float x) { return 1.0f / (1.0f + __expf(-x)); }
__device__ __forceinline__ int opq_tid() { int t = threadIdx.x; asm volatile("" : "+v"(t)); return t; }
#define LDS_WAIT() asm volatile("s_waitcnt lgkmcnt(0)" ::: "memory")
#define VM_WAIT() asm volatile("s_waitcnt vmcnt(0)" ::: "memory")

#define XB_TMO      128
#define XB_XCNT(j)  (256  + 64 * (j))
#define XB_XSUB(j)  (1280 + 64 * (j))
#define XB_XGEN(j)  (2304 + 64 * (j))
#define XB_TOP      3328
#define XB_TOPGEN   3392
#define XCD_BAR_WORDS 3456
#define XB_SPIN_CAP (1u << 18)
__device__ __forceinline__ unsigned xb_ld(unsigned* p)              { return __hip_atomic_load(p, __ATOMIC_RELAXED, __HIP_MEMORY_SCOPE_AGENT); }
__device__ __forceinline__ unsigned xb_add(unsigned* p, unsigned v) { return __hip_atomic_fetch_add(p, v, __ATOMIC_RELAXED, __HIP_MEMORY_SCOPE_AGENT); }
__device__ __forceinline__ unsigned xb_xcc_id() { return (unsigned)__builtin_amdgcn_s_getreg((3 << 11) | 20) & 0xFu; }
#define XB_SPIN(cond, bar) do { unsigned _sp = 0; while (cond) { __builtin_amdgcn_s_sleep(1); \
    if ((++_sp & 255u) == 0u) { if (xb_ld(&(bar)[XB_TMO])) break; if (_sp > XB_SPIN_CAP) { atomicAdd(&(bar)[XB_TMO], 1u); break; } } } } while (0)
struct XcdBarrier { unsigned* bar; unsigned x; volatile LAS unsigned* st; };
__device__ __forceinline__ XcdBarrier xcd_barrier_post(unsigned* bar, volatile LAS unsigned* st) {
    XcdBarrier b; b.bar = bar; b.x = xb_xcc_id(); b.st = st;
    if (threadIdx.x == 0) (void)xb_add(&bar[XB_XCNT(b.x)], 1u);
    return b;
}
__device__ __forceinline__ void xcd_barrier_complete(unsigned* bar, unsigned x, unsigned& nloc, unsigned& nx) {
    const unsigned G = gridDim.x * gridDim.y * gridDim.z;
    unsigned sum, cnt, mine, sp = 0u;
    for (;;) {
        sum = 0u; cnt = 0u; mine = 0u;
#pragma unroll 1
        for (unsigned j = 0; j < 16; ++j) { const unsigned c = xb_ld(&bar[XB_XCNT(j)]); sum += c; cnt += (c > 0u) ? 1u : 0u; mine = (j == x) ? c : mine; }
        if (sum == G) break;
        __builtin_amdgcn_s_sleep(1);
        if ((++sp & 255u) == 0u) { if (xb_ld(&bar[XB_TMO])) break; if (sp > XB_SPIN_CAP) { atomicAdd(&bar[XB_TMO], 1u); break; } }
    }
    nloc = mine > 0u ? mine : 1u; nx = cnt > 0u ? cnt : 1u;
}
__device__ __forceinline__ void xcd_barrier(const XcdBarrier& b) {
    asm volatile("s_waitcnt vmcnt(0)" ::: "memory");
    __syncthreads();
    if (threadIdx.x == 0) {
        unsigned* bar = b.bar; asm volatile("" : "+s"(bar));
        __builtin_amdgcn_s_waitcnt(0);
        volatile LAS unsigned* st = b.st; asm volatile("" : "+s"(st));
        unsigned nloc = st[0], nx = st[1];
        if (nloc == 0u) { xcd_barrier_complete(bar, b.x, nloc, nx); st[0] = nloc; st[1] = nx; }
        const unsigned old = xb_add(&bar[XB_XSUB(b.x)], 1u);
        const unsigned gen = old / nloc;
        if (old + 1u == (gen + 1u) * nloc) {
            __builtin_amdgcn_fence(__ATOMIC_RELEASE, "agent");
            asm volatile("s_waitcnt vmcnt(0)" ::: "memory");
            const unsigned og = xb_add(&bar[XB_TOP], 1u);
            const unsigned tg = og / nx;
            if (og + 1u == (tg + 1u) * nx) xb_add(&bar[XB_TOPGEN], 1u);
            else XB_SPIN(xb_ld(&bar[XB_TOPGEN]) == tg, bar);
            __builtin_amdgcn_fence(__ATOMIC_ACQUIRE, "agent");
            xb_add(&bar[XB_XGEN(b.x)], 1u);
            asm volatile("s_waitcnt vmcnt(0)" ::: "memory");
        } else {
            XB_SPIN(xb_ld(&bar[XB_XGEN(b.x)]) == gen, bar);
            __builtin_amdgcn_fence(__ATOMIC_ACQUIRE, "agent");
            asm volatile("s_waitcnt vmcnt(0)" ::: "memory");
        }
    }
    __syncthreads();
}

namespace pg8 {
constexpr int BM = 256, BK = 64, HALF = 128, HTB = HALF * BK * 2, STAGE_BYTES = 8 * HTB, NXCD = 8, WGM = 8;
__host__ __device__ __forceinline__ int lds_byte(int r, int c) { const int st = (r >> 4) * 2 + (c >> 5), rr = r & 15, cc = c & 31, ob = rr * 64 + cc * 2; return st * 1024 + (ob ^ (((ob >> 9) & 1) << 5)); }
__host__ __device__ __forceinline__ void stage_rc(int b, int& R, int& C) { const int st = b / 1024, sb = b % 1024, swz = sb ^ (((sb >> 9) & 1) << 5); R = (st >> 1) * 16 + swz / 64; C = (st & 1) * 32 + (swz % 64) / 2; }
__host__ __device__ __forceinline__ int perm32(int rho) { const int n = rho >> 4, i = rho & 15; return 8 * (i >> 2) + 4 * n + (i & 3); }

struct Unit { unsigned a, b; int r0, pn; };

__device__ __forceinline__ bool dense_tile(int i, int G, int c, int nM, int nN, int& pm, int& pn) {
    const int nwg = nM * nN; const long L = (long)i * G + c; if (L >= nwg) return false;
    int wgid = (int)L; { const int q = nwg / NXCD, r = nwg % NXCD, xcd = wgid % NXCD, off = wgid / NXCD; wgid = (xcd < r ? xcd * (q + 1) : r * (q + 1) + (xcd - r) * q) + off; }
    const int nig = WGM * nN, gid = wgid / nig, fm = gid * WGM, gsz = (nM - fm) < WGM ? (nM - fm) : WGM;
    pm = fm + ((wgid % nig) % gsz); pn = (wgid % nig) / gsz; return true;
}

template <class Epi, class Sched, bool GATHER>
__device__ __forceinline__ void gemm_phase(LAS unsigned char* lds, const char* Ab, const char* Bb, const int* rowidx, const int K, const int lda, const Sched& S, const Epi& E) {
    const int tid = opq_tid(), wid = __builtin_amdgcn_readfirstlane(tid >> 6), lane = tid & 63, wr = wid >> 2, wc = wid & 3, fr = lane & 15, fq = lane >> 4;
    const int nt = K / BK;
    int Rr[2], Cc[2];
    unsigned voffA[2][2], voffB[2];
#pragma unroll
    for (int i = 0; i < 2; ++i) { int R, C; stage_rc(tid * 16 + i * 8192, R, C); Rr[i] = R; Cc[i] = C; const int Rb = Epi::PERM ? ((R & ~31) + perm32(R & 31)) : R;
        voffB[i] = (unsigned)(Rb * K + C) * 2u;
        voffA[0][i] = (unsigned)(R * lda + C) * 2u; voffA[1][i] = (unsigned)((R + HALF) * lda + C) * 2u; }
    const size_t kstep = (size_t)(BK * 2);
    const size_t hstepB = (size_t)HALF * K * 2;
    const unsigned ldsw = (unsigned)wid * 1024u;
    const int aoff = lds_byte(wr * 64 + fr, fq * 8), boff = lds_byte(wc * 32 + fr, fq * 8);
#define PG8_SA(b, h) (((b) * 2 + (h)) * HTB)
#define PG8_SB(b, h) ((4 + (b) * 2 + (h)) * HTB)
#define PG8_STAGE(bufoff, gbase, voff) do { _Pragma("unroll") for (int _i = 0; _i < 2; ++_i) \
        __builtin_amdgcn_global_load_lds((const unsigned*)((const char*)(gbase) + (voff)[_i]), (LAS unsigned*)(lds + (bufoff) + ldsw + _i * 8192), 16, 0, 0); } while (0)
#define PG8_LDA(dst, b, h) do { _Pragma("unroll") for (int m = 0; m < 4; ++m) _Pragma("unroll") for (int k = 0; k < 2; ++k) dst[m][k] = *(const LAS bf16x8*)(lds + PG8_SA(b, h) + aoff + m * 2048 + k * 1024); } while (0)
#define PG8_LDB(dst, b, h) do { _Pragma("unroll") for (int n = 0; n < 2; ++n) _Pragma("unroll") for (int k = 0; k < 2; ++k) dst[n][k] = *(const LAS bf16x8*)(lds + PG8_SB(b, h) + boff + n * 2048 + k * 1024); } while (0)
#define PG8_MMA(ai, bj, At, Bt) do { __builtin_amdgcn_s_setprio(1); _Pragma("unroll") for (int m = 0; m < 4; ++m) _Pragma("unroll") for (int n = 0; n < 2; ++n) _Pragma("unroll") for (int k = 0; k < 2; ++k) \
        acc[ai][bj][m][n] = __builtin_amdgcn_mfma_f32_16x16x32_bf16(Bt[n][k], At[m][k], acc[ai][bj][m][n], 0, 0, 0); __builtin_amdgcn_s_setprio(0); } while (0)
#define PG8_WAIT_V(n) asm volatile("s_waitcnt vmcnt(" #n ")" ::: "memory")
#define PG8_WAIT_L(n) asm volatile("s_waitcnt lgkmcnt(" #n ")" ::: "memory")
#define PG8_BAR __builtin_amdgcn_s_barrier()
#define PG8_SCHED __builtin_amdgcn_sched_barrier(0)
    Unit cur, nxt; int ui = 0;
    if (!S.next(0, cur)) return;
    if constexpr (GATHER) {
#pragma unroll
        for (int h = 0; h < 2; ++h)
#pragma unroll
            for (int i = 0; i < 2; ++i) voffA[h][i] = (unsigned)(rowidx[cur.r0 + h * HALF + Rr[i]] * lda + Cc[i]) * 2u;
    }
    f32x4 acc[2][2][4][2];
#pragma unroll
    for (int a = 0; a < 2; ++a)
#pragma unroll
        for (int b = 0; b < 2; ++b)
#pragma unroll
            for (int m = 0; m < 4; ++m)
#pragma unroll
                for (int n = 0; n < 2; ++n) acc[a][b][m][n] = (f32x4){0.f, 0.f, 0.f, 0.f};
    bf16x8 At[4][2], B0[2][2], B1[2][2];
    const char* cA = Ab + cur.a; const char* cB = Bb + cur.b;
    PG8_STAGE(PG8_SB(0, 0), cB, voffB); PG8_STAGE(PG8_SB(0, 1), cB + hstepB, voffB); PG8_STAGE(PG8_SA(0, 0), cA, voffA[0]); PG8_STAGE(PG8_SA(0, 1), cA, voffA[1]);
    if (wr == 1) PG8_BAR;
    PG8_WAIT_V(2); PG8_BAR;
    PG8_STAGE(PG8_SB(1, 0), cB + kstep, voffB); PG8_STAGE(PG8_SA(1, 0), cA + kstep, voffA[0]); PG8_STAGE(PG8_SB(1, 1), cB + hstepB + kstep, voffB);
    PG8_WAIT_V(6); PG8_BAR;
    for (;;) {
        const bool has_next = S.next(ui + 1, nxt);
        const char* nA = has_next ? Ab + nxt.a : cA; const char* nB = has_next ? Bb + nxt.b : cB;
        unsigned nvoff[2][2];
#pragma unroll
        for (int h = 0; h < 2; ++h)
#pragma unroll
            for (int i = 0; i < 2; ++i) nvoff[h][i] = voffA[h][i];
        if constexpr (GATHER) {
            if (has_next) {
#pragma unroll
                for (int h = 0; h < 2; ++h)
#pragma unroll
                    for (int i = 0; i < 2; ++i) nvoff[h][i] = (unsigned)(rowidx[nxt.r0 + h * HALF + Rr[i]] * lda + Cc[i]) * 2u;
            }
        }
        for (int t = 0; t < nt; t += 2) {
            const bool last = (t == nt - 2);
            const char* a1 = cA + (size_t)(t + 1) * kstep;
            const char* a2 = last ? nA : cA + (size_t)(t + 2) * kstep; const char* b2 = last ? nB : cB + (size_t)(t + 2) * kstep;
            const char* a3 = a2 + kstep; const char* b3 = b2 + kstep;
            unsigned v2[2][2];
#pragma unroll
            for (int h = 0; h < 2; ++h)
#pragma unroll
                for (int i = 0; i < 2; ++i) v2[h][i] = (GATHER && last) ? nvoff[h][i] : voffA[h][i];
            PG8_LDB(B0, 0, 0); PG8_LDB(B1, 0, 1); PG8_SCHED; PG8_LDA(At, 0, 0); PG8_STAGE(PG8_SA(1, 1), a1, voffA[1]);
            PG8_WAIT_V(8); PG8_WAIT_L(0); PG8_BAR; PG8_MMA(0, 0, At, B0); PG8_MMA(0, 1, At, B1); PG8_BAR; PG8_SCHED;
            PG8_LDA(At, 0, 1); PG8_STAGE(PG8_SB(0, 0), b2, voffB); PG8_STAGE(PG8_SB(0, 1), b2 + hstepB, voffB); PG8_STAGE(PG8_SA(0, 0), a2, v2[0]);
            PG8_WAIT_V(8); PG8_WAIT_L(0); PG8_BAR; PG8_MMA(1, 0, At, B0); PG8_MMA(1, 1, At, B1); PG8_BAR; PG8_SCHED;
            PG8_LDB(B0, 1, 0); PG8_LDB(B1, 1, 1); PG8_SCHED; PG8_LDA(At, 1, 0); PG8_STAGE(PG8_SA(0, 1), a2, v2[1]);
            PG8_WAIT_V(8); PG8_WAIT_L(0); PG8_BAR; PG8_MMA(0, 0, At, B0); PG8_MMA(0, 1, At, B1); PG8_BAR; PG8_SCHED;
            PG8_LDA(At, 1, 1); PG8_STAGE(PG8_SB(1, 0), b3, voffB); PG8_STAGE(PG8_SB(1, 1), b3 + hstepB, voffB); PG8_STAGE(PG8_SA(1, 0), a3, v2[0]);
            PG8_WAIT_V(8); PG8_WAIT_L(0); PG8_BAR; PG8_MMA(1, 0, At, B0); PG8_MMA(1, 1, At, B1); PG8_BAR; PG8_SCHED;
        }
        if (wr == 0) PG8_BAR;
        E(acc, cur.r0, cur.pn, wr, wc, fr, fq);
        if (!has_next) break;
#pragma unroll
        for (int a = 0; a < 2; ++a)
#pragma unroll
            for (int b = 0; b < 2; ++b)
#pragma unroll
                for (int m = 0; m < 4; ++m)
#pragma unroll
                    for (int n = 0; n < 2; ++n) acc[a][b][m][n] = (f32x4){0.f, 0.f, 0.f, 0.f};
        cur = nxt; cA = nA; cB = nB; ++ui;
#pragma unroll
        for (int h = 0; h < 2; ++h)
#pragma unroll
            for (int i = 0; i < 2; ++i) voffA[h][i] = nvoff[h][i];
        if (wr == 1) PG8_BAR;
    }
    PG8_WAIT_V(0);
    PG8_BAR;
#undef PG8_SA
#undef PG8_SB
#undef PG8_STAGE
#undef PG8_LDA
#undef PG8_LDB
#undef PG8_MMA
#undef PG8_WAIT_V
#undef PG8_WAIT_L
#undef PG8_BAR
#undef PG8_SCHED
}
}
#define MK_MULTI 0
#define MK_DBG 0
struct Params {
    const float *x, *rel_bias, *w_in, *mla_q_norm, *mla_w_uq, *mla_kv_norm, *mla_w_ukv, *gmlp_ln_g, *gmlp_ln_b, *gmlp_w_s, *gmlp_b_s,
                *diff_lq1, *diff_lk1, *diff_lq2, *diff_lk2, *diff_subln, *w_o, *ln1_g, *ln1_b, *router_w, *router_bias,
                *exp_w_gate, *exp_w_up, *exp_w_down, *shared_w_gate, *shared_w_up, *shared_w_down, *ln2_g, *ln2_b;
    float* out;
    unsigned char* ws;
    int ph_lo, ph_hi;
    int use_bar;
    int dbg;
    float lam_init0, lam_init1;
};

typedef const __attribute__((address_space(4))) Params* KP_T;
#define OPQ(p) asm volatile("" : "+s"(p))
constexpr size_t al256(size_t x) { return (x + 255) & ~(size_t)255; }
constexpr size_t WS_CTL = 0, CTL_ZERO_BYTES = 65536;
constexpr size_t WS_ROPE = 1u << 20;
constexpr size_t SZ_ROPE = (size_t)SEQ * 32 * 4 * 2;
constexpr size_t WS_WIN = al256(WS_ROPE + SZ_ROPE);
constexpr size_t SZ_WIN = (size_t)HW * DM * 2;
constexpr size_t WS_WUQ = al256(WS_WIN + NLAYER * SZ_WIN);
constexpr size_t SZ_WUQ = (size_t)1536 * 512 * 2;
constexpr size_t WS_WUKV = al256(WS_WUQ + NLAYER * SZ_WUQ);
constexpr size_t SZ_WUKV = (size_t)2048 * 256 * 2;
constexpr size_t WS_WO = al256(WS_WUKV + NLAYER * SZ_WUKV);
constexpr size_t SZ_WO = (size_t)DM * DM * 2;
constexpr size_t WS_WGU = al256(WS_WO + NLAYER * SZ_WO);
constexpr size_t SZ_WGU1 = (size_t)1024 * DM * 2, SZ_WGU = NEXP1 * SZ_WGU1;
constexpr size_t WS_WD = al256(WS_WGU + NLAYER * SZ_WGU);
constexpr size_t SZ_WD1 = (size_t)DM * EDIM * 2, SZ_WD = NEXP1 * SZ_WD1;
constexpr size_t WS_XB = al256(WS_WD + NLAYER * SZ_WD);
constexpr size_t WS_XF = al256(WS_XB + (size_t)T * DM * 2);
constexpr size_t WS_HB = al256(WS_XF + (size_t)T * DM * 4);
constexpr size_t WS_RSS = al256(WS_HB + (size_t)T * HW * 2);
constexpr size_t WS_QB = al256(WS_RSS + (size_t)T * 12 * 4);
constexpr size_t WS_KB = al256(WS_QB + (size_t)T * 8 * 192 * 2);
constexpr size_t WS_VB = al256(WS_KB + (size_t)T * 8 * 192 * 2);
constexpr size_t WS_MIX = al256(WS_VB + (size_t)T * 8 * 128 * 2);
constexpr size_t WS_Y1 = al256(WS_MIX + (size_t)T * DM * 2);
constexpr size_t WS_X1F = al256(WS_Y1 + (size_t)T * DM * 4);
constexpr size_t WS_X1B = al256(WS_X1F + (size_t)T * DM * 4);
constexpr size_t WS_EIDX = al256(WS_X1B + (size_t)T * DM * 2);
constexpr size_t WS_EW = al256(WS_EIDX + (size_t)T * 8 * 4);
constexpr size_t WS_ELR = al256(WS_EW + (size_t)T * 8 * 4);
constexpr size_t WS_HIST = al256(WS_ELR + (size_t)T * 8 * 4);
constexpr size_t WS_EOFF = al256(WS_HIST + (size_t)RT_UNITS * 64 * 4);
constexpr size_t WS_SLOT = al256(WS_EOFF + 72 * 4);
constexpr size_t WS_ROWIDX = al256(WS_SLOT + (size_t)T * 8 * 4);
constexpr size_t WS_GATEW = al256(WS_ROWIDX + (size_t)NSLOT * 4);
constexpr size_t WS_HMOE = al256(WS_GATEW + (size_t)NSLOT * 4);
constexpr size_t WS_YMOE = al256(WS_HMOE + (size_t)NSLOT * EDIM * 2);
constexpr size_t WS_END = al256(WS_YMOE + (size_t)NSLOT * DM * 2);
constexpr int CW_BAR = 4096;
constexpr int CW_QUEUE = 8192;
constexpr int CW_ERR = 9216;

constexpr int LDS_STAGE = 131072;
constexpr int LDS_MISC = LDS_STAGE;
constexpr int LDS_BYTES = LDS_STAGE + 4096;

enum { PH_PRO = 0, PH_L0 = 1, PHL_G1 = 0, PHL_G2 = 1, PHL_MIX = 2, PHL_WO = 3, PHL_LNR = 4, PHL_SLOT = 5, PHL_GU = 6, PHL_DN = 7, PHL_CMB = 8, PHL_N = 9, PH_END = 1 + 2 * PHL_N };
using pg8::Unit;
typedef const f32x4 (&AccRef)[2][2][4][2];

__device__ __forceinline__ u32x4 pack8(f32x4 v0, f32x4 v1) { u32x4 w; w.x = cvtpk(v0[0], v0[1]); w.y = cvtpk(v0[2], v0[3]); w.z = cvtpk(v1[0], v1[1]); w.w = cvtpk(v1[2], v1[3]); return w; }
__device__ __forceinline__ u32x2 pack4(f32x4 v) { u32x2 w; w.x = cvtpk(v[0], v[1]); w.y = cvtpk(v[2], v[3]); return w; }

struct Epi1 {
    static constexpr bool PERM = true;
    bf16_t* HB; float* RSS; bf16_t* KB; const float* rc; const float* rs;
    __device__ __forceinline__ void operator()(AccRef acc, const int r0, const int pn, int wr, int wc, int fr, int fq) const {
        const int row0 = r0 + wr * 64 + fr;
        if (pn == 13) {
            if (wc < 2) {
                const int i0 = 4 * (wc * 4 + fq);
#pragma unroll
                for (int ai = 0; ai < 2; ++ai)
#pragma unroll
                    for (int m = 0; m < 4; ++m) {
                        const int row = row0 + ai * 128 + m * 16, pos = row & (SEQ - 1);
                        const f32x4 c = *(const f32x4*)(rc + pos * 32 + i0), s = *(const f32x4*)(rs + pos * 32 + i0);
                        const f32x4 x1 = acc[ai][0][m][0], x2 = acc[ai][0][m][1];
                        const u32x2 y1 = pack4(x1 * c - x2 * s), y2 = pack4(x2 * c + x1 * s);
                        bf16_t* kp = KB + (size_t)row * (8 * 192) + 128 + i0;
#pragma unroll
                        for (int h = 0; h < 8; ++h) { *(u32x2*)(kp + h * 192) = y1; *(u32x2*)(kp + h * 192 + 32) = y2; }
                    }
            }
            return;
        }
        const int mode = (pn <= 2) ? 0 : (pn <= 6) ? 1 : (pn <= 8) ? 2 : 3;
#pragma unroll
        for (int ai = 0; ai < 2; ++ai)
#pragma unroll
            for (int m = 0; m < 4; ++m) {
                const int row = row0 + ai * 128 + m * 16;
                bf16_t* rowp = HB + (size_t)row * HW + pn * 256 + wc * 32 + 8 * fq;
                float ss = 0.f;
#pragma unroll
                for (int bj = 0; bj < 2; ++bj) {
                    f32x4 v0 = acc[ai][bj][m][0], v1 = acc[ai][bj][m][1];
                    if (mode == 0) { ss += (v0[0] * v0[0] + v0[1] * v0[1]) + (v0[2] * v0[2] + v0[3] * v0[3]) + (v1[0] * v1[0] + v1[1] * v1[1]) + (v1[2] * v1[2] + v1[3] * v1[3]); }
                    if (mode == 1) {
#pragma unroll
                        for (int j = 0; j < 4; ++j) { v0[j] = gelu_tanh(v0[j]); v1[j] = gelu_tanh(v1[j]); } }
                    if (mode == 2) { v0 = v0 * (0.125f * LOG2E); v1 = v1 * (0.125f * LOG2E); }
                    *(u32x4*)(rowp + bj * 128) = pack8(v0, v1);
                }
                if (mode == 0) { ss += __shfl_xor(ss, 16); ss += __shfl_xor(ss, 32); if (fq == 0) RSS[(size_t)row * 12 + pn * 4 + wc] = ss; }
            }
    }
};

struct Epi2 {
    static constexpr bool PERM = true;
    int mode; const float* RSS; bf16_t *QB, *KB, *VB; const float* rc; const float* rs;
    __device__ __forceinline__ void operator()(AccRef acc, const int r0, const int pn, int wr, int wc, int fr, int fq) const {
        const int row0 = r0 + wr * 64 + fr;
#pragma unroll
        for (int ai = 0; ai < 2; ++ai)
#pragma unroll
            for (int m = 0; m < 4; ++m) {
                const int row = row0 + ai * 128 + m * 16;
                const float* rp = RSS + (size_t)row * 12;
                float sc;
                if (mode == 0) { const f32x4 a = *(const f32x4*)rp, b = *(const f32x4*)(rp + 4); const float ss = ((a[0] + a[1]) + (a[2] + a[3])) + ((b[0] + b[1]) + (b[2] + b[3]));
                    sc = rsqrtf(ss * (1.0f / 512.0f) + 1e-6f) * (0.07216878364870322f * LOG2E); }
                else { const f32x4 a = *(const f32x4*)(rp + 8); const float ss = (a[0] + a[1]) + (a[2] + a[3]); sc = rsqrtf(ss * (1.0f / 256.0f) + 1e-6f); }
#pragma unroll
                for (int bj = 0; bj < 2; ++bj) {
                    const f32x4 v0 = acc[ai][bj][m][0] * sc, v1 = acc[ai][bj][m][1] * sc;
                    if (mode == 0) {
                        const int col8 = pn * 256 + bj * 128 + wc * 32 + 8 * fq, head = col8 / 192, w = col8 - head * 192;
                        bf16_t* qp = QB + ((size_t)row * 8 + head) * 192;
                        if (w < 128) *(u32x4*)(qp + w) = pack8(v0, v1);
                        else { const int i0 = 4 * ((w - 128) >> 3), pos = row & (SEQ - 1);
                            const f32x4 c = *(const f32x4*)(rc + pos * 32 + i0), s = *(const f32x4*)(rs + pos * 32 + i0);
                            *(u32x2*)(qp + 128 + i0) = pack4(v0 * c - v1 * s); *(u32x2*)(qp + 160 + i0) = pack4(v1 * c + v0 * s); }
                    } else {
                        if (bj == 0) *(u32x4*)(KB + ((size_t)row * 8 + pn) * 192 + wc * 32 + 8 * fq) = pack8(v0, v1);
                        else         *(u32x4*)(VB + ((size_t)row * 8 + pn) * 128 + wc * 32 + 8 * fq) = pack8(v0, v1);
                    }
                }
            }
    }
};

struct EpiWO {
    static constexpr bool PERM = false;
    const float* XF; float* Y1;
    __device__ __forceinline__ void operator()(AccRef acc, const int r0, const int pn, int wr, int wc, int fr, int fq) const {
        const int row0 = r0 + wr * 64 + fr, col0 = pn * 256 + wc * 32 + 4 * fq;
#pragma unroll
        for (int ai = 0; ai < 2; ++ai)
#pragma unroll
            for (int m = 0; m < 4; ++m) { const size_t o = (size_t)(row0 + ai * 128 + m * 16) * DM + col0;
#pragma unroll
                for (int bj = 0; bj < 2; ++bj)
#pragma unroll
                    for (int n = 0; n < 2; ++n) { const f32x4 xv = *(const f32x4*)(XF + o + bj * 128 + n * 16); *(f32x4*)(Y1 + o + bj * 128 + n * 16) = xv * DN_ALPHA + acc[ai][bj][m][n]; } }
    }
};

struct EpiGU {
    static constexpr bool PERM = true;
    const float* GATEW; bf16_t* HM;
    __device__ __forceinline__ void operator()(AccRef acc, const int r0, const int pn, int wr, int wc, int fr, int fq) const {
        const int s0 = r0 + wr * 64 + fr;
#pragma unroll
        for (int ai = 0; ai < 2; ++ai)
#pragma unroll
            for (int m = 0; m < 4; ++m) {
                const int slot = s0 + ai * 128 + m * 16; const float gw = GATEW[slot];
                f32x4 h0, h1;
#pragma unroll
                for (int j = 0; j < 4; ++j) { const float g0 = acc[ai][0][m][0][j], g1 = acc[ai][0][m][1][j];
                    h0[j] = g0 * sigmoidf_(g0) * acc[ai][1][m][0][j] * gw; h1[j] = g1 * sigmoidf_(g1) * acc[ai][1][m][1][j] * gw; }
                *(u32x4*)(HM + (size_t)slot * EDIM + pn * 128 + wc * 32 + 8 * fq) = pack8(h0, h1);
            }
    }
};

struct EpiDN {
    static constexpr bool PERM = true;
    bf16_t* YM;
    __device__ __forceinline__ void operator()(AccRef acc, const int r0, const int pn, int wr, int wc, int fr, int fq) const {
        const int s0 = r0 + wr * 64 + fr;
#pragma unroll
        for (int ai = 0; ai < 2; ++ai)
#pragma unroll
            for (int m = 0; m < 4; ++m) { bf16_t* yp = YM + (size_t)(s0 + ai * 128 + m * 16) * DM + pn * 256 + wc * 32 + 8 * fq;
#pragma unroll
                for (int bj = 0; bj < 2; ++bj) *(u32x4*)(yp + bj * 128) = pack8(acc[ai][bj][m][0], acc[ai][bj][m][1]); }
    }
};

struct SchedDense {
    int lda, K, nM, nN, G, c;
    __device__ __forceinline__ bool next(int i, Unit& u) const {
        int pm, pn; if (!pg8::dense_tile(i, G, c, nM, nN, pm, pn)) return false;
        u.a = (unsigned)pm * 256u * (unsigned)lda * 2u; u.b = (unsigned)pn * 256u * (unsigned)K * 2u; u.r0 = pm * 256; u.pn = pn; return true;
    }
};
struct SchedMoE {
    const LAS int* t2e; unsigned wstride; int rowbytes, K, NJ, nunits, G, v;
    __device__ __forceinline__ bool next(int i, Unit& u) const {
        const int L = i * G + v; if (L >= nunits) return false;
        const int mt = L / NJ, j = L - mt * NJ, e = t2e[mt];
        u.a = (unsigned)mt * 256u * (unsigned)rowbytes; u.b = (unsigned)e * wstride + (unsigned)j * 256u * (unsigned)K * 2u; u.r0 = mt * 256; u.pn = j; return true;
    }
};
__device__ __forceinline__ void tr_item(const float* colp, int ldn, const float* gain, bf16_t* dst, int K, int k0, int n0, LAS float* scr, int lane) {
#pragma unroll 8
    for (int i = 0; i < 32; ++i) { const int kk = 2 * i + (lane >> 5); float v = colp ? colp[(size_t)(k0 + kk) * ldn] : 0.f; if (gain) v *= gain[k0 + kk]; scr[kk * 33 + (lane & 31)] = v; }
    LDS_WAIT(); asm volatile("" ::: "memory");
    const int c = lane & 7;
#pragma unroll
    for (int j = 0; j < 4; ++j) { const int n = (lane >> 3) + 8 * j; const LAS float* s = scr + (8 * c) * 33 + n;
        u32x4 o; o.x = cvtpk(s[0 * 33], s[1 * 33]); o.y = cvtpk(s[2 * 33], s[3 * 33]); o.z = cvtpk(s[4 * 33], s[5 * 33]); o.w = cvtpk(s[6 * 33], s[7 * 33]);
        *(u32x4*)(dst + (size_t)(n0 + n) * K + k0 + 8 * c) = o; }
    LDS_WAIT(); asm volatile("" ::: "memory");
}
__device__ __forceinline__ int rope_unperm(int p) { const int g = p >> 3, w = p & 7; return 4 * g + (w & 3) + ((w >= 4) ? 32 : 0); }

constexpr int IT_WIN = (DM / 64) * (HW / 32), IT_WUQ = (512 / 64) * (1536 / 32), IT_WUKV = (256 / 64) * (2048 / 32), IT_WO = (DM / 64) * (DM / 32),
              IT_WGU1 = (DM / 64) * (1024 / 32), IT_WD1 = (EDIM / 64) * (DM / 32);
constexpr int IT_LAYER = IT_WIN + IT_WUQ + IT_WUKV + IT_WO + NEXP1 * (IT_WGU1 + IT_WD1);

__device__ __forceinline__ void prologue_phase(KP_T P, LAS unsigned char* lds, int vcu, int G) {
    const int tid = opq_tid(), lane = tid & 63, wave = __builtin_amdgcn_readfirstlane(tid >> 6);
    LAS float* scr = (LAS float*)(lds + wave * 16384);
    const int gw = vcu * NWAVES + wave, NGW = G * NWAVES;
    unsigned char* ws = P->ws;
    for (int it = gw; it < NLAYER * IT_LAYER; it += NGW) {
        const int l = it / IT_LAYER; int r = it - l * IT_LAYER;
        const int ln = lane & 31;
        if (r < IT_WIN) {
            const int nblk = HW / 32, kb = r / nblk, nb = r - kb * nblk, np = nb * 32 + ln;
            int oc; if (np < 768) oc = np; else if (np < HC_KR) oc = np + 64; else if (np < HC_KR + 64) oc = 768 + rope_unperm(np - HC_KR); else oc = -1;
            const float* cp = oc >= 0 ? P->w_in + (size_t)l * DM * IN_W + oc : nullptr;
            tr_item(cp, IN_W, nullptr, (bf16_t*)(ws + WS_WIN + l * SZ_WIN), DM, kb * 64, nb * 32, scr, lane); continue; }
        r -= IT_WIN;
        if (r < IT_WUQ) {
            const int nblk = 1536 / 32, kb = r / nblk, nb = r - kb * nblk, np = nb * 32 + ln, head = np / 192, w = np - head * 192;
            const int oc = (w < 128) ? np : head * 192 + 128 + rope_unperm(w - 128);
            tr_item(P->mla_w_uq + (size_t)l * 512 * 1536 + oc, 1536, P->mla_q_norm + l * 512, (bf16_t*)(ws + WS_WUQ + l * SZ_WUQ), 512, kb * 64, nb * 32, scr, lane); continue; }
        r -= IT_WUQ;
        if (r < IT_WUKV) {
            const int nblk = 2048 / 32, kb = r / nblk, nb = r - kb * nblk, np = nb * 32 + ln;
            tr_item(P->mla_w_ukv + (size_t)l * 256 * 2048 + np, 2048, P->mla_kv_norm + l * 256, (bf16_t*)(ws + WS_WUKV + l * SZ_WUKV), 256, kb * 64, nb * 32, scr, lane); continue; }
        r -= IT_WUKV;
        if (r < IT_WO) {
            const int nblk = DM / 32, kb = r / nblk, nb = r - kb * nblk, np = nb * 32 + ln;
            tr_item(P->w_o + (size_t)l * DM * DM + np, DM, nullptr, (bf16_t*)(ws + WS_WO + l * SZ_WO), DM, kb * 64, nb * 32, scr, lane); continue; }
        r -= IT_WO;
        if (r < NEXP1 * IT_WGU1) {
            const int e = r / IT_WGU1, rr = r - e * IT_WGU1, nblk = 1024 / 32, kb = rr / nblk, nb = rr - kb * nblk, np = nb * 32 + ln;
            const int tj = np >> 8, w = np & 255, col = tj * 128 + (w & 127); const bool up = w >= 128;
            const float* src = (e < NEXP) ? (up ? P->exp_w_up : P->exp_w_gate) + ((size_t)l * NEXP + e) * DM * EDIM : (up ? P->shared_w_up : P->shared_w_gate) + (size_t)l * DM * EDIM;
            tr_item(src + col, EDIM, nullptr, (bf16_t*)(ws + WS_WGU + l * SZ_WGU + e * SZ_WGU1), DM, kb * 64, nb * 32, scr, lane); continue; }
        r -= NEXP1 * IT_WGU1;
        {
            const int e = r / IT_WD1, rr = r - e * IT_WD1, nblk = DM / 32, kb = rr / nblk, nb = rr - kb * nblk, np = nb * 32 + ln;
            const float* src = (e < NEXP) ? P->exp_w_down + ((size_t)l * NEXP + e) * EDIM * DM : P->shared_w_down + (size_t)l * EDIM * DM;
            tr_item(src + np, DM, nullptr, (bf16_t*)(ws + WS_WD + l * SZ_WD + e * SZ_WD1), EDIM, kb * 64, nb * 32, scr, lane); }
    }
    { bf16_t* XB = (bf16_t*)(ws + WS_XB);
      for (int ch = gw; ch < T * DM / 512; ch += NGW) { const size_t o = (size_t)ch * 512 + lane * 8;
          const f32x4 a = *(const f32x4*)(P->x + o), b = *(const f32x4*)(P->x + o + 4); *(u32x4*)(XB + o) = pack8(a, b); } }
    { float* rc = (float*)(ws + WS_ROPE); float* rs = rc + SEQ * 32;
      for (int i = gw * 64 + lane; i < SEQ * 32; i += NGW * 64) { const int pos = i >> 5, f = i & 31;
          const float inv = exp2f(-(float)f * (1.0f / 32.0f) * 13.287712379549449f);
          const float ang = (float)pos * inv;
          const double q = (double)ang * 0.15915494309189535; const double fr = q - __builtin_rint(q);
          const float rad = (float)(fr * 6.283185307179586);
          rc[i] = __cosf(rad); rs[i] = __sinf(rad); } }
}
typedef short v4i16_t __attribute__((ext_vector_type(4)));
__device__ __forceinline__ s16x4 vtr(const LAS char* p) { return __builtin_bit_cast(s16x4, __builtin_amdgcn_ds_read_tr16_b64_v4i16((LAS v4i16_t*)p)); }
#define FRAG8(lo, hi) ((bf16x8){(lo)[0], (lo)[1], (lo)[2], (lo)[3], (hi)[0], (hi)[1], (hi)[2], (hi)[3]})
constexpr int VROW = 320;
constexpr int KROW_M = 400;
constexpr int KROW_D = 272;
constexpr int MLA_KB = 64 * KROW_M, MLA_BUF = MLA_KB + 64 * VROW;
constexpr int DIF_KB = 64 * KROW_D, DIF_BUF = DIF_KB + 64 * VROW;
constexpr int ATT_TAB = 98304;
static_assert(2 * MLA_BUF <= ATT_TAB && 4 * 66 * 64 * 4 <= ATT_TAB && ATT_TAB + 512 <= LDS_STAGE, "attention LDS map");

template <int NT>
__device__ __forceinline__ void smax_update(f32x16 (&S)[NT], float& m, float& l, f32x16 (&O)[4], bf16x8 (&pf)[NT][2]) {
    float mx = S[0][0];
#pragma unroll
    for (int t = 0; t < NT; ++t)
#pragma unroll
        for (int r = 0; r < 16; ++r) mx = fmaxf(mx, S[t][r]);
    mx = fmaxf(mx, __shfl_xor(mx, 32));
    const float mn = fmaxf(m, mx);
    const float alpha = __builtin_amdgcn_exp2f(m - mn);
    m = mn;
    float sum = 0.f;
#pragma unroll
    for (int t = 0; t < NT; ++t)
#pragma unroll
        for (int r = 0; r < 16; ++r) { const float p = __builtin_amdgcn_exp2f(S[t][r] - mn); S[t][r] = p; sum += p; }
    l = l * alpha + sum;
    if (!__all(alpha == 1.0f)) {
#pragma unroll
        for (int d = 0; d < 4; ++d) O[d] = O[d] * alpha;
    }
#pragma unroll
    for (int t = 0; t < NT; ++t)
#pragma unroll
        for (int s = 0; s < 2; ++s) { u32x4 w; w.x = cvtpk(S[t][8 * s + 0], S[t][8 * s + 1]); w.y = cvtpk(S[t][8 * s + 2], S[t][8 * s + 3]); w.z = cvtpk(S[t][8 * s + 4], S[t][8 * s + 5]); w.w = cvtpk(S[t][8 * s + 6], S[t][8 * s + 7]);
            pf[t][s] = __builtin_bit_cast(bf16x8, w); }
}
__device__ __forceinline__ void pv_tile(f32x16 (&O)[4], const LAS char* vp, const bf16x8 (&pf)[2]) {
#pragma unroll
    for (int dt = 0; dt < 4; ++dt)
#pragma unroll
        for (int s = 0; s < 2; ++s) {
            const s16x4 lo = vtr(vp + (16 * s) * VROW + dt * 64), hi = vtr(vp + (16 * s + 8) * VROW + dt * 64);
            O[dt] = __builtin_amdgcn_mfma_f32_32x32x16_bf16(FRAG8(lo, hi), pf[s], O[dt], 0, 0, 0);
        }
}

__device__ __forceinline__ void mla_unit(KP_T P, LAS unsigned char* lds, int b, int h, int qb) {
    const int tid = opq_tid(), lane = tid & 63, wid = __builtin_amdgcn_readfirstlane(tid >> 6), rg = wid & 3, kg = wid >> 2, ql = lane & 31, hh = lane >> 5;
    const bf16_t* QB = (const bf16_t*)(P->ws + WS_QB); const bf16_t* KB = (const bf16_t*)(P->ws + WS_KB); const bf16_t* VB = (const bf16_t*)(P->ws + WS_VB); bf16_t* MIX = (bf16_t*)(P->ws + WS_MIX);
    const int q0 = qb * 128, nsteps = 2 * (qb + 1), rowmin = q0 + 32 * rg, row = rowmin + ql;
    int goff[5], loff[5];
#pragma unroll
    for (int i = 0; i < 5; ++i) { const int c = tid + 512 * i;
        if (i < 3) { const int r = c / 24, cc = c - r * 24; goff[i] = r * (8 * 192 * 2) + cc * 16; loff[i] = r * KROW_M + cc * 16; }
        else { const int c2 = c - 1536, r = c2 >> 4, cc = c2 & 15; goff[i] = r * (8 * 128 * 2) + cc * 16; loff[i] = MLA_KB + r * VROW + cc * 16; } }
    const char* kg0 = (const char*)(KB + ((size_t)b * SEQ * 8 + h) * 192); const char* vg0 = (const char*)(VB + ((size_t)b * SEQ * 8 + h) * 128);
    u32x4 st[5];
#define MLA_LOAD(j) do { _Pragma("unroll") for (int i = 0; i < 5; ++i) st[i] = *(const u32x4*)((i < 3 ? kg0 + (size_t)(j) * 64 * (8 * 192 * 2) : vg0 + (size_t)(j) * 64 * (8 * 128 * 2)) + goff[i]); } while (0)
#define MLA_WRITE(buf) do { _Pragma("unroll") for (int i = 0; i < 5; ++i) *(LAS u32x4*)(lds + (buf) * MLA_BUF + loff[i]) = st[i]; } while (0)
    MLA_LOAD(0);
    bf16x8 qf[12];
    { const bf16_t* qp = QB + (((size_t)b * SEQ + row) * 8 + h) * 192 + 8 * hh;
#pragma unroll
      for (int ks = 0; ks < 12; ++ks) qf[ks] = *(const bf16x8*)(qp + 16 * ks); }
    f32x16 O[4];
#pragma unroll
    for (int d = 0; d < 4; ++d)
#pragma unroll
        for (int r = 0; r < 16; ++r) O[d][r] = 0.f;
    float m = -1e30f, l = 0.f;
    MLA_WRITE(0);
    __syncthreads();
    const int koff = (32 * kg + ql) * KROW_M + 16 * hh;
    const int voff = MLA_KB + (32 * kg + 4 * hh + ((lane & 15) >> 2)) * VROW + (16 * ((lane >> 4) & 1) + 4 * (lane & 3)) * 2;
    for (int j = 0; j < nsteps; ++j) {
        const bool more = (j + 1 < nsteps);
        if (more) MLA_LOAD(j + 1);
        const int kbase = 64 * j + 32 * kg;
        if (kbase <= rowmin + 31) {
            const LAS unsigned char* buf = lds + (j & 1) * MLA_BUF;
            f32x16 S[1];
#pragma unroll
            for (int r = 0; r < 16; ++r) S[0][r] = 0.f;
#pragma unroll
            for (int ks = 0; ks < 12; ++ks) { const bf16x8 a = *(const LAS bf16x8*)(buf + koff + 32 * ks); S[0] = __builtin_amdgcn_mfma_f32_32x32x16_bf16(a, qf[ks], S[0], 0, 0, 0); }
            if (kbase + 31 > rowmin) {
#pragma unroll
                for (int r = 0; r < 16; ++r) { const int key = kbase + (r & 3) + 8 * (r >> 2) + 4 * hh; if (key > row) S[0][r] = -INFINITY; }
            }
            bf16x8 pf[1][2];
            smax_update<1>(S, m, l, O, pf);
            pv_tile(O, (const LAS char*)(buf + voff), pf[0]);
        }
        if (more) MLA_WRITE((j + 1) & 1);
        __syncthreads();
    }
    LAS float* xb = (LAS float*)lds + rg * (66 * 64) + lane;
    if (kg == 1) {
#pragma unroll
        for (int d = 0; d < 4; ++d)
#pragma unroll
            for (int r = 0; r < 16; ++r) xb[(d * 16 + r) * 64] = O[d][r];
        xb[64 * 64] = m; xb[65 * 64] = l;
    }
    __syncthreads();
    if (kg == 0) {
        const float m1 = xb[64 * 64], l1 = xb[65 * 64];
        const float mt = fmaxf(m, m1), a0 = __builtin_amdgcn_exp2f(m - mt), a1 = __builtin_amdgcn_exp2f(m1 - mt);
        float lt = l * a0 + l1 * a1; lt += __shfl_xor(lt, 32);
        const float inv = 1.0f / lt;
        bf16_t* op = MIX + ((size_t)b * SEQ + row) * DM + h * 128 + 4 * hh;
#pragma unroll
        for (int d = 0; d < 4; ++d)
#pragma unroll
            for (int g4 = 0; g4 < 4; ++g4) { f32x4 v;
#pragma unroll
                for (int j = 0; j < 4; ++j) { const int r = 4 * g4 + j; v[j] = (O[d][r] * a0 + xb[(d * 16 + r) * 64] * a1) * inv; }
                *(u32x2*)(op + 32 * d + 8 * g4) = pack4(v); }
    }
    __syncthreads();
#undef MLA_LOAD
#undef MLA_WRITE
}

__device__ __forceinline__ void diff_unit(KP_T P, LAS unsigned char* lds, int lyr, int b, int h, int qb, float lam_init) {
    const int tid = opq_tid(), lane = tid & 63, wid = __builtin_amdgcn_readfirstlane(tid >> 6), rg = wid & 3, mp = wid >> 2, ql = lane & 31, hh = lane >> 5;
    const bf16_t* HB = (const bf16_t*)(P->ws + WS_HB); bf16_t* MIX = (bf16_t*)(P->ws + WS_MIX);
    const int q0 = qb * 128, nsteps = 2 * (qb + 1), rowmin = q0 + 32 * rg, row = rowmin + ql;
    LAS float* tab = (LAS float*)(lds + ATT_TAB);
    if (tid < 128) { const int n = tid; int bk;
        if (n < 16) bk = n; else { bk = 16 + (int)(logf((float)n * (1.0f / 16.0f)) / 2.0794415416798357f * 16.0f); bk = bk > 31 ? 31 : bk; }
        tab[n] = P->rel_bias[bk * 4 + h] * LOG2E; }
    float lam;
    { const float a = P->diff_lq1[lyr * 64 + lane] * P->diff_lk1[lyr * 64 + lane], c = P->diff_lq2[lyr * 64 + lane] * P->diff_lk2[lyr * 64 + lane];
      lam = expf(wave_sum(a)) - expf(wave_sum(c)) + lam_init; }
    int goff[4], loff[4];
#pragma unroll
    for (int i = 0; i < 4; ++i) { const int c = (tid + 512 * i) & 1023, r = c >> 4, cc = c & 15; goff[i] = r * (HW * 2) + cc * 16 + (i < 2 ? HC_DK * 2 : HC_DV * 2); loff[i] = (i < 2 ? r * KROW_D : DIF_KB + r * VROW) + cc * 16; }
    const char* hg0 = (const char*)(HB + (size_t)b * SEQ * HW + h * 128);
    u32x4 st[4];
#define DIF_LOAD(j) do { _Pragma("unroll") for (int i = 0; i < 4; ++i) st[i] = *(const u32x4*)(hg0 + (size_t)(j) * 64 * (HW * 2) + goff[i]); } while (0)
#define DIF_WRITE(buf) do { _Pragma("unroll") for (int i = 0; i < 4; ++i) *(LAS u32x4*)(lds + (buf) * DIF_BUF + loff[i]) = st[i]; } while (0)
    DIF_LOAD(0);
    bf16x8 qf[4];
    { const bf16_t* qp = HB + ((size_t)b * SEQ + row) * HW + HC_DQ + h * 128 + mp * 64 + 8 * hh;
#pragma unroll
      for (int ks = 0; ks < 4; ++ks) qf[ks] = *(const bf16x8*)(qp + 16 * ks); }
    f32x16 O[4];
#pragma unroll
    for (int d = 0; d < 4; ++d)
#pragma unroll
        for (int r = 0; r < 16; ++r) O[d][r] = 0.f;
    float m = -1e30f, l = 0.f;
    DIF_WRITE(0);
    __syncthreads();
    const float c31 = tab[127];
    const int koff = ql * KROW_D + (64 * mp + 8 * hh) * 2;
    const int voff = DIF_KB + (4 * hh + ((lane & 15) >> 2)) * VROW + (16 * ((lane >> 4) & 1) + 4 * (lane & 3)) * 2;
    for (int j = 0; j < nsteps; ++j) {
        const bool more = (j + 1 < nsteps);
        if (more) DIF_LOAD(j + 1);
        const int kbase = 64 * j;
        if (kbase <= rowmin + 31) {
            const LAS unsigned char* buf = lds + (j & 1) * DIF_BUF;
            f32x16 S[2];
#pragma unroll
            for (int t = 0; t < 2; ++t) {
#pragma unroll
                for (int r = 0; r < 16; ++r) S[t][r] = 0.f;
#pragma unroll
                for (int ks = 0; ks < 4; ++ks) { const bf16x8 a = *(const LAS bf16x8*)(buf + koff + t * 32 * KROW_D + 32 * ks); S[t] = __builtin_amdgcn_mfma_f32_32x32x16_bf16(a, qf[ks], S[t], 0, 0, 0); }
            }
            if (rowmin - (kbase + 63) >= 127) {
#pragma unroll
                for (int t = 0; t < 2; ++t)
#pragma unroll
                    for (int r = 0; r < 16; ++r) S[t][r] += c31;
            } else {
#pragma unroll
                for (int t = 0; t < 2; ++t)
#pragma unroll
                    for (int r = 0; r < 16; ++r) { const int key = kbase + 32 * t + (r & 3) + 8 * (r >> 2) + 4 * hh; int n = row - key; const bool ok = n >= 0; n = n < 0 ? 0 : (n > 127 ? 127 : n);
                        S[t][r] = ok ? S[t][r] + tab[n] : -INFINITY; }
            }
            bf16x8 pf[2][2];
            smax_update<2>(S, m, l, O, pf);
            pv_tile(O, (const LAS char*)(buf + voff), pf[0]);
            pv_tile(O, (const LAS char*)(buf + voff + 32 * VROW), pf[1]);
        }
        if (more) DIF_WRITE((j + 1) & 1);
        __syncthreads();
    }
    { float lt = l + __shfl_xor(l, 32); const float inv = 1.0f / lt;
#pragma unroll
      for (int d = 0; d < 4; ++d) O[d] = O[d] * inv; }
    LAS float* xb = (LAS float*)lds + rg * (64 * 64) + lane;
    if (mp == 1) {
#pragma unroll
        for (int d = 0; d < 4; ++d)
#pragma unroll
            for (int r = 0; r < 16; ++r) xb[(d * 16 + r) * 64] = O[d][r];
    }
    __syncthreads();
    if (mp == 0) {
        float ss = 0.f;
#pragma unroll
        for (int d = 0; d < 4; ++d)
#pragma unroll
            for (int r = 0; r < 16; ++r) { const float o = O[d][r] - lam * xb[(d * 16 + r) * 64]; O[d][r] = o; ss += o * o; }
        ss += __shfl_xor(ss, 32);
        const float rs = rsqrtf(ss * (1.0f / 128.0f) + 1e-6f) * (1.0f - lam_init);
        bf16_t* op = MIX + ((size_t)b * SEQ + row) * DM + 1536 + h * 128 + 4 * hh;
        const float* gp = P->diff_subln + lyr * 128 + 4 * hh;
#pragma unroll
        for (int d = 0; d < 4; ++d)
#pragma unroll
            for (int g4 = 0; g4 < 4; ++g4) { const f32x4 g = *(const f32x4*)(gp + 32 * d + 8 * g4); f32x4 v;
#pragma unroll
                for (int j = 0; j < 4; ++j) v[j] = O[d][4 * g4 + j] * rs * g[j];
                *(u32x2*)(op + 32 * d + 8 * g4) = pack4(v); }
    }
    __syncthreads();
#undef DIF_LOAD
#undef DIF_WRITE
}

constexpr int GM_W = 0, GM_V = 128 * KROW_D, GM_ST = GM_V + 128 * VROW;
__device__ __forceinline__ void gmlp_unit(KP_T P, LAS unsigned char* lds, int lyr, int b, int c) {
    const int tid = opq_tid(), lane = tid & 63, wid = __builtin_amdgcn_readfirstlane(tid >> 6), ql = lane & 31, hh = lane >> 5;
    const bf16_t* HB = (const bf16_t*)(P->ws + WS_HB); bf16_t* MIX = (bf16_t*)(P->ws + WS_MIX);
    const size_t R0 = (size_t)b * SEQ + c * 128;
    LAS f32x2* stats = (LAS f32x2*)(lds + GM_ST);
    for (int rr = 0; rr < 16; ++rr) { const int r = 16 * wid + rr;
        const u32x4 w = *(const u32x4*)(HB + (R0 + r) * HW + HC_GV + 8 * lane);
        float v[8] = {bflo(w.x), bfhi(w.x), bflo(w.y), bfhi(w.y), bflo(w.z), bfhi(w.z), bflo(w.w), bfhi(w.w)};
        float s = 0.f;
#pragma unroll
        for (int j = 0; j < 8; ++j) s += v[j];
        const float mean = wave_sum(s) * (1.0f / 512.0f); float q = 0.f;
#pragma unroll
        for (int j = 0; j < 8; ++j) { const float d = v[j] - mean; q += d * d; }
        const float rstd = rsqrtf(wave_sum(q) * (1.0f / 512.0f) + 1e-5f);
        if (lane == 0) stats[r] = (f32x2){mean, rstd}; }
    __syncthreads();
    const int tt = wid & 3, dp = wid >> 2;
    const int woff = GM_W + (32 * tt + ql) * KROW_D + 16 * hh;
    const int voff = GM_V + (8 * hh + ((lane & 15) >> 2)) * VROW + (16 * ((lane >> 4) & 1) + 4 * (lane & 3)) * 2;
    for (int g = 0; g < 4; ++g) {
#pragma unroll
        for (int i = 0; i < 4; ++i) { const int cid = tid + 512 * i, t = cid >> 4, s0 = (cid & 15) * 8;
            const float* wp = P->gmlp_w_s + (((size_t)lyr * 4 + g) * 128 + t) * 128 + s0; const f32x4 a = *(const f32x4*)wp, bq = *(const f32x4*)(wp + 4);
            f32x4 a2, b2;
#pragma unroll
            for (int j = 0; j < 4; ++j) { a2[j] = (s0 + j <= t) ? a[j] : 0.f; b2[j] = (s0 + 4 + j <= t) ? bq[j] : 0.f; }
            *(LAS u32x4*)(lds + GM_W + t * KROW_D + s0 * 2) = pack8(a2, b2);
            const int r = cid >> 4, c8 = (cid & 15) * 8; const f32x2 ms = stats[r];
            const u32x4 w = *(const u32x4*)(HB + (R0 + r) * HW + HC_GV + g * 128 + c8);
            const float* gp = P->gmlp_ln_g + lyr * 512 + g * 128 + c8; const float* bp = P->gmlp_ln_b + lyr * 512 + g * 128 + c8;
            const f32x4 g0 = *(const f32x4*)gp, g1 = *(const f32x4*)(gp + 4), b0 = *(const f32x4*)bp, b1 = *(const f32x4*)(bp + 4);
            f32x4 v0 = {bflo(w.x), bfhi(w.x), bflo(w.y), bfhi(w.y)}, v1 = {bflo(w.z), bfhi(w.z), bflo(w.w), bfhi(w.w)};
            v0 = (v0 - ms.x) * ms.y * g0 + b0; v1 = (v1 - ms.x) * ms.y * g1 + b1;
            *(LAS u32x4*)(lds + GM_V + r * VROW + c8 * 2) = pack8(v0, v1); }
        __syncthreads();
        f32x16 acc[2];
#pragma unroll
        for (int dd = 0; dd < 2; ++dd)
#pragma unroll
            for (int r = 0; r < 16; ++r) acc[dd][r] = 0.f;
        for (int ks = 0; ks < 8; ++ks) {
            if (16 * ks > 32 * tt + 31) break;
            const bf16x8 bw = *(const LAS bf16x8*)(lds + woff + 32 * ks);
#pragma unroll
            for (int dd = 0; dd < 2; ++dd) { const int dt = 2 * dp + dd;
                const s16x4 lo = vtr((const LAS char*)(lds + voff + (16 * ks) * VROW + dt * 64)), hi = vtr((const LAS char*)(lds + voff + (16 * ks + 4) * VROW + dt * 64));
                acc[dd] = __builtin_amdgcn_mfma_f32_32x32x16_bf16(FRAG8(lo, hi), bw, acc[dd], 0, 0, 0); }
        }
        { const int t = 32 * tt + ql; const float bs = P->gmlp_b_s[((size_t)lyr * 4 + g) * 128 + t];
          const bf16_t* up = HB + (R0 + t) * HW + HC_GU + g * 128 + 4 * hh; bf16_t* op = MIX + (R0 + t) * DM + 1024 + g * 128 + 4 * hh;
#pragma unroll
          for (int dd = 0; dd < 2; ++dd)
#pragma unroll
              for (int g4 = 0; g4 < 4; ++g4) { const int d0 = 32 * (2 * dp + dd) + 8 * g4; const u32x2 uw = *(const u32x2*)(up + d0);
                  f32x4 v; v[0] = bflo(uw.x) * (acc[dd][4 * g4 + 0] + bs); v[1] = bfhi(uw.x) * (acc[dd][4 * g4 + 1] + bs); v[2] = bflo(uw.y) * (acc[dd][4 * g4 + 2] + bs); v[3] = bfhi(uw.y) * (acc[dd][4 * g4 + 3] + bs);
                  *(u32x2*)(op + d0) = pack4(v); } }
        __syncthreads();
    }
}

__device__ __forceinline__ int queue_pop(unsigned* q, volatile LAS unsigned* slot) {
    if (opq_tid() == 0) *slot = __hip_atomic_fetch_add(q, 1u, __ATOMIC_RELAXED, __HIP_MEMORY_SCOPE_AGENT);
    __syncthreads();
    const int v = (int)*slot;
    __syncthreads();
    return v;
}
__device__ __forceinline__ void mixer_phase(KP_T P, LAS unsigned char* lds, int lyr) {
    unsigned* ctl = (unsigned*)(P->ws + WS_CTL);
    volatile LAS unsigned* slot = (volatile LAS unsigned*)(lds + LDS_MISC + 8);
    const float lam_init = lyr == 0 ? P->lam_init0 : P->lam_init1;
#ifndef MK_MX
#define MK_MX 7
#endif
    if (MK_MX & 1) for (;;) { const int i = queue_pop(ctl + CW_QUEUE + 192 * lyr, slot); if (i >= 256) break;
        diff_unit(P, lds, lyr, (i & 7) >> 2, i & 3, 31 - (i >> 3), lam_init); }
    if (MK_MX & 2) for (;;) { const int i = queue_pop(ctl + CW_QUEUE + 192 * lyr + 64, slot); if (i >= 512) break;
        mla_unit(P, lds, (i & 15) >> 3, i & 7, 31 - (i >> 4)); }
    if (MK_MX & 4) for (;;) { const int i = queue_pop(ctl + CW_QUEUE + 192 * lyr + 128, slot); if (i >= 256) break;
        gmlp_unit(P, lds, lyr, i >> 5, i & 31); }
}
__device__ __forceinline__ void lnr_phase(KP_T P, LAS unsigned char* lds, int lyr, int vcu, int G) {
    const int tid = opq_tid(), lane = tid & 63, wid = __builtin_amdgcn_readfirstlane(tid >> 6);
    const float* Y1 = (const float*)(P->ws + WS_Y1); float* X1F = (float*)(P->ws + WS_X1F); bf16_t* X1B = (bf16_t*)(P->ws + WS_X1B);
    int* EIDX = (int*)(P->ws + WS_EIDX); float* EW = (float*)(P->ws + WS_EW); int* ELR = (int*)(P->ws + WS_ELR); int* HIST = (int*)(P->ws + WS_HIST);
    LAS float* xs = (LAS float*)lds;
    volatile LAS unsigned long long* selm = (volatile LAS unsigned long long*)(lds + LDS_MISC + 256);
    const float* g1 = P->ln1_g + lyr * DM; const float* b1 = P->ln1_b + lyr * DM;
    const float* rw = P->router_w + (size_t)lyr * DM * NEXP;
    for (int u = vcu; u < RT_UNITS; u += G) {
        const int tok0 = u * RT_TOK;
#pragma unroll
        for (int rr = 0; rr < 2; ++rr) { const int mrow = 2 * wid + rr; const size_t row = (size_t)(tok0 + mrow);
            f32x4 v[8]; float s = 0.f;
#pragma unroll
            for (int j = 0; j < 8; ++j) { v[j] = *(const f32x4*)(Y1 + row * DM + 4 * lane + 256 * j); s += (v[j][0] + v[j][1]) + (v[j][2] + v[j][3]); }
            const float mean = wave_sum(s) * (1.0f / DM); float q = 0.f;
#pragma unroll
            for (int j = 0; j < 8; ++j) { v[j] = v[j] - mean; q += (v[j][0] * v[j][0] + v[j][1] * v[j][1]) + (v[j][2] * v[j][2] + v[j][3] * v[j][3]); }
            const float rstd = rsqrtf(wave_sum(q) * (1.0f / DM) + 1e-5f);
#pragma unroll
            for (int j = 0; j < 8; ++j) { const int col = 4 * lane + 256 * j; const f32x4 gg = *(const f32x4*)(g1 + col), bb = *(const f32x4*)(b1 + col);
                const f32x4 o = v[j] * rstd * gg + bb;
                *(f32x4*)(X1F + row * DM + col) = o; *(u32x2*)(X1B + row * DM + col) = pack4(o);
                *(LAS f32x4*)(xs + mrow * DM + (col ^ (4 * (mrow & 7)))) = o; } }
        __syncthreads();
        f32x4 acc[4];
#pragma unroll
        for (int n = 0; n < 4; ++n) acc[n] = (f32x4){0.f, 0.f, 0.f, 0.f};
        { const int mrow = lane & 15, kq = lane >> 4;
          for (int kk = 0; kk < 64; ++kk) { const int k = 256 * wid + 4 * kk + kq;
              const float a = xs[mrow * DM + (k ^ (4 * (mrow & 7)))];
              const float* bp = rw + (size_t)k * NEXP + (lane & 15);
#pragma unroll
              for (int n = 0; n < 4; ++n) acc[n] = __builtin_amdgcn_mfma_f32_16x16x4f32(a, bp[16 * n], acc[n], 0, 0, 0); } }
        __syncthreads();
        { LAS float* part = xs + wid * (16 * 64);
#pragma unroll
          for (int n = 0; n < 4; ++n)
#pragma unroll
              for (int r = 0; r < 4; ++r) part[(4 * (lane >> 4) + r) * 64 + 16 * n + (lane & 15)] = acc[n][r]; }
        __syncthreads();
#pragma unroll
        for (int rr = 0; rr < 2; ++rr) { const int tk = 2 * wid + rr; float logit = 0.f;
#pragma unroll
            for (int w = 0; w < 8; ++w) logit += xs[w * (16 * 64) + tk * 64 + lane];
            const float score = 1.0f / (1.0f + expf(-logit));
            const float biased = score + P->router_bias[lyr * NEXP + lane];
            float gm = biased; gm = fmaxf(gm, __shfl_xor(gm, 1)); gm = fmaxf(gm, __shfl_xor(gm, 2)); gm = fmaxf(gm, __shfl_xor(gm, 4));
            const unsigned long long bm = __ballot(biased == gm); const unsigned gb = (unsigned)(bm >> (8 * (lane >> 3))) & 0xffu;
            const bool isfirst = (lane & 7) == (__builtin_ctz(gb));
            float g2 = isfirst ? -INFINITY : biased; g2 = fmaxf(g2, __shfl_xor(g2, 1)); g2 = fmaxf(g2, __shfl_xor(g2, 2)); g2 = fmaxf(g2, __shfl_xor(g2, 4));
            const float gs = gm + g2; int rank = 0;
#pragma unroll
            for (int gp = 0; gp < 8; ++gp) { const float o = __shfl(gs, 8 * gp); rank += (o > gs || (o == gs && gp < (lane >> 3))) ? 1 : 0; }
            float v = (rank < 4) ? biased : -INFINITY;
            unsigned long long sm = 0ull;
#pragma unroll
            for (int k = 0; k < TOPK; ++k) { const float mx = wave_max(v); const unsigned long long b2 = __ballot(v == mx); const int f = __builtin_ctzll(b2); sm |= 1ull << f; if (lane == f) v = -INFINITY; }
            const bool chosen = (sm >> lane) & 1ull;
            const float ssum = wave_sum(chosen ? score : 0.f);
            const int kpos = __builtin_popcountll(sm & ((1ull << lane) - 1ull));
            if (chosen) { EIDX[(size_t)(tok0 + tk) * 8 + kpos] = lane; EW[(size_t)(tok0 + tk) * 8 + kpos] = score / ssum * 2.5f; }
            if (lane == 0) selm[tk] = sm; }
        __syncthreads();
#pragma unroll
        for (int rr = 0; rr < 2; ++rr) { const int tk = 2 * wid + rr; const unsigned long long sm = selm[tk];
            if ((sm >> lane) & 1ull) { int lr = 0; for (int t2 = 0; t2 < tk; ++t2) lr += (int)((selm[t2] >> lane) & 1ull);
                ELR[(size_t)(tok0 + tk) * 8 + __builtin_popcountll(sm & ((1ull << lane) - 1ull))] = lr; } }
        if (wid == 0) { int hc = 0; for (int t2 = 0; t2 < RT_TOK; ++t2) hc += (int)((selm[t2] >> lane) & 1ull); HIST[(size_t)u * 64 + lane] = hc; }
        __syncthreads();
    }
}

__device__ __forceinline__ void slot_phase(KP_T P, LAS unsigned char* lds, int vcu, int G) {
    const int tid = opq_tid(), lane = tid & 63, wid = __builtin_amdgcn_readfirstlane(tid >> 6);
    const int* HIST = (const int*)(P->ws + WS_HIST); const int* EIDX = (const int*)(P->ws + WS_EIDX); const float* EW = (const float*)(P->ws + WS_EW); const int* ELR = (const int*)(P->ws + WS_ELR);
    int* EOFF = (int*)(P->ws + WS_EOFF); int* SLOT = (int*)(P->ws + WS_SLOT); int* ROWIDX = (int*)(P->ws + WS_ROWIDX); float* GATEW = (float*)(P->ws + WS_GATEW);
    LAS int* tmp = (LAS int*)lds;
    LAS int* tot = tmp + 512;
    LAS int* off = tot + 64;
    LAS int* base = off + 72;
    { int s = 0; for (int u = wid; u < RT_UNITS; u += 8) s += HIST[(size_t)u * 64 + lane]; tmp[wid * 64 + lane] = s; }
    __syncthreads();
    if (tid < 64) { int s = 0;
#pragma unroll
        for (int w = 0; w < 8; ++w) s += tmp[w * 64 + tid]; tot[tid] = s; }
    __syncthreads();
    if (tid == 0) { int o = 0; for (int e = 0; e < NEXP; ++e) { off[e] = o; o += (tot[e] + 255) & ~255; } off[64] = o; off[65] = o + T; }
    __syncthreads();
    if (vcu == 0 && tid < 67) EOFF[tid] = tid < 66 ? off[tid] : off[65] / 256;
    for (int u = vcu; u < RT_UNITS; u += G) {
        { int s = 0; for (int u2 = wid; u2 < u; u2 += 8) s += HIST[(size_t)u2 * 64 + lane]; tmp[wid * 64 + lane] = s; }
        __syncthreads();
        if (tid < 64) { int s = off[tid];
#pragma unroll
            for (int w = 0; w < 8; ++w) s += tmp[w * 64 + tid]; base[tid] = s; }
        __syncthreads();
        if (tid < RT_TOK * 8) { const size_t i = (size_t)u * (RT_TOK * 8) + tid; const int e = EIDX[i], slot = base[e] + ELR[i];
            SLOT[i] = slot; ROWIDX[slot] = (int)(i >> 3); GATEW[slot] = EW[i]; }
        __syncthreads();
    }
    for (int e = vcu; e < NEXP; e += G) for (int s = off[e] + tot[e] + tid; s < off[e + 1]; s += NTHREADS) { ROWIDX[s] = 0; GATEW[s] = 0.f; }
    for (int t = vcu * NTHREADS + tid; t < T; t += G * NTHREADS) { ROWIDX[off[64] + t] = t; GATEW[off[64] + t] = 1.0f; }
}

__device__ __forceinline__ int moe_tables(KP_T P, LAS unsigned char* lds) {
    const int* EOFF = (const int*)(P->ws + WS_EOFF);
    LAS int* eo = (LAS int*)(lds + LDS_MISC + 512);
    LAS int* t2e = (LAS int*)(lds + LDS_MISC + 1024);
    const int tid = opq_tid();
    if (tid < 67) eo[tid] = EOFF[tid];
    __syncthreads();
    const int ntiles = eo[66];
    for (int mt = tid; mt < ntiles; mt += NTHREADS) { int e = 0; for (int k = 1; k <= NEXP; ++k) e = (mt * 256 >= eo[k]) ? k : e; t2e[mt] = e; }
    __syncthreads();
    return ntiles;
}

__device__ __forceinline__ void combine_phase(KP_T P, int lyr, int vcu, int G) {
    const int tid = opq_tid(), lane = tid & 63, wid = __builtin_amdgcn_readfirstlane(tid >> 6);
    const float* X1F = (const float*)(P->ws + WS_X1F); const bf16_t* YM = (const bf16_t*)(P->ws + WS_YMOE); const int* SLOT = (const int*)(P->ws + WS_SLOT); const int* EOFF = (const int*)(P->ws + WS_EOFF);
    float* XF = (float*)(P->ws + WS_XF); bf16_t* XB = (bf16_t*)(P->ws + WS_XB);
    const float* g2 = P->ln2_g + lyr * DM; const float* b2 = P->ln2_b + lyr * DM;
    const int shoff = EOFF[64];
    for (int tok = vcu * NWAVES + wid; tok < T; tok += G * NWAVES) {
        f32x4 v[4][2];
#pragma unroll
        for (int j = 0; j < 4; ++j) { const float* xp = X1F + (size_t)tok * DM + 8 * lane + 512 * j; v[j][0] = *(const f32x4*)xp * DN_ALPHA; v[j][1] = *(const f32x4*)(xp + 4) * DN_ALPHA; }
#pragma unroll
        for (int k = 0; k < 9; ++k) { const int slot = (k < 8) ? SLOT[(size_t)tok * 8 + k] : shoff + tok; const bf16_t* yp = YM + (size_t)slot * DM + 8 * lane;
#pragma unroll
            for (int j = 0; j < 4; ++j) { const u32x4 w = *(const u32x4*)(yp + 512 * j);
                v[j][0] += (f32x4){bflo(w.x), bfhi(w.x), bflo(w.y), bfhi(w.y)}; v[j][1] += (f32x4){bflo(w.z), bfhi(w.z), bflo(w.w), bfhi(w.w)}; } }
        float s = 0.f;
#pragma unroll
        for (int j = 0; j < 4; ++j)
#pragma unroll
            for (int q = 0; q < 2; ++q) s += (v[j][q][0] + v[j][q][1]) + (v[j][q][2] + v[j][q][3]);
        const float mean = wave_sum(s) * (1.0f / DM); float qq = 0.f;
#pragma unroll
        for (int j = 0; j < 4; ++j)
#pragma unroll
            for (int q = 0; q < 2; ++q) { v[j][q] = v[j][q] - mean; qq += (v[j][q][0] * v[j][q][0] + v[j][q][1] * v[j][q][1]) + (v[j][q][2] * v[j][q][2] + v[j][q][3] * v[j][q][3]); }
        const float rstd = rsqrtf(wave_sum(qq) * (1.0f / DM) + 1e-5f);
#pragma unroll
        for (int j = 0; j < 4; ++j) { const int col = 8 * lane + 512 * j;
            const f32x4 o0 = v[j][0] * rstd * *(const f32x4*)(g2 + col) + *(const f32x4*)(b2 + col), o1 = v[j][1] * rstd * *(const f32x4*)(g2 + col + 4) + *(const f32x4*)(b2 + col + 4);
            if (lyr == NLAYER - 1) { *(f32x4*)(P->out + (size_t)tok * DM + col) = o0; *(f32x4*)(P->out + (size_t)tok * DM + col + 4) = o1; }
            else { *(f32x4*)(XF + (size_t)tok * DM + col) = o0; *(f32x4*)(XF + (size_t)tok * DM + col + 4) = o1; *(u32x4*)(XB + (size_t)tok * DM + col) = pack8(o0, o1); } }
    }
}
#ifndef MK_EN
#define MK_EN 0x3ff
#endif
#define EN(k) ((MK_EN >> (k)) & 1)
__global__ void __launch_bounds__(NTHREADS, 2) fwd(Params Parg) {
    extern __shared__ __attribute__((aligned(16))) unsigned char lds_raw[];
    LAS unsigned char* lds0 = (LAS unsigned char*)lds_raw;
    KP_T KP = (KP_T)__builtin_amdgcn_kernarg_segment_ptr();
    const int tid = threadIdx.x, G0 = gridDim.x, bx0 = blockIdx.x;
    const int vcu0 = (G0 % 8 == 0) ? (bx0 % 8) * (G0 / 8) + bx0 / 8 : bx0;
    for (int i = tid; i < (LDS_BYTES - LDS_MISC) / 4; i += NTHREADS) ((LAS unsigned*)(lds0 + LDS_MISC))[i] = 0u;
    __syncthreads();
    const int ph_lo = KP->ph_lo, ph_hi = KP->ph_hi, use_bar = KP->use_bar;
    XcdBarrier bar; bar.bar = (unsigned*)(KP->ws + WS_CTL) + CW_BAR; bar.x = 0; bar.st = (volatile LAS unsigned*)(lds0 + LDS_MISC);
    if (use_bar) bar = xcd_barrier_post(bar.bar, (volatile LAS unsigned*)(lds0 + LDS_MISC));
#define IN(k) (ph_lo <= (k) && (k) < ph_hi)
#define PHASE_BEGIN() KP_T P = KP; int G = G0, bx = bx0, vcu = vcu0, l = l0; unsigned lo_ = 0u; asm volatile("" : "+s"(P), "+s"(G), "+s"(bx), "+s"(vcu), "+s"(lo_), "+s"(l)); LAS unsigned char* lds = lds0 + lo_; (void)G; (void)bx; (void)vcu; (void)lds; (void)l
#define SEAM(k) do { if (IN(k) && IN((k) + 1) && use_bar) xcd_barrier(bar); } while (0)

    { const int l0 = 0; if (EN(0) && IN(PH_PRO)) { PHASE_BEGIN(); prologue_phase(P, lds, vcu, G); } }
    SEAM(PH_PRO);
    for (int l0 = 0; l0 < NLAYER; ++l0) {
        const int pb = PH_L0 + PHL_N * l0;
        if (EN(1) && IN(pb + PHL_G1)) {
            PHASE_BEGIN(); unsigned char* ws = P->ws;
            SchedDense S{DM, DM, T / 256, HW / 256, G, bx};
            Epi1 E{(bf16_t*)(ws + WS_HB), (float*)(ws + WS_RSS), (bf16_t*)(ws + WS_KB), (const float*)(ws + WS_ROPE), (const float*)(ws + WS_ROPE) + SEQ * 32};
            pg8::gemm_phase<Epi1, SchedDense, false>(lds, (const char*)(ws + WS_XB), (const char*)(ws + WS_WIN + l * SZ_WIN), nullptr, DM, DM, S, E);
        }
        SEAM(pb + PHL_G1);
        if (EN(2) && IN(pb + PHL_G2)) {
            PHASE_BEGIN(); unsigned char* ws = P->ws;
            { SchedDense S{HW, 512, T / 256, 1536 / 256, G, bx};
              Epi2 E{0, (const float*)(ws + WS_RSS), (bf16_t*)(ws + WS_QB), (bf16_t*)(ws + WS_KB), (bf16_t*)(ws + WS_VB), (const float*)(ws + WS_ROPE), (const float*)(ws + WS_ROPE) + SEQ * 32};
              pg8::gemm_phase<Epi2, SchedDense, false>(lds, (const char*)(ws + WS_HB) + HC_CQ * 2, (const char*)(ws + WS_WUQ + l * SZ_WUQ), nullptr, 512, HW, S, E); }
            { SchedDense S{HW, 256, T / 256, 2048 / 256, G, (bx + 64) % G};
              Epi2 E{1, (const float*)(ws + WS_RSS), (bf16_t*)(ws + WS_QB), (bf16_t*)(ws + WS_KB), (bf16_t*)(ws + WS_VB), (const float*)(ws + WS_ROPE), (const float*)(ws + WS_ROPE) + SEQ * 32};
              pg8::gemm_phase<Epi2, SchedDense, false>(lds, (const char*)(ws + WS_HB) + HC_CKV * 2, (const char*)(ws + WS_WUKV + l * SZ_WUKV), nullptr, 256, HW, S, E); }
        }
        SEAM(pb + PHL_G2);
        if (EN(3) && IN(pb + PHL_MIX)) { PHASE_BEGIN(); mixer_phase(P, lds, l); }
        SEAM(pb + PHL_MIX);
        if (EN(4) && IN(pb + PHL_WO)) {
            PHASE_BEGIN(); unsigned char* ws = P->ws;
            SchedDense S{DM, DM, T / 256, DM / 256, G, bx};
            EpiWO E{l == 0 ? P->x : (const float*)(ws + WS_XF), (float*)(ws + WS_Y1)};
            pg8::gemm_phase<EpiWO, SchedDense, false>(lds, (const char*)(ws + WS_MIX), (const char*)(ws + WS_WO + l * SZ_WO), nullptr, DM, DM, S, E);
        }
        SEAM(pb + PHL_WO);
        if (EN(5) && IN(pb + PHL_LNR)) { PHASE_BEGIN(); lnr_phase(P, lds, l, vcu, G); }
        SEAM(pb + PHL_LNR);
        if (EN(6) && IN(pb + PHL_SLOT)) { PHASE_BEGIN(); slot_phase(P, lds, vcu, G); }
        SEAM(pb + PHL_SLOT);
        if (EN(7) && IN(pb + PHL_GU)) {
            PHASE_BEGIN(); unsigned char* ws = P->ws;
            const int ntiles = moe_tables(P, lds);
            SchedMoE S{(const LAS int*)(lds + LDS_MISC + 1024), (unsigned)SZ_WGU1, 0, DM, 4, ntiles * 4, G, vcu};
            EpiGU E{(const float*)(ws + WS_GATEW), (bf16_t*)(ws + WS_HMOE)};
            pg8::gemm_phase<EpiGU, SchedMoE, true>(lds, (const char*)(ws + WS_X1B), (const char*)(ws + WS_WGU + l * SZ_WGU), (const int*)(ws + WS_ROWIDX), DM, DM, S, E);
        }
        SEAM(pb + PHL_GU);
        if (EN(8) && IN(pb + PHL_DN)) {
            PHASE_BEGIN(); unsigned char* ws = P->ws;
            const int ntiles = moe_tables(P, lds);
            SchedMoE S{(const LAS int*)(lds + LDS_MISC + 1024), (unsigned)SZ_WD1, EDIM * 2, EDIM, 8, ntiles * 8, G, vcu};
            EpiDN E{(bf16_t*)(ws + WS_YMOE)};
            pg8::gemm_phase<EpiDN, SchedMoE, false>(lds, (const char*)(ws + WS_HMOE), (const char*)(ws + WS_WD + l * SZ_WD), nullptr, EDIM, EDIM, S, E);
        }
        SEAM(pb + PHL_DN);
        if (EN(9) && IN(pb + PHL_CMB)) { PHASE_BEGIN(); combine_phase(P, l, vcu, G); }
        SEAM(pb + PHL_CMB);
    }
#undef IN
#undef SEAM
}
#ifndef MK_MULTI
#define MK_MULTI 0
#endif
extern "C" void kernel_launch(void* const* d_in, const int* in_sizes, int n_in, void* d_out, int out_size, void* d_ws, size_t ws_size, hipStream_t stream) {
    static int grid = 0;
    if (grid == 0) {
        if (n_in != 29 || out_size != T * DM || ws_size < WS_END) { fprintf(stderr, "kernel_launch: unexpected shapes (n_in %d, out %d, ws %zu < %zu)\n", n_in, out_size, ws_size, (size_t)WS_END); grid = -1; return; }
        int dev = 0, cus = 0, per_cu = 0;
        if (hipGetDevice(&dev) != hipSuccess || hipDeviceGetAttribute(&cus, hipDeviceAttributeMultiprocessorCount, dev) != hipSuccess) { grid = -1; return; }
        if (hipFuncSetAttribute((const void*)fwd, hipFuncAttributeMaxDynamicSharedMemorySize, LDS_BYTES) != hipSuccess) { fprintf(stderr, "kernel_launch: hipFuncSetAttribute failed\n"); grid = -1; return; }
        if (hipOccupancyMaxActiveBlocksPerMultiprocessor(&per_cu, (const void*)fwd, NTHREADS, LDS_BYTES) != hipSuccess || per_cu < 1) { fprintf(stderr, "kernel_launch: occupancy query says %d\n", per_cu); }
        (void)hipGetLastError();
        grid = cus;
    }
    if (grid < 0) return;
    (void)hipMemsetAsync((char*)d_ws + WS_CTL, 0, CTL_ZERO_BYTES, stream);
    Params p{};
    const float** f = (const float**)&p;
    for (int i = 0; i < 29; ++i) f[i] = (const float*)d_in[i];
    p.out = (float*)d_out; p.ws = (unsigned char*)d_ws; p.dbg = 0;
    p.lam_init0 = (float)(0.8 - 0.6 * exp(-0.3 * 0.0)); p.lam_init1 = (float)(0.8 - 0.6 * exp(-0.3 * 1.0));
#if MK_MULTI
    for (int ph = 0; ph < PH_END; ++ph) {
        p.ph_lo = ph; p.ph_hi = ph + 1; p.use_bar = 0;
        hipLaunchKernelGGL(fwd, dim3(grid), dim3(NTHREADS), LDS_BYTES, stream, p);
#if MK_DBG
        dbg_after_phase(p, ph, stream);
#endif
    }
#if MK_DBG
    hipLaunchKernelGGL(dbg_report, dim3(256), dim3(256), 0, stream, p);
#endif
#else
    p.ph_lo = 0; p.ph_hi = PH_END; p.use_bar = 1;
    hipLaunchKernelGGL(fwd, dim3(grid), dim3(NTHREADS), LDS_BYTES, stream, p);
#endif
}
```

```cpp
#include <hip/hip_runtime.h>
#include <cstdio>
#include <cstdint>
#include <cmath>

#define LAS __attribute__((address_space(3)))
#define GAS __attribute__((address_space(1)))
typedef unsigned short bf16_t;
typedef short bf16x8 __attribute__((ext_vector_type(8)));
typedef short s16x4 __attribute__((ext_vector_type(4)));
typedef float f32x2 __attribute__((ext_vector_type(2)));
typedef float f32x4 __attribute__((ext_vector_type(4)));
typedef float f32x16 __attribute__((ext_vector_type(16)));
typedef unsigned u32x2 __attribute__((ext_vector_type(2)));
typedef unsigned u32x4 __attribute__((ext_vector_type(4)));
typedef __bf16 bf16x2_t __attribute__((ext_vector_type(2)));

constexpr int NB = 2, SEQ = 4096, T = NB * SEQ, DM = 2048, NLAYER = 2;
constexpr int IN_W = 3392;
constexpr int HW = 3584;
constexpr int HC_CQ = 0, HC_CKV = 512, HC_GU = 768, HC_GV = 1280, HC_DQ = 1792, HC_DK = 2304, HC_DV = 2816, HC_KR = 3328;
constexpr int NEXP = 64, NEXP1 = 65, EDIM = 512, TOPK = 8;
constexpr int MAXTILES = 352, NSLOT = MAXTILES * 256;
constexpr int NWAVES = 8, NTHREADS = 512;
constexpr float LOG2E = 1.4426950408889634f;
constexpr float DN_ALPHA = 1.4142135623730951f;
constexpr int RT_TOK = 16, RT_UNITS = T / RT_TOK;

__device__ __forceinline__ unsigned cvtpk(float lo, float hi) { f32x2 v = {lo, hi}; bf16x2_t b = __builtin_convertvector(v, bf16x2_t); return __builtin_bit_cast(unsigned, b); }
__device__ __forceinline__ float bf2f(unsigned short h) { return __uint_as_float(((unsigned)h) << 16); }
__device__ __forceinline__ float bflo(unsigned w) { return __uint_as_float(w << 16); }
__device__ __forceinline__ float bfhi(unsigned w) { return __uint_as_float(w & 0xffff0000u); }
__device__ __forceinline__ float wave_sum(float v) {
#pragma unroll
    for (int o = 1; o < 64; o <<= 1) v += __shfl_xor(v, o);
    return v;
}
__device__ __forceinline__ float wave_max(float v) {
#pragma unroll
    for (int o = 1; o < 64; o <<= 1) v = fmaxf(v, __shfl_xor(v, o));
    return v;
}
__device__ __forceinline__ float gelu_tanh(float x) {
    const float u = 0.7978845608028654f * (x + 0.044715f * x * x * x);
    const float e = __builtin_amdgcn_exp2f(u * (2.0f * LOG2E));
    const float th = 1.0f - 2.0f * __builtin_amdgcn_rcpf(e + 1.0f);
    return 0.5f * x * (1.0f + th);
}
__device__ __forceinline__ float sigmoidf_(float x) { return __builtin_amdgcn_rcpf(1.0f + __builtin_amdgcn_exp2f(-LOG2E * x)); }
__device__ __forceinline__ int opq_tid() { int t = threadIdx.x; asm volatile("" : "+v"(t)); return t; }
#define LDS_WAIT() asm volatile("s_waitcnt lgkmcnt(0)" ::: "memory")
#define VM_WAIT() asm volatile("s_waitcnt vmcnt(0)" ::: "memory")

#define XB_TMO      128
#define XB_XCNT(j)  (256  + 64 * (j))
#define XB_XSUB(j)  (1280 + 64 * (j))
#define XB_XGEN(j)  (2304 + 64 * (j))
#define XB_TOP      3328
#define XB_TOPGEN   3392
#define XCD_BAR_WORDS 3456
#define XB_SPIN_CAP (1u << 18)
__device__ __forceinline__ unsigned xb_ld(unsigned* p)              { return __hip_atomic_load(p, __ATOMIC_RELAXED, __HIP_MEMORY_SCOPE_AGENT); }
__device__ __forceinline__ unsigned xb_add(unsigned* p, unsigned v) { return __hip_atomic_fetch_add(p, v, __ATOMIC_RELAXED, __HIP_MEMORY_SCOPE_AGENT); }
__device__ __forceinline__ unsigned xb_xcc_id() { return (unsigned)__builtin_amdgcn_s_getreg((3 << 11) | 20) & 0xFu; }
#define XB_SPIN(cond, bar) do { unsigned _sp = 0; while (cond) { __builtin_amdgcn_s_sleep(1); \
    if ((++_sp & 255u) == 0u) { if (xb_ld(&(bar)[XB_TMO])) break; if (_sp > XB_SPIN_CAP) { atomicAdd(&(bar)[XB_TMO], 1u); break; } } } } while (0)
struct XcdBarrier { unsigned* bar; unsigned x; volatile LAS unsigned* st; };
__device__ __forceinline__ XcdBarrier xcd_barrier_post(unsigned* bar, volatile LAS unsigned* st) {
    XcdBarrier b; b.bar = bar; b.x = xb_xcc_id(); b.st = st;
    if (threadIdx.x == 0) (void)xb_add(&bar[XB_XCNT(b.x)], 1u);
    return b;
}
__device__ __forceinline__ void xcd_barrier_complete(unsigned* bar, unsigned x, unsigned& nloc, unsigned& nx) {
    const unsigned G = gridDim.x * gridDim.y * gridDim.z;
    unsigned sum, cnt, mine, sp = 0u;
    for (;;) {
        sum = 0u; cnt = 0u; mine = 0u;
#pragma unroll 1
        for (unsigned j = 0; j < 16; ++j) { const unsigned c = xb_ld(&bar[XB_XCNT(j)]); sum += c; cnt += (c > 0u) ? 1u : 0u; mine = (j == x) ? c : mine; }
        if (sum == G) break;
        __builtin_amdgcn_s_sleep(1);
        if ((++sp & 255u) == 0u) { if (xb_ld(&bar[XB_TMO])) break; if (sp > XB_SPIN_CAP) { atomicAdd(&bar[XB_TMO], 1u); break; } }
    }
    nloc = mine > 0u ? mine : 1u; nx = cnt > 0u ? cnt : 1u;
}
__device__ __forceinline__ void xcd_barrier(const XcdBarrier& b) {
    asm volatile("s_waitcnt vmcnt(0)" ::: "memory");
    __syncthreads();
    if (threadIdx.x == 0) {
        unsigned* bar = b.bar; asm volatile("" : "+s"(bar));
        __builtin_amdgcn_s_waitcnt(0);
        volatile LAS unsigned* st = b.st; asm volatile("" : "+s"(st));
        unsigned nloc = st[0], nx = st[1];
        if (nloc == 0u) { xcd_barrier_complete(bar, b.x, nloc, nx); st[0] = nloc; st[1] = nx; }
        const unsigned old = xb_add(&bar[XB_XSUB(b.x)], 1u);
        const unsigned gen = old / nloc;
        if (old + 1u == (gen + 1u) * nloc) {
            __builtin_amdgcn_fence(__ATOMIC_RELEASE, "agent");
            asm volatile("s_waitcnt vmcnt(0)" ::: "memory");
            const unsigned og = xb_add(&bar[XB_TOP], 1u);
            const unsigned tg = og / nx;
            if (og + 1u == (tg + 1u) * nx) xb_add(&bar[XB_TOPGEN], 1u);
            else XB_SPIN(xb_ld(&bar[XB_TOPGEN]) == tg, bar);
            __builtin_amdgcn_fence(__ATOMIC_ACQUIRE, "agent");
            xb_add(&bar[XB_XGEN(b.x)], 1u);
            asm volatile("s_waitcnt vmcnt(0)" ::: "memory");
        } else {
            XB_SPIN(xb_ld(&bar[XB_XGEN(b.x)]) == gen, bar);
            __builtin_amdgcn_fence(__ATOMIC_ACQUIRE, "agent");
            asm volatile("s_waitcnt vmcnt(0)" ::: "memory");
        }
    }
    __syncthreads();
}

namespace pg8 {
constexpr int BM = 256, BK = 64, HALF = 128, HTB = HALF * BK * 2, STAGE_BYTES = 8 * HTB, NXCD = 8, WGM = 8;
__host__ __device__ __forceinline__ int lds_byte(int r, int c) { const int st = (r >> 4) * 2 + (c >> 5), rr = r & 15, cc = c & 31, ob = rr * 64 + cc * 2; return st * 1024 + (ob ^ (((ob >> 9) & 1) << 5)); }
__host__ __device__ __forceinline__ void stage_rc(int b, int& R, int& C) { const int st = b / 1024, sb = b % 1024, swz = sb ^ (((sb >> 9) & 1) << 5); R = (st >> 1) * 16 + swz / 64; C = (st & 1) * 32 + (swz % 64) / 2; }
__host__ __device__ __forceinline__ int perm32(int rho) { const int n = rho >> 4, i = rho & 15; return 8 * (i >> 2) + 4 * n + (i & 3); }

struct Unit { unsigned a, b; int r0, pn, half; };

__device__ __forceinline__ bool dense_tile(int i, int G, int c, int nM, int nN, int& pm, int& pn) {
    const int nwg = nM * nN; const long L = (long)i * G + c; if (L >= nwg) return false;
    int wgid = (int)L; { const int q = nwg / NXCD, r = nwg % NXCD, xcd = wgid % NXCD, off = wgid / NXCD; wgid = (xcd < r ? xcd * (q + 1) : r * (q + 1) + (xcd - r) * q) + off; }
    const int nig = WGM * nN, gid = wgid / nig, fm = gid * WGM, gsz = (nM - fm) < WGM ? (nM - fm) : WGM;
    pm = fm + ((wgid % nig) % gsz); pn = (wgid % nig) / gsz; return true;
}

template <class Epi, class Sched, bool GATHER, bool ALIGN_EPI = true>
__device__ __forceinline__ void gemm_phase(unsigned long long* gst, LAS unsigned char* lds, const char* Ab, const char* Bb, const LAS int* rowidx, const int K, const int lda, const int ldb, const Sched& S, const Epi& E) {
    const int tid = opq_tid(), wid = __builtin_amdgcn_readfirstlane(tid >> 6), lane = tid & 63, wr = wid >> 2, wc = wid & 3, fr = lane & 15, fq = lane >> 4;
    const int nt = K / BK;
    int Rr[2], Cc[2];
    unsigned voffA[2][2], voffB[2];
#pragma unroll
    for (int i = 0; i < 2; ++i) { int R, C; stage_rc(tid * 16 + i * 8192, R, C); Rr[i] = R; Cc[i] = C; const int Rb = Epi::PERM ? ((R & ~31) + perm32(R & 31)) : R;
        voffB[i] = (unsigned)(Rb * ldb + C) * 2u;
        voffA[0][i] = (unsigned)(R * lda + C) * 2u; voffA[1][i] = (unsigned)((R + HALF) * lda + C) * 2u; }
    const size_t kstep = (size_t)(BK * 2);
    const size_t hstepB = (size_t)HALF * ldb * 2;
    const unsigned ldsw = (unsigned)wid * 1024u;
    const int aoff = lds_byte(wr * 64 + fr, fq * 8), boff = lds_byte(wc * 32 + fr, fq * 8);
#define PG8_SA(b, h) (((b) * 2 + (h)) * HTB)
#define PG8_SB(b, h) ((4 + (b) * 2 + (h)) * HTB)
#define PG8_STAGE(bufoff, gbase, voff) do { _Pragma("unroll") for (int _i = 0; _i < 2; ++_i) \
        __builtin_amdgcn_global_load_lds((const unsigned*)((const char*)(gbase) + (voff)[_i]), (LAS unsigned*)(lds + (bufoff) + ldsw + _i * 8192), 16, 0, 0); } while (0)
#define PG8_LDA(dst, b, h) do { _Pragma("unroll") for (int m = 0; m < 4; ++m) _Pragma("unroll") for (int k = 0; k < 2; ++k) dst[m][k] = *(const LAS bf16x8*)(lds + PG8_SA(b, h) + aoff + m * 2048 + k * 1024); } while (0)
#define PG8_LDB(dst, b, h) do { _Pragma("unroll") for (int n = 0; n < 2; ++n) _Pragma("unroll") for (int k = 0; k < 2; ++k) dst[n][k] = *(const LAS bf16x8*)(lds + PG8_SB(b, h) + boff + n * 2048 + k * 1024); } while (0)
#define PG8_MMA(ai, bj, At, Bt) do { __builtin_amdgcn_s_setprio(1); _Pragma("unroll") for (int m = 0; m < 4; ++m) _Pragma("unroll") for (int n = 0; n < 2; ++n) _Pragma("unroll") for (int k = 0; k < 2; ++k) \
        acc[ai][bj][m][n] = __builtin_amdgcn_mfma_f32_16x16x32_bf16(Bt[n][k], At[m][k], acc[ai][bj][m][n], 0, 0, 0); __builtin_amdgcn_s_setprio(0); } while (0)
#define PG8_WAIT_V(n) asm volatile("s_waitcnt vmcnt(" #n ")" ::: "memory")
#define PG8_WAIT_L(n) asm volatile("s_waitcnt lgkmcnt(" #n ")" ::: "memory")
#define PG8_BAR __builtin_amdgcn_s_barrier()
#define PG8_SCHED __builtin_amdgcn_sched_barrier(0)
    Unit cur, nxt; int ui = 0;
    if (!S.next(0, cur)) return;
    if constexpr (GATHER) {
#pragma unroll
        for (int h = 0; h < 2; ++h)
#pragma unroll
            for (int i = 0; i < 2; ++i) voffA[h][i] = (unsigned)(rowidx[h * HALF + Rr[i]] * lda + Cc[i]) * 2u;
    }
    f32x4 acc[2][2][4][2];
#pragma unroll
    for (int a = 0; a < 2; ++a)
#pragma unroll
        for (int b = 0; b < 2; ++b)
#pragma unroll
            for (int m = 0; m < 4; ++m)
#pragma unroll
                for (int n = 0; n < 2; ++n) acc[a][b][m][n] = (f32x4){0.f, 0.f, 0.f, 0.f};
    bf16x8 At[4][2], B0[2][2], B1[2][2];
    const char* cA = Ab + cur.a; const char* cB = Bb + cur.b;
    PG8_STAGE(PG8_SB(0, 0), cB, voffB); PG8_STAGE(PG8_SB(0, 1), cB + hstepB, voffB); PG8_STAGE(PG8_SA(0, 0), cA, voffA[0]); PG8_STAGE(PG8_SA(0, 1), cA, voffA[1]);
    if (wr == 1) PG8_BAR;
    PG8_WAIT_V(2); PG8_BAR;
    PG8_STAGE(PG8_SB(1, 0), cB + kstep, voffB); PG8_STAGE(PG8_SA(1, 0), cA + kstep, voffA[0]); PG8_STAGE(PG8_SB(1, 1), cB + hstepB + kstep, voffB);
    PG8_WAIT_V(6); PG8_BAR;
    unsigned long long gt0 = gst ? __builtin_amdgcn_s_memrealtime() : 0ull;
#define GST(k) do { if (gst) { const unsigned long long t1_ = __builtin_amdgcn_s_memrealtime(); gst[k] += t1_ - gt0; gt0 = t1_; } } while (0)
    for (;;) {
        const bool has_next = S.next(ui + 1, nxt);
        GST(1);
        const char* nA = has_next ? Ab + nxt.a : cA; const char* nB = has_next ? Bb + nxt.b : cB;
        unsigned nvoff[2][2];
#pragma unroll
        for (int h = 0; h < 2; ++h)
#pragma unroll
            for (int i = 0; i < 2; ++i) nvoff[h][i] = voffA[h][i];
        if constexpr (GATHER) {
            if (has_next) {
#pragma unroll
                for (int h = 0; h < 2; ++h)
#pragma unroll
                    for (int i = 0; i < 2; ++i) nvoff[h][i] = (unsigned)(rowidx[(ui + 1) * 256 + h * HALF + Rr[i]] * lda + Cc[i]) * 2u;
            }
        }
        for (int t = 0; t < nt; t += 2) {
            const bool last = (t == nt - 2);
            const char* a1 = cA + (size_t)(t + 1) * kstep;
            const char* a2 = last ? nA : cA + (size_t)(t + 2) * kstep; const char* b2 = last ? nB : cB + (size_t)(t + 2) * kstep;
            const char* a3 = a2 + kstep; const char* b3 = b2 + kstep;
            unsigned v2[2][2];
#pragma unroll
            for (int h = 0; h < 2; ++h)
#pragma unroll
                for (int i = 0; i < 2; ++i) v2[h][i] = (GATHER && last) ? nvoff[h][i] : voffA[h][i];
            PG8_LDB(B0, 0, 0); PG8_LDB(B1, 0, 1); PG8_SCHED; PG8_LDA(At, 0, 0); PG8_STAGE(PG8_SA(1, 1), a1, voffA[1]);
            PG8_WAIT_V(8); PG8_WAIT_L(0); PG8_BAR; PG8_MMA(0, 0, At, B0); PG8_MMA(0, 1, At, B1); PG8_BAR; PG8_SCHED;
            PG8_LDA(At, 0, 1); PG8_STAGE(PG8_SB(0, 0), b2, voffB); PG8_STAGE(PG8_SB(0, 1), b2 + hstepB, voffB); PG8_STAGE(PG8_SA(0, 0), a2, v2[0]);
            PG8_WAIT_V(8); PG8_WAIT_L(0); PG8_BAR; if (!cur.half) { PG8_MMA(1, 0, At, B0); PG8_MMA(1, 1, At, B1); } PG8_BAR; PG8_SCHED;
            PG8_LDB(B0, 1, 0); PG8_LDB(B1, 1, 1); PG8_SCHED; PG8_LDA(At, 1, 0); PG8_STAGE(PG8_SA(0, 1), a2, v2[1]);
            PG8_WAIT_V(8); PG8_WAIT_L(0); PG8_BAR; PG8_MMA(0, 0, At, B0); PG8_MMA(0, 1, At, B1); PG8_BAR; PG8_SCHED;
            PG8_LDA(At, 1, 1); PG8_STAGE(PG8_SB(1, 0), b3, voffB); PG8_STAGE(PG8_SB(1, 1), b3 + hstepB, voffB); PG8_STAGE(PG8_SA(1, 0), a3, v2[0]);
            PG8_WAIT_V(8); PG8_WAIT_L(0); PG8_BAR; if (!cur.half) { PG8_MMA(1, 0, At, B0); PG8_MMA(1, 1, At, B1); } PG8_BAR; PG8_SCHED;
        }
        GST(0);
        if constexpr (ALIGN_EPI) { if (wr == 0) PG8_BAR; }
        E(acc, cur.r0, cur.pn, cur.half, wr, wc, fr, fq);
        if (!has_next) break;
#pragma unroll
        for (int a = 0; a < 2; ++a)
#pragma unroll
            for (int b = 0; b < 2; ++b)
#pragma unroll
                for (int m = 0; m < 4; ++m)
#pragma unroll
                    for (int n = 0; n < 2; ++n) acc[a][b][m][n] = (f32x4){0.f, 0.f, 0.f, 0.f};
        cur = nxt; cA = nA; cB = nB; ++ui;
#pragma unroll
        for (int h = 0; h < 2; ++h)
#pragma unroll
            for (int i = 0; i < 2; ++i) voffA[h][i] = nvoff[h][i];
        if constexpr (ALIGN_EPI) { if (wr == 1) PG8_BAR; }
    }
    PG8_WAIT_V(0);
    if constexpr (!ALIGN_EPI) { if (wr == 0) PG8_BAR; }
    PG8_BAR;
#undef PG8_SA
#undef PG8_SB
#undef PG8_STAGE
#undef PG8_LDA
#undef PG8_LDB
#undef PG8_MMA
#undef PG8_WAIT_V
#undef PG8_WAIT_L
#undef PG8_BAR
#undef PG8_SCHED
}
}
#define MK_MULTI 0
#define MK_DBG 0
struct Params {
    const float *x, *rel_bias, *w_in, *mla_q_norm, *mla_w_uq, *mla_kv_norm, *mla_w_ukv, *gmlp_ln_g, *gmlp_ln_b, *gmlp_w_s, *gmlp_b_s,
                *diff_lq1, *diff_lk1, *diff_lq2, *diff_lk2, *diff_subln, *w_o, *ln1_g, *ln1_b, *router_w, *router_bias,
                *exp_w_gate, *exp_w_up, *exp_w_down, *shared_w_gate, *shared_w_up, *shared_w_down, *ln2_g, *ln2_b;
    float* out;
    unsigned char* ws;
    int ph_lo, ph_hi;
    int use_bar;
    int dbg;
    float lam_init0, lam_init1;
};

typedef const __attribute__((address_space(4))) Params* KP_T;
#define OPQ(p) asm volatile("" : "+s"(p))
constexpr size_t al256(size_t x) { return (x + 255) & ~(size_t)255; }
constexpr size_t WS_CTL = 0, CTL_ZERO_BYTES = 65536;
constexpr size_t WS_ROPE = 1u << 20;
constexpr size_t SZ_ROPE = (size_t)SEQ * 32 * 4 * 2;
constexpr size_t WS_WIN = al256(WS_ROPE + SZ_ROPE);
constexpr size_t SZ_WIN = (size_t)HW * DM * 2;
constexpr size_t WS_WUQ = al256(WS_WIN + NLAYER * SZ_WIN);
constexpr size_t SZ_WUQ = (size_t)1536 * 512 * 2;
constexpr size_t WS_WUKV = al256(WS_WUQ + NLAYER * SZ_WUQ);
constexpr size_t SZ_WUKV = (size_t)2048 * 256 * 2;
constexpr size_t WS_WO = al256(WS_WUKV + NLAYER * SZ_WUKV);
constexpr size_t SZ_WO = (size_t)DM * DM * 2;
constexpr size_t WS_WGU = al256(WS_WO + NLAYER * SZ_WO);
constexpr int WGSTR = DM + 64, WDSTR = 512 + 64, XSTR = DM + 64;
constexpr size_t SZ_WGU1 = (size_t)1024 * WGSTR * 2, SZ_WGU = NEXP1 * SZ_WGU1;
constexpr size_t WS_WD = al256(WS_WGU + NLAYER * SZ_WGU);
constexpr size_t SZ_WD1 = (size_t)DM * WDSTR * 2, SZ_WD = NEXP1 * SZ_WD1;
constexpr size_t WS_XB = al256(WS_WD + NLAYER * SZ_WD);
constexpr size_t WS_XF = al256(WS_XB + (size_t)T * DM * 2);
constexpr size_t WS_HB = al256(WS_XF + (size_t)T * DM * 4);
constexpr size_t WS_RSS = al256(WS_HB + (size_t)T * HW * 2);
constexpr size_t WS_QB = al256(WS_RSS + (size_t)T * 12 * 4);
constexpr size_t WS_KB = al256(WS_QB + (size_t)T * 8 * 192 * 2);
constexpr size_t WS_VB = al256(WS_KB + (size_t)T * 8 * 192 * 2);
constexpr size_t WS_MIX = al256(WS_VB + (size_t)T * 8 * 128 * 2);
constexpr size_t WS_Y1 = al256(WS_MIX + (size_t)T * DM * 2);
constexpr size_t WS_X1F = al256(WS_Y1 + (size_t)T * DM * 4);
constexpr size_t WS_RTR = WS_X1F;
constexpr size_t WS_X1B = al256(WS_X1F + (size_t)T * DM * 4);
constexpr size_t WS_EIDX = al256(WS_X1B + (size_t)T * XSTR * 2);
constexpr size_t WS_EW = al256(WS_EIDX + (size_t)T * 8 * 4);
constexpr size_t WS_ELR = al256(WS_EW + (size_t)T * 8 * 4);
constexpr size_t WS_HIST = al256(WS_ELR + (size_t)T * 8 * 4);
constexpr size_t WS_EOFF = al256(WS_HIST + (size_t)RT_UNITS * 64 * 4);
constexpr size_t WS_SLOT = al256(WS_EOFF + 160 * 4);
constexpr size_t WS_ROWIDX = al256(WS_SLOT + (size_t)T * 8 * 4);
constexpr size_t WS_GATEW = al256(WS_ROWIDX + (size_t)NSLOT * 4);
constexpr size_t WS_HMOE = al256(WS_GATEW + (size_t)NSLOT * 4);
constexpr int HSTR = EDIM + 64;
constexpr size_t WS_YMOE = al256(WS_HMOE + (size_t)NSLOT * HSTR * 2);
constexpr size_t WS_END = al256(WS_YMOE + (size_t)NSLOT * DM);
constexpr int CW_BAR = 4096;
constexpr int CW_QUEUE = 8192;
constexpr int CW_ERR = 9216;

constexpr int LDS_STAGE = 131072;
constexpr int LDS_MISC = LDS_STAGE;
constexpr int LDS_GIDX = LDS_MISC + 4096;
constexpr int LDS_BYTES = LDS_STAGE + 4096 + 8192;

enum { PH_PRO = 0, PH_L0 = 1, PHL_G1 = 0, PHL_G2 = 1, PHL_MIX = 2, PHL_WO = 3, PHL_LNR = 4, PHL_SLOT = 5, PHL_GU = 6, PHL_DN = 7, PHL_CMB = 8, PHL_N = 9, PH_END = 1 + 2 * PHL_N };
using pg8::Unit;
typedef const f32x4 (&AccRef)[2][2][4][2];

__device__ __forceinline__ u32x4 pack8(f32x4 v0, f32x4 v1) { u32x4 w; w.x = cvtpk(v0[0], v0[1]); w.y = cvtpk(v0[2], v0[3]); w.z = cvtpk(v1[0], v1[1]); w.w = cvtpk(v1[2], v1[3]); return w; }
__device__ __forceinline__ u32x2 pack4(f32x4 v) { u32x2 w; w.x = cvtpk(v[0], v[1]); w.y = cvtpk(v[2], v[3]); return w; }

struct Epi1 {
    static constexpr bool PERM = true;
    bf16_t* HB; float* RSS; bf16_t* KB; const float* rc; const float* rs;
    __device__ __forceinline__ void operator()(AccRef acc, const int r0, const int pn, const int half, int wr, int wc, int fr, int fq) const {
        const int row0 = r0 + wr * 64 + fr;
        if (pn == 13) {
            if (wc < 2) {
                const int i0 = 4 * (wc * 4 + fq);
#pragma unroll
                for (int ai = 0; ai < 2; ++ai)
#pragma unroll
                    for (int m = 0; m < 4; ++m) {
                        const int row = row0 + ai * 128 + m * 16, pos = row & (SEQ - 1);
                        const f32x4 c = *(const f32x4*)(rc + pos * 32 + i0), s = *(const f32x4*)(rs + pos * 32 + i0);
                        const f32x4 x1 = acc[ai][0][m][0], x2 = acc[ai][0][m][1];
                        const u32x2 y1 = pack4(x1 * c - x2 * s), y2 = pack4(x2 * c + x1 * s);
                        bf16_t* kp = KB + (size_t)row * (8 * 192) + 128 + i0;
#pragma unroll
                        for (int h = 0; h < 8; ++h) { *(u32x2*)(kp + h * 192) = y1; *(u32x2*)(kp + h * 192 + 32) = y2; }
                    }
            }
            return;
        }
        const int mode = (pn <= 2) ? 0 : (pn <= 6) ? 1 : (pn <= 8) ? 2 : 3;
#pragma unroll
        for (int ai = 0; ai < 2; ++ai)
#pragma unroll
            for (int m = 0; m < 4; ++m) {
                const int row = row0 + ai * 128 + m * 16;
                bf16_t* rowp = HB + (size_t)row * HW + pn * 256 + wc * 32 + 8 * fq;
                float ss = 0.f;
#pragma unroll
                for (int bj = 0; bj < 2; ++bj) {
                    f32x4 v0 = acc[ai][bj][m][0], v1 = acc[ai][bj][m][1];
                    if (mode == 0) { ss += (v0[0] * v0[0] + v0[1] * v0[1]) + (v0[2] * v0[2] + v0[3] * v0[3]) + (v1[0] * v1[0] + v1[1] * v1[1]) + (v1[2] * v1[2] + v1[3] * v1[3]); }
                    if (mode == 1) {
#pragma unroll
                        for (int j = 0; j < 4; ++j) { v0[j] = gelu_tanh(v0[j]); v1[j] = gelu_tanh(v1[j]); } }
                    if (mode == 2) { v0 = v0 * (0.125f * LOG2E); v1 = v1 * (0.125f * LOG2E); }
                    *(u32x4*)(rowp + bj * 128) = pack8(v0, v1);
                }
                if (mode == 0) { ss += __shfl_xor(ss, 16); ss += __shfl_xor(ss, 32); if (fq == 0) RSS[(size_t)row * 12 + pn * 4 + wc] = ss; }
            }
    }
};

struct Epi2 {
    static constexpr bool PERM = true;
    int mode; const float* RSS; bf16_t *QB, *KB, *VB; const float* rc; const float* rs;
    __device__ __forceinline__ void operator()(AccRef acc, const int r0, const int pn, const int half, int wr, int wc, int fr, int fq) const {
        const int row0 = r0 + wr * 64 + fr;
#pragma unroll
        for (int ai = 0; ai < 2; ++ai)
#pragma unroll
            for (int m = 0; m < 4; ++m) {
                const int row = row0 + ai * 128 + m * 16;
                const float* rp = RSS + (size_t)row * 12;
                float sc;
                if (mode == 0) { const f32x4 a = *(const f32x4*)rp, b = *(const f32x4*)(rp + 4); const float ss = ((a[0] + a[1]) + (a[2] + a[3])) + ((b[0] + b[1]) + (b[2] + b[3]));
                    sc = rsqrtf(ss * (1.0f / 512.0f) + 1e-6f) * (0.07216878364870322f * LOG2E); }
                else { const f32x4 a = *(const f32x4*)(rp + 8); const float ss = (a[0] + a[1]) + (a[2] + a[3]); sc = rsqrtf(ss * (1.0f / 256.0f) + 1e-6f); }
#pragma unroll
                for (int bj = 0; bj < 2; ++bj) {
                    const f32x4 v0 = acc[ai][bj][m][0] * sc, v1 = acc[ai][bj][m][1] * sc;
                    if (mode == 0) {
                        const int col8 = pn * 256 + bj * 128 + wc * 32 + 8 * fq, head = col8 / 192, w = col8 - head * 192;
                        bf16_t* qp = QB + ((size_t)row * 8 + head) * 192;
                        if (w < 128) *(u32x4*)(qp + w) = pack8(v0, v1);
                        else { const int i0 = 4 * ((w - 128) >> 3), pos = row & (SEQ - 1);
                            const f32x4 c = *(const f32x4*)(rc + pos * 32 + i0), s = *(const f32x4*)(rs + pos * 32 + i0);
                            *(u32x2*)(qp + 128 + i0) = pack4(v0 * c - v1 * s); *(u32x2*)(qp + 160 + i0) = pack4(v1 * c + v0 * s); }
                    } else {
                        if (bj == 0) *(u32x4*)(KB + ((size_t)row * 8 + pn) * 192 + wc * 32 + 8 * fq) = pack8(v0, v1);
                        else         *(u32x4*)(VB + ((size_t)row * 8 + pn) * 128 + wc * 32 + 8 * fq) = pack8(v0, v1);
                    }
                }
            }
    }
};

struct EpiWO {
    static constexpr bool PERM = true;
    bf16_t* Y1;
    __device__ __forceinline__ void operator()(AccRef acc, const int r0, const int pn, const int half, int wr, int wc, int fr, int fq) const {
        const int row0 = r0 + wr * 64 + fr, col0 = pn * 256 + wc * 32 + 8 * fq;
#pragma unroll
        for (int ai = 0; ai < 2; ++ai)
#pragma unroll
            for (int m = 0; m < 4; ++m) { const size_t o = (size_t)(row0 + ai * 128 + m * 16) * DM + col0;
#pragma unroll
                for (int bj = 0; bj < 2; ++bj) *(u32x4*)(Y1 + o + bj * 128) = pack8(acc[ai][bj][m][0], acc[ai][bj][m][1]); }
    }
};

struct EpiGU {
    static constexpr bool PERM = true;
    bf16_t* HM;
    __device__ __forceinline__ void operator()(AccRef acc, const int r0, const int pn, const int half, int wr, int wc, int fr, int fq) const {
        const int s0 = r0 + wr * 64 + fr;
#pragma unroll
        for (int ai = 0; ai < 2; ++ai) { if (ai == 1 && half) break;
#pragma unroll
            for (int m = 0; m < 4; ++m) {
                const int slot = s0 + ai * 128 + m * 16;
                f32x4 h0, h1;
#pragma unroll
                for (int j = 0; j < 4; ++j) { const float g0 = acc[ai][0][m][0][j], g1 = acc[ai][0][m][1][j];
                    h0[j] = g0 * sigmoidf_(g0) * acc[ai][1][m][0][j]; h1[j] = g1 * sigmoidf_(g1) * acc[ai][1][m][1][j]; }
                *(u32x4*)(HM + (size_t)slot * HSTR + pn * 128 + wc * 32 + 8 * fq) = pack8(h0, h1);
            } }
    }
};

__device__ __forceinline__ u32x2 pack8_fp8(f32x4 v0, f32x4 v1) { u32x2 w;
    int a, b; asm volatile("" : "=v"(a), "=v"(b));
    a = __builtin_amdgcn_cvt_pk_fp8_f32(v0[0], v0[1], a, false); a = __builtin_amdgcn_cvt_pk_fp8_f32(v0[2], v0[3], a, true);
    b = __builtin_amdgcn_cvt_pk_fp8_f32(v1[0], v1[1], b, false); b = __builtin_amdgcn_cvt_pk_fp8_f32(v1[2], v1[3], b, true);
    w.x = (unsigned)a; w.y = (unsigned)b; return w; }
struct EpiDN {
    static constexpr bool PERM = true;
    unsigned char* YM;
    __device__ __forceinline__ void operator()(AccRef acc, const int r0, const int pn, const int half, int wr, int wc, int fr, int fq) const {
        const int s0 = r0 + wr * 64 + fr;
#pragma unroll
        for (int ai = 0; ai < 2; ++ai) { if (ai == 1 && half) break;
#pragma unroll
            for (int m = 0; m < 4; ++m) { unsigned char* yp = YM + (size_t)(s0 + ai * 128 + m * 16) * DM + pn * 256 + wc * 32 + 8 * fq;
#pragma unroll
                for (int bj = 0; bj < 2; ++bj) *(u32x2*)(yp + bj * 128) = pack8_fp8(acc[ai][bj][m][0], acc[ai][bj][m][1]); } }
    }
};

struct SchedDense {
    int lda, K, nM, nN, pn0, Gs, c;
    __device__ __forceinline__ bool next(int i, Unit& u) const {
        if (c < 0 || c >= Gs) return false;
        int pm, pn; if (!pg8::dense_tile(i, Gs, c, nM, nN, pm, pn)) return false;
        pn += pn0;
        u.a = (unsigned)pm * 256u * (unsigned)lda * 2u; u.b = (unsigned)pn * 256u * (unsigned)K * 2u; u.r0 = pm * 256; u.pn = pn; u.half = 0; return true;
    }
};
struct SchedMoE {
    const LAS int* t2e; unsigned wstride; int rowbytes, K, NJ, nunits, G, v;
    __device__ __forceinline__ bool next(int i, Unit& u) const {
        const int L = i * G + ((i & 1) ? G - 1 - v : v); if (L >= nunits) return false;
        const int q = L / NJ, j = L - q * NJ, ent = t2e[MAXTILES + q], mt = ent & 0xffff, e = t2e[mt];
        u.a = (unsigned)mt * 256u * (unsigned)rowbytes; u.b = (unsigned)e * wstride + (unsigned)j * 256u * (unsigned)K * 2u; u.r0 = mt * 256; u.pn = j; u.half = ent >> 16; return true;
    }
};
__device__ __forceinline__ void tr_item(const float* colp, int ldn, const float* gain, bf16_t* dst, int K, int k0, int n0, LAS unsigned char* scr, int lane) {
    const int kq = lane >> 4, nq = lane & 15;
    f32x4 v[32];
#pragma unroll
    for (int i = 0; i < 32; ++i) { const int kk = 64 * (i >> 4) + 8 * ((i & 15) >> 1) + 2 * kq + (i & 1); v[i] = colp ? __builtin_nontemporal_load((const f32x4*)(colp + (size_t)(k0 + kk) * ldn)) : (f32x4){0.f, 0.f, 0.f, 0.f}; }
    if (gain) {
#pragma unroll
        for (int i = 0; i < 32; ++i) { const int kk = 64 * (i >> 4) + 8 * ((i & 15) >> 1) + 2 * kq + (i & 1); v[i] = v[i] * gain[k0 + kk]; } }
#pragma unroll
    for (int hb = 0; hb < 2; ++hb) {
#pragma unroll
        for (int m = 0; m < 8; ++m) { const int kk = 8 * m + 2 * kq;
#pragma unroll
            for (int c = 0; c < 4; ++c) *(LAS unsigned*)(scr + (4 * nq + c) * 128 + 4 * ((kk >> 1) ^ (4 * (nq & 7)))) = cvtpk(v[16 * hb + 2 * m][c], v[16 * hb + 2 * m + 1][c]); }
        LDS_WAIT(); asm volatile("" ::: "memory");
#pragma unroll
        for (int j = 0; j < 8; ++j) { const int n = 8 * j + (lane >> 3), c = lane & 7;
            const u32x4 o = *(const LAS u32x4*)(scr + n * 128 + 16 * (c ^ ((n >> 2) & 7)));
            __builtin_nontemporal_store(o, (u32x4*)(dst + (size_t)(n0 + n) * K + k0 + 64 * hb + 8 * c)); }
        LDS_WAIT(); asm volatile("" ::: "memory");
    }
}
__device__ __forceinline__ int rope_unperm(int p) { const int g = p >> 3, w = p & 7; return 4 * g + (w & 3) + ((w >= 4) ? 32 : 0); }

constexpr int IT_WIN = (DM / 128) * (HW / 64), IT_WUQ = (512 / 128) * (1536 / 64), IT_WUKV = (256 / 128) * (2048 / 64), IT_WO = (DM / 128) * (DM / 64),
              IT_WGU1 = (DM / 128) * (1024 / 64), IT_WD1 = (EDIM / 128) * (DM / 64);
constexpr int IT_LAYER = IT_WIN + IT_WUQ + IT_WUKV + IT_WO + NEXP1 * (IT_WGU1 + IT_WD1);

constexpr int IT_DENSE = IT_WIN + IT_WUQ + IT_WUKV + IT_WO;
constexpr int IT_EXPERT = NEXP1 * (IT_WGU1 + IT_WD1);
constexpr int CV_CHUNK = 64, CV_NCHUNK = IT_EXPERT / CV_CHUNK;
static_assert(IT_LAYER == IT_DENSE + IT_EXPERT && IT_EXPERT % CV_CHUNK == 0 && IT_WGU1 == 256 && IT_WD1 == 128 && (CV_CHUNK == 128 || CV_CHUNK == 64), "conversion chunks");
__device__ __forceinline__ void conv_item(KP_T P, unsigned char* ws, int l, int r, LAS unsigned char* scr, int lane) {
    const int ln = 4 * (lane & 15);
    if (r < IT_WIN) {
        const int nblk = HW / 64, kb = r / nblk, nb = r - kb * nblk, np = nb * 64 + ln;
        int oc; if (np < 768) oc = np; else if (np < HC_KR) oc = np + 64; else if (np < HC_KR + 64) oc = 768 + rope_unperm(np - HC_KR); else oc = -1;
        const float* cp = oc >= 0 ? P->w_in + (size_t)l * DM * IN_W + oc : nullptr;
        tr_item(cp, IN_W, nullptr, (bf16_t*)(ws + WS_WIN + l * SZ_WIN), DM, kb * 128, nb * 64, scr, lane); return; }
    r -= IT_WIN;
    if (r < IT_WUQ) {
        const int nblk = 1536 / 64, kb = r / nblk, nb = r - kb * nblk, np = nb * 64 + ln, head = np / 192, w = np - head * 192;
        const int oc = (w < 128) ? np : head * 192 + 128 + rope_unperm(w - 128);
        tr_item(P->mla_w_uq + (size_t)l * 512 * 1536 + oc, 1536, P->mla_q_norm + l * 512, (bf16_t*)(ws + WS_WUQ + l * SZ_WUQ), 512, kb * 128, nb * 64, scr, lane); return; }
    r -= IT_WUQ;
    if (r < IT_WUKV) {
        const int nblk = 2048 / 64, kb = r / nblk, nb = r - kb * nblk, np = nb * 64 + ln;
        tr_item(P->mla_w_ukv + (size_t)l * 256 * 2048 + np, 2048, P->mla_kv_norm + l * 256, (bf16_t*)(ws + WS_WUKV + l * SZ_WUKV), 256, kb * 128, nb * 64, scr, lane); return; }
    r -= IT_WUKV;
    if (r < IT_WO) {
        const int nblk = DM / 64, kb = r / nblk, nb = r - kb * nblk, np = nb * 64 + ln;
        tr_item(P->w_o + (size_t)l * DM * DM + np, DM, nullptr, (bf16_t*)(ws + WS_WO + l * SZ_WO), DM, kb * 128, nb * 64, scr, lane); return; }
    r -= IT_WO;
    if (r < NEXP1 * IT_WGU1) {
        const int e = r / IT_WGU1, rr = r - e * IT_WGU1, nblk = 1024 / 64, kb = rr / nblk, nb = rr - kb * nblk, np = nb * 64 + ln;
        const int tj = np >> 8, w = np & 255, col = tj * 128 + (w & 127); const bool up = w >= 128;
        const float* src = (e < NEXP) ? (up ? P->exp_w_up : P->exp_w_gate) + ((size_t)l * NEXP + e) * DM * EDIM : (up ? P->shared_w_up : P->shared_w_gate) + (size_t)l * DM * EDIM;
        tr_item(src + col, EDIM, nullptr, (bf16_t*)(ws + WS_WGU + l * SZ_WGU + e * SZ_WGU1), DM, kb * 128, nb * 64, scr, lane); return; }
    r -= NEXP1 * IT_WGU1;
    {
        const int e = r / IT_WD1, rr = r - e * IT_WD1, nblk = DM / 64, kb = rr / nblk, nb = rr - kb * nblk, np = nb * 64 + ln;
        const float* src = (e < NEXP) ? P->exp_w_down + ((size_t)l * NEXP + e) * EDIM * DM : P->shared_w_down + (size_t)l * EDIM * DM;
        tr_item(src + np, DM, nullptr, (bf16_t*)(ws + WS_WD + l * SZ_WD + e * SZ_WD1), EDIM, kb * 128, nb * 64, scr, lane); }
}
#ifndef CV_STORE
#define CV_STORE(v, p) __builtin_nontemporal_store(v, p)
#endif
struct CvDesc { const float* colp; bf16_t* dst; int ldn, K, k0, n0; float sc; };
__device__ __forceinline__ CvDesc conv_desc(KP_T P, unsigned char* ws, int l, int r, int lane) {
    const int ln = 4 * (lane & 15); CvDesc d;
    if (r < NEXP1 * IT_WGU1) {
        const int e = r / IT_WGU1, rr = r - e * IT_WGU1, nb = 8 * (rr >> 7) + (rr & 7), kb = (rr >> 3) & 15, np = nb * 64 + ln;
        const int tj = np >> 8, w = np & 255, col = tj * 128 + (w & 127); const bool up = w >= 128;
        const float* src = (e < NEXP) ? (up ? P->exp_w_up : P->exp_w_gate) + ((size_t)l * NEXP + e) * DM * EDIM : (up ? P->shared_w_up : P->shared_w_gate) + (size_t)l * DM * EDIM;
        d.colp = src + col; d.dst = (bf16_t*)(ws + WS_WGU + l * SZ_WGU + e * SZ_WGU1); d.ldn = EDIM; d.K = WGSTR; d.k0 = kb * 128; d.n0 = nb * 64; d.sc = 1.0f;
    } else { r -= NEXP1 * IT_WGU1;
        const int e = r / IT_WD1, rr = r - e * IT_WD1, nb = (rr & 7) + 8 * (rr >> 5), kb = (rr >> 3) & 3, np = nb * 64 + ln;
        const float* src = (e < NEXP) ? P->exp_w_down + ((size_t)l * NEXP + e) * EDIM * DM : P->shared_w_down + (size_t)l * EDIM * DM;
        d.colp = src + np; d.dst = (bf16_t*)(ws + WS_WD + l * SZ_WD + e * SZ_WD1); d.ldn = DM; d.K = WDSTR; d.k0 = kb * 128; d.n0 = nb * 64; d.sc = 8.0f; }
    return d;
}
__device__ __forceinline__ void tr_load16(const CvDesc& d, int hb, f32x4 (&v)[16], int lane) {
    const int kq = lane >> 4;
#pragma unroll
    for (int i = 0; i < 16; ++i) { const int kk = 64 * hb + 8 * (i >> 1) + 2 * kq + (i & 1); v[i] = __builtin_nontemporal_load((const f32x4*)(d.colp + (size_t)(d.k0 + kk) * d.ldn)); }
}
__device__ __forceinline__ void tr_store16(const CvDesc& d, int hb, const f32x4 (&v)[16], LAS unsigned char* scr, int lane) {
    const int kq = lane >> 4, nq = lane & 15, sw = 4 * (nq & 7);
#pragma unroll
    for (int m = 0; m < 8; ++m) {
#pragma unroll
        for (int c = 0; c < 4; ++c) *(LAS unsigned*)(scr + (4 * nq + c) * 128 + 4 * ((4 * m + kq) ^ sw)) = cvtpk(v[2 * m][c] * d.sc, v[2 * m + 1][c] * d.sc); }
    LDS_WAIT(); asm volatile("" ::: "memory");
#pragma unroll
    for (int j = 0; j < 8; ++j) { const int n = 8 * j + (lane >> 3), c = lane & 7;
        const u32x4 o = *(const LAS u32x4*)(scr + n * 128 + 16 * (c ^ ((n >> 2) & 7)));
        CV_STORE(o, (u32x4*)(d.dst + (size_t)(d.n0 + n) * d.K + d.k0 + 64 * hb + 8 * c)); }
    LDS_WAIT(); asm volatile("" ::: "memory");
}
__device__ __forceinline__ void convert_chunk(KP_T P, LAS unsigned char* lds, int l, int chunk) {
    const int tid = opq_tid(), lane = tid & 63, wave = __builtin_amdgcn_readfirstlane(tid >> 6);
    LAS unsigned char* scr = lds + wave * 16384; unsigned char* ws = P->ws;
    const int r0 = chunk * CV_CHUNK + wave;
    CvDesc d = conv_desc(P, ws, l, r0, lane);
    f32x4 va[16], vb[16];
    tr_load16(d, 0, va, lane);
#pragma unroll 1
    for (int i = 0; i < CV_CHUNK / NWAVES; ++i) {
        tr_load16(d, 1, vb, lane);
        tr_store16(d, 0, va, scr, lane);
        const bool more = i + 1 < CV_CHUNK / NWAVES;
        const CvDesc dn = more ? conv_desc(P, ws, l, r0 + NWAVES * (i + 1), lane) : d;
        if (more) tr_load16(dn, 0, va, lane);
        tr_store16(d, 1, vb, scr, lane);
        d = dn;
    }
}

__device__ __forceinline__ void prologue_phase(KP_T P, LAS unsigned char* lds, int vcu, int G) {
    const int tid = opq_tid(), lane = tid & 63, wave = __builtin_amdgcn_readfirstlane(tid >> 6);
    LAS unsigned char* scr = lds + wave * 16384;
    const int gw = vcu * NWAVES + wave, NGW = G * NWAVES;
    unsigned char* ws = P->ws;
    for (int it = gw; it < NLAYER * IT_DENSE; it += NGW) { const int l = it / IT_DENSE; conv_item(P, ws, l, it - l * IT_DENSE, scr, lane); }
    { u32x4* WH = (u32x4*)(ws + WS_RTR); u32x4* WL = WH + NLAYER * 16384;
      for (int idx = gw * 64 + lane; idx < NLAYER * 16384; idx += NGW * 64) { const int l = idx >> 14, rem = idx & 16383, ks = rem >> 8, n = (rem >> 6) & 3, ln = rem & 63, e = 4 * (ln & 15) + n;
          const float* p = P->router_w + ((size_t)l * DM + 32 * ks + 8 * (ln >> 4)) * NEXP + e;
          f32x4 a, b;
#pragma unroll
          for (int t = 0; t < 4; ++t) { a[t] = p[(size_t)t * NEXP]; b[t] = p[(size_t)(t + 4) * NEXP]; }
          const u32x4 hi = pack8(a, b);
          const f32x4 ra = a - (f32x4){bflo(hi.x), bfhi(hi.x), bflo(hi.y), bfhi(hi.y)}, rb = b - (f32x4){bflo(hi.z), bfhi(hi.z), bflo(hi.w), bfhi(hi.w)};
          WH[idx] = hi; WL[idx] = pack8(ra, rb); } }
    { bf16_t* XB = (bf16_t*)(ws + WS_XB);
      for (int ch = gw; ch < T * DM / 512; ch += 4 * NGW) { f32x4 a[4], b[4];
#pragma unroll
          for (int q = 0; q < 4; ++q) { const int c = ch + q * NGW; const size_t o = (size_t)(c < T * DM / 512 ? c : ch) * 512 + lane * 8; a[q] = *(const f32x4*)(P->x + o); b[q] = *(const f32x4*)(P->x + o + 4); }
#pragma unroll
          for (int q = 0; q < 4; ++q) { const int c = ch + q * NGW; if (c < T * DM / 512) *(u32x4*)(XB + (size_t)c * 512 + lane * 8) = pack8(a[q], b[q]); } } }
    { float* rc = (float*)(ws + WS_ROPE); float* rs = rc + SEQ * 32;
      for (int i = gw * 64 + lane; i < SEQ * 32; i += NGW * 64) { const int pos = i >> 5, f = i & 31;
          const float inv = exp2f(-(float)f * (1.0f / 32.0f) * 13.287712379549449f);
          const float ang = (float)pos * inv;
          const double q = (double)ang * 0.15915494309189535; const double fr = q - __builtin_rint(q);
          const float rad = (float)(fr * 6.283185307179586);
          rc[i] = __cosf(rad); rs[i] = __sinf(rad); } }
}
#define CVSEL 4

typedef short v4i16_t __attribute__((ext_vector_type(4)));
__device__ __forceinline__ s16x4 vtr(const LAS char* p) { return __builtin_bit_cast(s16x4, __builtin_amdgcn_ds_read_tr16_b64_v4i16((LAS v4i16_t*)p)); }
#define FRAG8(lo, hi) ((bf16x8){(lo)[0], (lo)[1], (lo)[2], (lo)[3], (hi)[0], (hi)[1], (hi)[2], (hi)[3]})
constexpr int VROW = 320;
constexpr int KROW_M = 400;
constexpr int KROW_D = 272;
constexpr int ATT_TAB = 98304;
static_assert(4 * 66 * 64 * 4 <= ATT_TAB && ATT_TAB + 512 <= LDS_STAGE, "attention LDS map");

__device__ __forceinline__ float half_max(float x) { auto rr = __builtin_amdgcn_permlane32_swap(__float_as_uint(x), __float_as_uint(x), false, false); return fmaxf(__uint_as_float(rr[0]), __uint_as_float(rr[1])); }
__device__ __forceinline__ float half_sum(float x) { auto rr = __builtin_amdgcn_permlane32_swap(__float_as_uint(x), __float_as_uint(x), false, false); return __uint_as_float(rr[0]) + __uint_as_float(rr[1]); }
template <int NT>
__device__ __forceinline__ void smax_update(f32x16 (&S)[NT], float& m, float& l, f32x16 (&O)[4], bf16x8 (&pf)[NT][2]) {
    float mx = fmaxf(S[0][0], S[0][1]);
#pragma unroll
    for (int t = 0; t < NT; ++t)
#pragma unroll
        for (int r = (t == 0 ? 2 : 0); r < 16; r += 2) mx = fmaxf(mx, fmaxf(S[t][r], S[t][r + 1]));
    mx = half_max(mx);
    if (__any(mx > m + 8.0f)) {
        const float mn = fmaxf(m, mx), alpha = __builtin_amdgcn_exp2f(m - mn);
        m = mn; l *= alpha;
#pragma unroll
        for (int d = 0; d < 4; ++d) O[d] = O[d] * alpha;
    }
    float sum = 0.f;
#pragma unroll
    for (int t = 0; t < NT; ++t)
#pragma unroll
        for (int r = 0; r < 16; ++r) { const float p = __builtin_amdgcn_exp2f(S[t][r] - m); S[t][r] = p; sum += p; }
    l += sum;
#pragma unroll
    for (int t = 0; t < NT; ++t)
#pragma unroll
        for (int s = 0; s < 2; ++s) { u32x4 w; w.x = cvtpk(S[t][8 * s + 0], S[t][8 * s + 1]); w.y = cvtpk(S[t][8 * s + 2], S[t][8 * s + 3]); w.z = cvtpk(S[t][8 * s + 4], S[t][8 * s + 5]); w.w = cvtpk(S[t][8 * s + 6], S[t][8 * s + 7]);
            pf[t][s] = __builtin_bit_cast(bf16x8, w); }
}
__device__ __forceinline__ void pv_tile(f32x16 (&O)[4], const LAS char* vp, const bf16x8 (&pf)[2]) {
    s16x4 lo[4][2], hi[4][2];
#pragma unroll
    for (int dt = 0; dt < 4; ++dt)
#pragma unroll
        for (int s = 0; s < 2; ++s) { lo[dt][s] = vtr(vp + (16 * s) * VROW + dt * 64); hi[dt][s] = vtr(vp + (16 * s + 8) * VROW + dt * 64); }
    __builtin_amdgcn_sched_barrier(0);
#pragma unroll
    for (int dt = 0; dt < 4; ++dt)
#pragma unroll
        for (int s = 0; s < 2; ++s) O[dt] = __builtin_amdgcn_mfma_f32_32x32x16_bf16(FRAG8(lo[dt][s], hi[dt][s]), pf[s], O[dt], 0, 0, 0);
}

constexpr int MLA_KT = 64 * 384, MLA_SLOT = MLA_KT + 64 * 256;
constexpr int DIF_KT = 64 * 256, DIF_SLOT = DIF_KT + 64 * 256;
static_assert(3 * MLA_SLOT <= LDS_STAGE && 3 * DIF_SLOT <= ATT_TAB, "attention ring");
#define ATT_DMA(gp, ldsp) __builtin_amdgcn_global_load_lds((const unsigned*)(gp), (LAS unsigned*)(ldsp), 16, 0, 0)
__device__ __forceinline__ void pv_tile_sw(f32x16 (&O)[4], const LAS char* slotv, const int (&vb)[4], const bf16x8 (&pf)[2]) {
    s16x4 lo[4][2], hi[4][2];
    const unsigned sv = (unsigned)(__UINTPTR_TYPE__)slotv;
#pragma unroll
    for (int dt = 0; dt < 4; ++dt) { const unsigned a = sv + (unsigned)vb[dt];
        asm volatile("ds_read_b64_tr_b16 %0, %4\n\tds_read_b64_tr_b16 %1, %4 offset:2048\n\tds_read_b64_tr_b16 %2, %4 offset:4096\n\tds_read_b64_tr_b16 %3, %4 offset:6144"
                     : "=&v"(lo[dt][0]), "=&v"(hi[dt][0]), "=&v"(lo[dt][1]), "=&v"(hi[dt][1]) : "v"(a) : "memory"); }
    asm volatile("s_waitcnt lgkmcnt(0)" ::: "memory");
    __builtin_amdgcn_sched_barrier(0);
#pragma unroll
    for (int dt = 0; dt < 4; ++dt)
#pragma unroll
        for (int s = 0; s < 2; ++s) O[dt] = __builtin_amdgcn_mfma_f32_32x32x16_bf16(FRAG8(lo[dt][s], hi[dt][s]), pf[s], O[dt], 0, 0, 0);
}

__device__ __forceinline__ void mla_unit(KP_T P, LAS unsigned char* lds, int b, int h, int qb) {
    const int tid = opq_tid(), lane = tid & 63, wid = __builtin_amdgcn_readfirstlane(tid >> 6), rg = wid & 3, kg = wid >> 2, ql = lane & 31, hh = lane >> 5;
    const bf16_t* QB = (const bf16_t*)(P->ws + WS_QB); const bf16_t* KB = (const bf16_t*)(P->ws + WS_KB); const bf16_t* VB = (const bf16_t*)(P->ws + WS_VB); bf16_t* MIX = (bf16_t*)(P->ws + WS_MIX);
    const int q0 = qb * 128, nsteps = 2 * (qb + 1), rowmin = q0 + 32 * rg, row = rowmin + ql;
    int gk[3], gv[2];
#pragma unroll
    for (int t = 0; t < 3; ++t) { const int p16 = (3 * wid + t) * 64 + lane, r = p16 / 24, ph = p16 - r * 24, lg = (ph & ~7) | ((ph ^ (r >> 1)) & 7); gk[t] = r * (8 * 192 * 2) + lg * 16; }
#pragma unroll
    for (int t = 0; t < 2; ++t) { const int p16 = (2 * wid + t) * 64 + lane, r = p16 >> 4, ph = p16 & 15, lg = ph ^ ((r & 3) << 2); gv[t] = r * (8 * 128 * 2) + lg * 16; }
    const char* kg0 = (const char*)(KB + ((size_t)b * SEQ * 8 + h) * 192); const char* vg0 = (const char*)(VB + ((size_t)b * SEQ * 8 + h) * 128);
#define MLA_DMA(j, slot) do { const char* kt_ = kg0 + (size_t)(j) * 64 * (8 * 192 * 2); const char* vt_ = vg0 + (size_t)(j) * 64 * (8 * 128 * 2); LAS unsigned char* sb_ = lds + (slot) * MLA_SLOT; \
        _Pragma("unroll") for (int t = 0; t < 3; ++t) ATT_DMA(kt_ + gk[t], sb_ + (3 * wid + t) * 1024); \
        _Pragma("unroll") for (int t = 0; t < 2; ++t) ATT_DMA(vt_ + gv[t], sb_ + MLA_KT + (2 * wid + t) * 1024); } while (0)
    bf16x8 qf[12];
    { const bf16_t* qp = QB + (((size_t)b * SEQ + row) * 8 + h) * 192 + 8 * hh;
#pragma unroll
      for (int ks = 0; ks < 12; ++ks) qf[ks] = *(const bf16x8*)(qp + 16 * ks); }
    MLA_DMA(0, 0); MLA_DMA(1, 1);
#pragma unroll
    for (int ks = 0; ks < 12; ++ks) asm volatile("" : "+v"(qf[ks]));
    f32x16 O[4];
#pragma unroll
    for (int d = 0; d < 4; ++d)
#pragma unroll
        for (int r = 0; r < 16; ++r) O[d][r] = 0.f;
    float m = -1e30f, l = 0.f;
    const int rk = 32 * kg + ql; int ko[4];
#pragma unroll
    for (int c = 0; c < 4; ++c) ko[c] = rk * 384 + 16 * ((2 * c + hh) ^ ((rk >> 1) & 7));
    const int q4 = (lane & 15) >> 2; int vb[4];
#pragma unroll
    for (int dt = 0; dt < 4; ++dt) vb[dt] = MLA_KT + (32 * kg + 4 * hh + q4) * 256 + 64 * (dt ^ q4) + 32 * ((lane >> 4) & 1) + 8 * (lane & 3);
    int slot = 0;
    for (int j = 0; j < nsteps; ++j) {
        if (j + 1 < nsteps) asm volatile("s_waitcnt vmcnt(5)" ::: "memory"); else asm volatile("s_waitcnt vmcnt(0)" ::: "memory");
        __builtin_amdgcn_s_barrier(); asm volatile("" ::: "memory");
        if (j + 2 < nsteps) { const int s2 = slot >= 1 ? slot - 1 : 2; MLA_DMA(j + 2, s2); }
        const int kbase = 64 * j + 32 * kg;
        if (kbase <= rowmin + 31) {
            const LAS unsigned char* buf = lds + slot * MLA_SLOT;
            f32x16 S[1];
#pragma unroll
            for (int r = 0; r < 16; ++r) S[0][r] = 0.f;
            { bf16x8 kf[12];
#pragma unroll
              for (int ks = 0; ks < 12; ++ks) kf[ks] = *(const LAS bf16x8*)(buf + ko[ks & 3] + 128 * (ks >> 2));
              __builtin_amdgcn_sched_barrier(0);
#pragma unroll
              for (int ks = 0; ks < 12; ++ks) S[0] = __builtin_amdgcn_mfma_f32_32x32x16_bf16(kf[ks], qf[ks], S[0], 0, 0, 0); }
            if (kbase + 31 > rowmin) {
#pragma unroll
                for (int r = 0; r < 16; ++r) { const int key = kbase + (r & 3) + 8 * (r >> 2) + 4 * hh; if (key > row) S[0][r] = -INFINITY; }
            }
            bf16x8 pf[1][2];
            smax_update<1>(S, m, l, O, pf);
            pv_tile_sw(O, (const LAS char*)buf, vb, pf[0]);
        }
        slot = slot == 2 ? 0 : slot + 1;
    }
    __syncthreads();
    LAS float* xb = (LAS float*)lds + rg * (66 * 64) + lane;
    if (kg == 1) {
#pragma unroll
        for (int d = 0; d < 4; ++d)
#pragma unroll
            for (int r = 0; r < 16; ++r) xb[(d * 16 + r) * 64] = O[d][r];
        xb[64 * 64] = m; xb[65 * 64] = l;
    }
    __syncthreads();
    if (kg == 0) {
        const float m1 = xb[64 * 64], l1 = xb[65 * 64];
        const float mt = fmaxf(m, m1), a0 = __builtin_amdgcn_exp2f(m - mt), a1 = __builtin_amdgcn_exp2f(m1 - mt);
        float lt = l * a0 + l1 * a1; lt = half_sum(lt);
        const float inv = 1.0f / lt;
        bf16_t* op = MIX + ((size_t)b * SEQ + row) * DM + h * 128 + 4 * hh;
#pragma unroll
        for (int d = 0; d < 4; ++d)
#pragma unroll
            for (int g4 = 0; g4 < 4; ++g4) { f32x4 v;
#pragma unroll
                for (int j = 0; j < 4; ++j) { const int r = 4 * g4 + j; v[j] = (O[d][r] * a0 + xb[(d * 16 + r) * 64] * a1) * inv; }
                *(u32x2*)(op + 32 * d + 8 * g4) = pack4(v); }
    }
    __syncthreads();
#undef MLA_DMA
}

__device__ __forceinline__ void diff_unit(KP_T P, LAS unsigned char* lds, int lyr, int b, int h, int qb, float lam_init) {
    const int tid = opq_tid(), lane = tid & 63, wid = __builtin_amdgcn_readfirstlane(tid >> 6), rg = wid & 3, mp = wid >> 2, ql = lane & 31, hh = lane >> 5;
    const bf16_t* HB = (const bf16_t*)(P->ws + WS_HB); bf16_t* MIX = (bf16_t*)(P->ws + WS_MIX);
    const int q0 = qb * 128, nsteps = 2 * (qb + 1), rowmin = q0 + 32 * rg, row = rowmin + ql;
    LAS float* tab = (LAS float*)(lds + ATT_TAB);
    if (tid < 128) { const int n = tid; int bk;
        if (n < 16) bk = n; else { bk = 16 + (int)(logf((float)n * (1.0f / 16.0f)) / 2.0794415416798357f * 16.0f); bk = bk > 31 ? 31 : bk; }
        tab[n] = P->rel_bias[bk * 4 + h] * LOG2E; }
    float lam;
    { const float a = P->diff_lq1[lyr * 64 + lane] * P->diff_lk1[lyr * 64 + lane], c = P->diff_lq2[lyr * 64 + lane] * P->diff_lk2[lyr * 64 + lane];
      lam = expf(wave_sum(a)) - expf(wave_sum(c)) + lam_init; }
    int gk[2], gv[2];
#pragma unroll
    for (int t = 0; t < 2; ++t) { const int p16 = (2 * wid + t) * 64 + lane, r = p16 >> 4, ph = p16 & 15;
        gk[t] = r * (HW * 2) + HC_DK * 2 + (ph ^ (r & 15)) * 16; gv[t] = r * (HW * 2) + HC_DV * 2 + (ph ^ ((r & 3) << 2)) * 16; }
    const char* hg0 = (const char*)(HB + (size_t)b * SEQ * HW + h * 128);
#define DIF_DMA(j, slot) do { const char* t_ = hg0 + (size_t)(j) * 64 * (HW * 2); LAS unsigned char* sb_ = lds + (slot) * DIF_SLOT; \
        _Pragma("unroll") for (int t = 0; t < 2; ++t) ATT_DMA(t_ + gk[t], sb_ + (2 * wid + t) * 1024); \
        _Pragma("unroll") for (int t = 0; t < 2; ++t) ATT_DMA(t_ + gv[t], sb_ + DIF_KT + (2 * wid + t) * 1024); } while (0)
    bf16x8 qf[4];
    { const bf16_t* qp = HB + ((size_t)b * SEQ + row) * HW + HC_DQ + h * 128 + mp * 64 + 8 * hh;
#pragma unroll
      for (int ks = 0; ks < 4; ++ks) qf[ks] = *(const bf16x8*)(qp + 16 * ks); }
    DIF_DMA(0, 0); DIF_DMA(1, 1);
#pragma unroll
    for (int ks = 0; ks < 4; ++ks) asm volatile("" : "+v"(qf[ks]));
    asm volatile("" : "+v"(lam));
    f32x16 O[4];
#pragma unroll
    for (int d = 0; d < 4; ++d)
#pragma unroll
        for (int r = 0; r < 16; ++r) O[d][r] = 0.f;
    float m = -1e30f, l = 0.f;
    int ko[4];
#pragma unroll
    for (int c = 0; c < 4; ++c) ko[c] = ql * 256 + 16 * ((8 * mp + 2 * c + hh) ^ (ql & 15));
    const int q4 = (lane & 15) >> 2; int vb[4];
#pragma unroll
    for (int dt = 0; dt < 4; ++dt) vb[dt] = DIF_KT + (4 * hh + q4) * 256 + 64 * (dt ^ q4) + 32 * ((lane >> 4) & 1) + 8 * (lane & 3);
    float c31 = 0.f; int slot = 0;
    for (int j = 0; j < nsteps; ++j) {
        if (j + 1 < nsteps) asm volatile("s_waitcnt vmcnt(4)" ::: "memory"); else asm volatile("s_waitcnt vmcnt(0)" ::: "memory");
        asm volatile("s_waitcnt lgkmcnt(0)" ::: "memory"); __builtin_amdgcn_s_barrier(); asm volatile("" ::: "memory");
        if (j == 0) c31 = tab[127];
        if (j + 2 < nsteps) { const int s2 = slot >= 1 ? slot - 1 : 2; DIF_DMA(j + 2, s2); }
        const int kbase = 64 * j;
        if (kbase <= rowmin + 31) {
            const LAS unsigned char* buf = lds + slot * DIF_SLOT;
            f32x16 S[2];
            { bf16x8 kf[2][4];
#pragma unroll
              for (int t = 0; t < 2; ++t)
#pragma unroll
                  for (int ks = 0; ks < 4; ++ks) kf[t][ks] = *(const LAS bf16x8*)(buf + ko[ks] + t * 32 * 256);
              __builtin_amdgcn_sched_barrier(0);
#pragma unroll
              for (int t = 0; t < 2; ++t) {
#pragma unroll
                  for (int r = 0; r < 16; ++r) S[t][r] = 0.f;
#pragma unroll
                  for (int ks = 0; ks < 4; ++ks) S[t] = __builtin_amdgcn_mfma_f32_32x32x16_bf16(kf[t][ks], qf[ks], S[t], 0, 0, 0); } }
            if (rowmin - (kbase + 63) >= 127) {
#pragma unroll
                for (int t = 0; t < 2; ++t)
#pragma unroll
                    for (int r = 0; r < 16; ++r) S[t][r] += c31;
            } else {
#pragma unroll
                for (int t = 0; t < 2; ++t)
#pragma unroll
                    for (int r = 0; r < 16; ++r) { const int key = kbase + 32 * t + (r & 3) + 8 * (r >> 2) + 4 * hh; int n = row - key; const bool ok = n >= 0; n = n < 0 ? 0 : (n > 127 ? 127 : n);
                        S[t][r] = ok ? S[t][r] + tab[n] : -INFINITY; }
            }
            bf16x8 pf[2][2];
            smax_update<2>(S, m, l, O, pf);
            pv_tile_sw(O, (const LAS char*)buf, vb, pf[0]);
            pv_tile_sw(O, (const LAS char*)buf + 32 * 256, vb, pf[1]);
        }
        slot = slot == 2 ? 0 : slot + 1;
    }
    __syncthreads();
    { float lt = half_sum(l); const float inv = 1.0f / lt;
#pragma unroll
      for (int d = 0; d < 4; ++d) O[d] = O[d] * inv; }
    LAS float* xb = (LAS float*)lds + rg * (64 * 64) + lane;
    if (mp == 1) {
#pragma unroll
        for (int d = 0; d < 4; ++d)
#pragma unroll
            for (int r = 0; r < 16; ++r) xb[(d * 16 + r) * 64] = O[d][r];
    }
    __syncthreads();
    if (mp == 0) {
        float ss = 0.f;
#pragma unroll
        for (int d = 0; d < 4; ++d)
#pragma unroll
            for (int r = 0; r < 16; ++r) { const float o = O[d][r] - lam * xb[(d * 16 + r) * 64]; O[d][r] = o; ss += o * o; }
        ss = half_sum(ss);
        const float rs = rsqrtf(ss * (1.0f / 128.0f) + 1e-6f) * (1.0f - lam_init);
        bf16_t* op = MIX + ((size_t)b * SEQ + row) * DM + 1536 + h * 128 + 4 * hh;
        const float* gp = P->diff_subln + lyr * 128 + 4 * hh;
#pragma unroll
        for (int d = 0; d < 4; ++d)
#pragma unroll
            for (int g4 = 0; g4 < 4; ++g4) { const f32x4 g = *(const f32x4*)(gp + 32 * d + 8 * g4); f32x4 v;
#pragma unroll
                for (int j = 0; j < 4; ++j) v[j] = O[d][4 * g4 + j] * rs * g[j];
                *(u32x2*)(op + 32 * d + 8 * g4) = pack4(v); }
    }
    __syncthreads();
#undef DIF_DMA
}

constexpr int GM_W = 0, GM_V = 128 * KROW_D, GM_ST = GM_V + 128 * VROW;
__device__ __forceinline__ void gmlp_unit(KP_T P, LAS unsigned char* lds, int lyr, int b, int c) {
    const int tid = opq_tid(), lane = tid & 63, wid = __builtin_amdgcn_readfirstlane(tid >> 6), ql = lane & 31, hh = lane >> 5;
    const bf16_t* HB = (const bf16_t*)(P->ws + WS_HB); bf16_t* MIX = (bf16_t*)(P->ws + WS_MIX);
    const size_t R0 = (size_t)b * SEQ + c * 128;
    LAS f32x2* stats = (LAS f32x2*)(lds + GM_ST);
    { const int r = 16 * wid + (lane >> 2), q = lane & 3; const bf16_t* vp = HB + (R0 + r) * HW + HC_GV + 128 * q;
      u32x4 w[16];
#pragma unroll
      for (int i = 0; i < 16; ++i) w[i] = *(const u32x4*)(vp + 8 * i);
      float s = 0.f;
#pragma unroll
      for (int i = 0; i < 16; ++i) s += ((bflo(w[i].x) + bfhi(w[i].x)) + (bflo(w[i].y) + bfhi(w[i].y))) + ((bflo(w[i].z) + bfhi(w[i].z)) + (bflo(w[i].w) + bfhi(w[i].w)));
      s += __shfl_xor(s, 1); s += __shfl_xor(s, 2);
      const float mean = s * (1.0f / 512.0f); float qv = 0.f;
#pragma unroll
      for (int i = 0; i < 16; ++i) { const float d0 = bflo(w[i].x) - mean, d1 = bfhi(w[i].x) - mean, d2 = bflo(w[i].y) - mean, d3 = bfhi(w[i].y) - mean, d4 = bflo(w[i].z) - mean, d5 = bfhi(w[i].z) - mean, d6 = bflo(w[i].w) - mean, d7 = bfhi(w[i].w) - mean;
          qv += ((d0 * d0 + d1 * d1) + (d2 * d2 + d3 * d3)) + ((d4 * d4 + d5 * d5) + (d6 * d6 + d7 * d7)); }
      qv += __shfl_xor(qv, 1); qv += __shfl_xor(qv, 2);
      if (q == 0) stats[r] = (f32x2){mean, rsqrtf(qv * (1.0f / 512.0f) + 1e-5f)}; }
    const int tt = wid & 3, dp = wid >> 2;
    const int woff = GM_W + (32 * tt + ql) * KROW_D + 16 * hh;
    const int voff = GM_V + (8 * hh + ((lane & 15) >> 2)) * VROW + (16 * ((lane >> 4) & 1) + 4 * (lane & 3)) * 2;
    f32x4 wa[4], wb[4]; u32x4 vv[4];
#define GM_FETCH(g) do { _Pragma("unroll") for (int i = 0; i < 4; ++i) { const int cid = tid + 512 * i, t = cid >> 4, s0 = (cid & 15) * 8; \
        const float* wp = P->gmlp_w_s + (((size_t)lyr * 4 + (g)) * 128 + t) * 128 + s0; wa[i] = *(const f32x4*)wp; wb[i] = *(const f32x4*)(wp + 4); \
        vv[i] = *(const u32x4*)(HB + (R0 + t) * HW + HC_GV + (g) * 128 + s0); } } while (0)
    GM_FETCH(0);
    __syncthreads();
    for (int g = 0; g < 4; ++g) {
#pragma unroll
        for (int i = 0; i < 4; ++i) { const int cid = tid + 512 * i, t = cid >> 4, s0 = (cid & 15) * 8;
            f32x4 a2, b2;
#pragma unroll
            for (int j = 0; j < 4; ++j) { a2[j] = (s0 + j <= t) ? wa[i][j] : 0.f; b2[j] = (s0 + 4 + j <= t) ? wb[i][j] : 0.f; }
            *(LAS u32x4*)(lds + GM_W + t * KROW_D + s0 * 2) = pack8(a2, b2);
            const f32x2 ms = stats[t]; const u32x4 w = vv[i];
            const float* gp = P->gmlp_ln_g + lyr * 512 + g * 128 + s0; const float* bp = P->gmlp_ln_b + lyr * 512 + g * 128 + s0;
            const f32x4 g0 = *(const f32x4*)gp, g1 = *(const f32x4*)(gp + 4), b0 = *(const f32x4*)bp, b1 = *(const f32x4*)(bp + 4);
            f32x4 v0 = {bflo(w.x), bfhi(w.x), bflo(w.y), bfhi(w.y)}, v1 = {bflo(w.z), bfhi(w.z), bflo(w.w), bfhi(w.w)};
            v0 = (v0 - ms.x) * ms.y * g0 + b0; v1 = (v1 - ms.x) * ms.y * g1 + b1;
            *(LAS u32x4*)(lds + GM_V + t * VROW + s0 * 2) = pack8(v0, v1); }
        const int t = 32 * tt + ql; const float bs = P->gmlp_b_s[((size_t)lyr * 4 + g) * 128 + t];
        const bf16_t* up = HB + (R0 + t) * HW + HC_GU + g * 128 + 4 * hh; u32x2 uw[2][4];
#pragma unroll
        for (int dd = 0; dd < 2; ++dd)
#pragma unroll
            for (int g4 = 0; g4 < 4; ++g4) uw[dd][g4] = *(const u32x2*)(up + 32 * (2 * dp + dd) + 8 * g4);
        if (g < 3) GM_FETCH(g + 1);
        __syncthreads();
        f32x16 acc[2];
#pragma unroll
        for (int dd = 0; dd < 2; ++dd)
#pragma unroll
            for (int r = 0; r < 16; ++r) acc[dd][r] = 0.f;
#pragma unroll
        for (int kp = 0; kp < 4; ++kp) {
            if (kp <= tt) {
                bf16x8 bw[2]; s16x4 lo[2][2], hi[2][2];
#pragma unroll
                for (int q = 0; q < 2; ++q) { const int ks = 2 * kp + q; bw[q] = *(const LAS bf16x8*)(lds + woff + 32 * ks);
#pragma unroll
                    for (int dd = 0; dd < 2; ++dd) { const int dt = 2 * dp + dd; lo[q][dd] = vtr((const LAS char*)(lds + voff + (16 * ks) * VROW + dt * 64)); hi[q][dd] = vtr((const LAS char*)(lds + voff + (16 * ks + 4) * VROW + dt * 64)); } }
#pragma unroll
                for (int q = 0; q < 2; ++q)
#pragma unroll
                    for (int dd = 0; dd < 2; ++dd) acc[dd] = __builtin_amdgcn_mfma_f32_32x32x16_bf16(FRAG8(lo[q][dd], hi[q][dd]), bw[q], acc[dd], 0, 0, 0);
            }
        }
        { bf16_t* op = MIX + (R0 + t) * DM + 1024 + g * 128 + 4 * hh;
#pragma unroll
          for (int dd = 0; dd < 2; ++dd)
#pragma unroll
              for (int g4 = 0; g4 < 4; ++g4) { const int d0 = 32 * (2 * dp + dd) + 8 * g4; const u32x2 u2 = uw[dd][g4];
                  f32x4 v; v[0] = bflo(u2.x) * (acc[dd][4 * g4 + 0] + bs); v[1] = bfhi(u2.x) * (acc[dd][4 * g4 + 1] + bs); v[2] = bflo(u2.y) * (acc[dd][4 * g4 + 2] + bs); v[3] = bfhi(u2.y) * (acc[dd][4 * g4 + 3] + bs);
                  *(u32x2*)(op + d0) = pack4(v); } }
        __syncthreads();
    }
#undef GM_FETCH
}

__device__ __forceinline__ int queue_pop(unsigned* q, volatile LAS unsigned* slot) {
    if (opq_tid() == 0) *slot = __hip_atomic_fetch_add(q, 1u, __ATOMIC_RELAXED, __HIP_MEMORY_SCOPE_AGENT);
    __syncthreads();
    const int v = (int)*slot;
    __syncthreads();
    return v;
}
__device__ __forceinline__ void mixer_phase(KP_T P, LAS unsigned char* lds, int lyr, unsigned long long& st_dur) {
    unsigned* ctl = (unsigned*)(P->ws + WS_CTL);
    volatile LAS unsigned* slot = (volatile LAS unsigned*)(lds + LDS_MISC + 8);
    const float lam_init = lyr == 0 ? P->lam_init0 : P->lam_init1;
#ifndef MK_MX
#define MK_MX 7
#endif
#ifdef MK_STAMP
    unsigned long long t0_ = __builtin_amdgcn_s_memrealtime();
#define SUBST(id) do { const unsigned long long t1_ = __builtin_amdgcn_s_memrealtime(); if (MK_STAMP == (id)) st_dur += t1_ - t0_; t0_ = t1_; } while (0)
#define AGG(id) do { const unsigned long long t1_ = __builtin_amdgcn_s_memrealtime(); if (MK_STAMP == (id) && threadIdx.x == 0) __hip_atomic_fetch_add(ctl + CW_ERR + 16, (unsigned)(t1_ - t0_), __ATOMIC_RELAXED, __HIP_MEMORY_SCOPE_AGENT); t0_ = t1_; } while (0)
#else
#define SUBST(id) do {} while (0)
#define AGG(id) do {} while (0)
#endif
    unsigned* cvq = ctl + CW_QUEUE + 384 + 64 * lyr;
    if (((blockIdx.x >> 3) & 7) < CVSEL) for (;;) { const int i = queue_pop(cvq, slot); if (i >= CV_NCHUNK) break; convert_chunk(P, lds, lyr, i); }
    AGG(34);
    if (MK_MX & 4) for (;;) { const int i = queue_pop(ctl + CW_QUEUE + 192 * lyr + 128, slot); if (i >= (T / 128)) break;
        gmlp_unit(P, lds, lyr, i >> 5, i & 31); }
    AGG(35);
    if (MK_MX & 1) for (;;) { const int i = queue_pop(ctl + CW_QUEUE + 192 * lyr, slot); if (i >= 256) break;
        diff_unit(P, lds, lyr, (i & 7) >> 2, i & 3, 31 - (i >> 3), lam_init); }
    AGG(36);
    if (MK_MX & 2) for (;;) { const int i = queue_pop(ctl + CW_QUEUE + 192 * lyr + 64, slot); if (i >= 512) break;
        mla_unit(P, lds, (i & 15) >> 3, i & 7, 31 - (i >> 4)); }
    AGG(37);
    for (;;) { const int i = queue_pop(cvq, slot); if (i >= CV_NCHUNK) break; convert_chunk(P, lds, lyr, i); }
    AGG(34);
}
__device__ __forceinline__ void lnr_phase(KP_T P, LAS unsigned char* lds, int lyr, int vcu, int G, unsigned long long& st_dur) {
#ifdef MK_STAMP
    unsigned long long t0_ = __builtin_amdgcn_s_memrealtime();
#define LSUB(id) do { const unsigned long long t1_ = __builtin_amdgcn_s_memrealtime(); if (MK_STAMP == (id)) st_dur += t1_ - t0_; t0_ = t1_; } while (0)
#else
#define LSUB(id) do {} while (0)
#endif
    const int tid = opq_tid(), lane = tid & 63, wid = __builtin_amdgcn_readfirstlane(tid >> 6);
    const bf16_t* Y1 = (const bf16_t*)(P->ws + WS_Y1); const bf16_t* XBr = (const bf16_t*)(P->ws + WS_XB); bf16_t* X1B = (bf16_t*)(P->ws + WS_X1B);
    int* EIDX = (int*)(P->ws + WS_EIDX); float* EW = (float*)(P->ws + WS_EW); int* ELR = (int*)(P->ws + WS_ELR); int* HIST = (int*)(P->ws + WS_HIST);
    LAS float* xs = (LAS float*)lds;
    volatile LAS unsigned long long* selm = (volatile LAS unsigned long long*)(lds + LDS_MISC + 256);
    const float* g1 = P->ln1_g + lyr * DM; const float* b1 = P->ln1_b + lyr * DM;
    const float* rw = P->router_w + (size_t)lyr * DM * NEXP;
    const float rbias = P->router_bias[lyr * NEXP + lane];
    for (int u = vcu; u < RT_UNITS; u += G) {
        const int tok0 = u * RT_TOK;
        LSUB(44);
        const unsigned char* sbh = P->ws + WS_RTR + ((size_t)(lyr * 64 + 8 * wid) * 4) * 1024; asm volatile("" : "+s"(sbh));
        const unsigned char* sbl = sbh + (size_t)NLAYER * 16384 * 16; const unsigned lo16 = (unsigned)lane * 16u;
#define RT_LDH(q_) (*(const u32x4*)(sbh + (q_) * 1024 + lo16))
#define RT_LDL(q_) (*(const u32x4*)(sbl + (q_) * 1024 + lo16))
        u32x4 qh[8], ql[8];
#pragma unroll
        for (int q = 0; q < 8; ++q) { qh[q] = RT_LDH(q); ql[q] = RT_LDL(q); }
#pragma unroll
        for (int rr = 0; rr < 2; ++rr) { const int mrow = 2 * wid + rr; const size_t row = (size_t)(tok0 + mrow);
            f32x4 v[4][2]; float s = 0.f;
#pragma unroll
            for (int j = 0; j < 4; ++j) { const u32x4 w = *(const u32x4*)(Y1 + row * DM + 8 * lane + 512 * j), xw = *(const u32x4*)(XBr + row * DM + 8 * lane + 512 * j);
                v[j][0] = (f32x4){bflo(w.x), bfhi(w.x), bflo(w.y), bfhi(w.y)} + (f32x4){bflo(xw.x), bfhi(xw.x), bflo(xw.y), bfhi(xw.y)} * DN_ALPHA;
                v[j][1] = (f32x4){bflo(w.z), bfhi(w.z), bflo(w.w), bfhi(w.w)} + (f32x4){bflo(xw.z), bfhi(xw.z), bflo(xw.w), bfhi(xw.w)} * DN_ALPHA;
                s += ((v[j][0][0] + v[j][0][1]) + (v[j][0][2] + v[j][0][3])) + ((v[j][1][0] + v[j][1][1]) + (v[j][1][2] + v[j][1][3])); }
            const float mean = wave_sum(s) * (1.0f / DM); float q = 0.f;
#pragma unroll
            for (int j = 0; j < 4; ++j)
#pragma unroll
                for (int h = 0; h < 2; ++h) { v[j][h] = v[j][h] - mean; q += (v[j][h][0] * v[j][h][0] + v[j][h][1] * v[j][h][1]) + (v[j][h][2] * v[j][h][2] + v[j][h][3] * v[j][h][3]); }
            const float rstd = rsqrtf(wave_sum(q) * (1.0f / DM) + 1e-5f);
#pragma unroll
            for (int j = 0; j < 4; ++j) { const int col = 8 * lane + 512 * j;
                const f32x4 o0 = v[j][0] * rstd * *(const f32x4*)(g1 + col) + *(const f32x4*)(b1 + col), o1 = v[j][1] * rstd * *(const f32x4*)(g1 + col + 4) + *(const f32x4*)(b1 + col + 4);
                const u32x4 hi = pack8(o0, o1);
                *(u32x4*)(X1B + row * XSTR + col) = hi;
                const f32x4 r0 = o0 - (f32x4){bflo(hi.x), bfhi(hi.x), bflo(hi.y), bfhi(hi.y)}, r1 = o1 - (f32x4){bflo(hi.z), bfhi(hi.z), bflo(hi.w), bfhi(hi.w)};
                const int ch = (col >> 3) ^ (mrow & 7);
                *(LAS u32x4*)(lds + mrow * 4096 + 16 * ch) = hi; *(LAS u32x4*)(lds + 65536 + mrow * 4096 + 16 * ch) = pack8(r0, r1); } }
        __syncthreads();
        LSUB(41);
        f32x4 acc[4];
#pragma unroll
        for (int n = 0; n < 4; ++n) acc[n] = (f32x4){0.f, 0.f, 0.f, 0.f};
        { const int i = lane & 15, g = lane >> 4, sw = i & 7;
          const LAS unsigned char* ah = lds + i * 4096; const LAS unsigned char* al = ah + 65536;
#pragma unroll
          for (int s = 0; s < 8; ++s) {
              const bf16x8 Ah = *(const LAS bf16x8*)(ah + 16 * ((4 * (8 * wid + s) + g) ^ sw)), Al = *(const LAS bf16x8*)(al + 16 * ((4 * (8 * wid + s) + g) ^ sw));
              bf16x8 Bh[4], Bl[4];
#pragma unroll
              for (int n = 0; n < 4; ++n) { const int q = (s & 1) * 4 + n; Bh[n] = __builtin_bit_cast(bf16x8, qh[q]); Bl[n] = __builtin_bit_cast(bf16x8, ql[q]);
                  if (s < 6) { qh[q] = RT_LDH((s + 2) * 4 + n); ql[q] = RT_LDL((s + 2) * 4 + n); } }
#pragma unroll
              for (int n = 0; n < 4; ++n) acc[n] = __builtin_amdgcn_mfma_f32_16x16x32_bf16(Ah, Bh[n], acc[n], 0, 0, 0);
#pragma unroll
              for (int n = 0; n < 4; ++n) acc[n] = __builtin_amdgcn_mfma_f32_16x16x32_bf16(Ah, Bl[n], acc[n], 0, 0, 0);
#pragma unroll
              for (int n = 0; n < 4; ++n) acc[n] = __builtin_amdgcn_mfma_f32_16x16x32_bf16(Al, Bh[n], acc[n], 0, 0, 0);
              __builtin_amdgcn_sched_barrier(0); } }
#undef RT_LDH
#undef RT_LDL
        __syncthreads();
        LSUB(42);
        { LAS float* part = xs + wid * (16 * 64);
#pragma unroll
          for (int n = 0; n < 4; ++n)
#pragma unroll
              for (int r = 0; r < 4; ++r) part[(4 * (lane >> 4) + r) * 64 + 4 * (lane & 15) + n] = acc[n][r]; }
        __syncthreads();
#pragma unroll
        for (int rr = 0; rr < 2; ++rr) { const int tk = 2 * wid + rr; float logit = 0.f;
#pragma unroll
            for (int w = 0; w < 8; ++w) logit += xs[w * (16 * 64) + tk * 64 + lane];
            const float score = 1.0f / (1.0f + expf(-logit));
            const float biased = score + rbias;
            float t1 = -INFINITY, t2 = -INFINITY;
#pragma unroll
            for (int j = 0; j < 8; ++j) { const float o = __shfl(biased, (lane & ~7) + j); const float lo = fminf(t1, o); t1 = fmaxf(t1, o); t2 = fmaxf(t2, lo); }
            const float gs = t1 + t2; int grank = 0;
#pragma unroll
            for (int gp = 0; gp < 8; ++gp) { const float o = __int_as_float(__builtin_amdgcn_readlane(__float_as_int(gs), 8 * gp)); grank += (o > gs || (o == gs && gp < (lane >> 3))) ? 1 : 0; }
            const float v = (grank < 4) ? biased : -INFINITY;
            int rank = 0;
#pragma unroll
            for (int e = 0; e < 64; ++e) { const float o = __int_as_float(__builtin_amdgcn_readlane(__float_as_int(v), e)); rank += (o > v || (o == v && e < lane)) ? 1 : 0; }
            const bool chosen = rank < TOPK;
            const unsigned long long sm = __ballot(chosen);
            const float ssum = wave_sum(chosen ? score : 0.f);
            const int kpos = __builtin_popcountll(sm & ((1ull << lane) - 1ull));
            if (chosen) { EIDX[(size_t)(tok0 + tk) * 8 + kpos] = lane; EW[(size_t)(tok0 + tk) * 8 + kpos] = score / ssum * 2.5f; }
            if (lane == 0) selm[tk] = sm; }
        __syncthreads();
        { int bit[RT_TOK];
#pragma unroll
          for (int t2 = 0; t2 < RT_TOK; ++t2) bit[t2] = (int)((((const LAS unsigned long long*)(lds + LDS_MISC + 256))[t2] >> lane) & 1ull);
#pragma unroll
          for (int rr = 0; rr < 2; ++rr) { const int tk = 2 * wid + rr; const unsigned long long sm = ((const LAS unsigned long long*)(lds + LDS_MISC + 256))[tk];
              int lr = 0;
#pragma unroll
              for (int t2 = 0; t2 < RT_TOK; ++t2) lr += (t2 < tk) ? bit[t2] : 0;
              if ((sm >> lane) & 1ull) ELR[(size_t)(tok0 + tk) * 8 + __builtin_popcountll(sm & ((1ull << lane) - 1ull))] = lr; }
          if (wid == 0) { int hc = 0;
#pragma unroll
              for (int t2 = 0; t2 < RT_TOK; ++t2) hc += bit[t2];
              HIST[(size_t)u * 64 + lane] = hc; } }
        __syncthreads();
        LSUB(43);
    }
}

__device__ __forceinline__ void slot_phase(KP_T P, LAS unsigned char* lds, int vcu, int G) {
    const int tid = opq_tid(), lane = tid & 63, wid = __builtin_amdgcn_readfirstlane(tid >> 6);
    const int* HIST = (const int*)(P->ws + WS_HIST); const int* EIDX = (const int*)(P->ws + WS_EIDX); const float* EW = (const float*)(P->ws + WS_EW); const int* ELR = (const int*)(P->ws + WS_ELR);
    int* EOFF = (int*)(P->ws + WS_EOFF); int* SLOT = (int*)(P->ws + WS_SLOT); int* ROWIDX = (int*)(P->ws + WS_ROWIDX); float* GATEW = (float*)(P->ws + WS_GATEW);
    LAS int* tmp = (LAS int*)lds;
    LAS int* tot = tmp + 512;
    LAS int* off = tot + 64;
    LAS int* base = off + 72;
    LAS int* pre = base + 64;
    const int ua = vcu, ub = vcu + G;
    { int s = 0, sa = 0, sb = 0;
#pragma unroll 16
      for (int u = wid; u < RT_UNITS; u += 8) { const int hv = HIST[(size_t)u * 64 + lane]; s += hv; sa += (u < ua) ? hv : 0; sb += (u < ub) ? hv : 0; }
      tmp[wid * 64 + lane] = s; pre[wid * 64 + lane] = sa; pre[512 + wid * 64 + lane] = sb; }
    __syncthreads();
    if (tid < 64) { int s = 0;
#pragma unroll
        for (int w = 0; w < 8; ++w) s += tmp[w * 64 + tid]; tot[tid] = s; }
    __syncthreads();
    if (tid == 0) { int o = 0; for (int e = 0; e < NEXP; ++e) { off[e] = o; o += (tot[e] + 255) & ~255; } off[64] = o; off[65] = o + T; }
    __syncthreads();
    if (vcu == 0 && tid < 67) EOFF[tid] = tid < 66 ? off[tid] : off[65] / 256;
    if (vcu == 0 && tid >= 128 && tid < 192) EOFF[80 + tid - 128] = tot[tid - 128];
    for (int u = vcu, ui = 0; u < RT_UNITS; u += G, ++ui) {
        const LAS int* pp = ui < 2 ? pre + ui * 512 : tmp;
        if (ui >= 2) {
            int s = 0;
#pragma unroll 16
            for (int u2 = wid; u2 < RT_UNITS; u2 += 8) { const int hv = HIST[(size_t)u2 * 64 + lane]; s += (u2 < u) ? hv : 0; }
            tmp[wid * 64 + lane] = s;
            __syncthreads(); }
        if (tid < 64) { int s = off[tid];
#pragma unroll
            for (int w = 0; w < 8; ++w) s += pp[w * 64 + tid]; base[tid] = s; }
        __syncthreads();
        if (tid < RT_TOK * 8) { const size_t i = (size_t)u * (RT_TOK * 8) + tid; const int e = EIDX[i], slot = base[e] + ELR[i];
            SLOT[i] = slot; ROWIDX[slot] = (int)(i >> 3); }
        __syncthreads();
    }
    for (int e = vcu; e < NEXP; e += G) for (int s = off[e] + tot[e] + tid; s < off[e + 1]; s += NTHREADS) ROWIDX[s] = 0;
    for (int t = vcu * NTHREADS + tid; t < T; t += G * NTHREADS) ROWIDX[off[64] + t] = t;
}

__device__ __forceinline__ int moe_tables(KP_T P, LAS unsigned char* lds) {
    const int* EOFF = (const int*)(P->ws + WS_EOFF);
    LAS int* eo = (LAS int*)(lds + LDS_MISC + 384);
    LAS int* t2e = (LAS int*)(lds + LDS_MISC + 1024);
    const int tid = opq_tid();
    if (tid < 67) eo[tid] = EOFF[tid];
    if (tid >= 128 && tid < 192) eo[80 + tid - 128] = EOFF[80 + tid - 128];
    __syncthreads();
    const int ntiles = eo[66];
    for (int mt = tid; mt < ntiles; mt += NTHREADS) { int e = 0; for (int k = 1; k <= NEXP; ++k) e = (mt * 256 >= eo[k]) ? k : e; t2e[mt] = e; }
    __syncthreads();
    { const int lane = tid & 63, w = tid >> 6; const bool act = tid < ntiles; int valid = 0;
      if (act) { const int e = t2e[tid]; valid = (e == NEXP ? T : eo[80 + e]) - (tid * 256 - eo[e]); }
      const bool heavy = act && valid > 128, light = act && valid <= 128;
      const unsigned long long hb = __ballot(heavy), lb = __ballot(light);
      LAS int* wc = (LAS int*)(lds + LDS_MISC + 64);
      if (lane == 0) { wc[w] = __builtin_popcountll(hb); wc[8 + w] = __builtin_popcountll(lb); }
      __syncthreads();
      int ph = 0, pl = 0, nh = 0;
#pragma unroll
      for (int k = 0; k < 8; ++k) { const int ch = wc[k], cl = wc[8 + k]; nh += ch; if (k < w) { ph += ch; pl += cl; } }
      const unsigned long long lt = (1ull << lane) - 1ull;
      if (heavy) t2e[MAXTILES + ph + __builtin_popcountll(hb & lt)] = tid;
      if (light) t2e[MAXTILES + nh + pl + __builtin_popcountll(lb & lt)] = tid | (1 << 16); }
    __syncthreads();
    return ntiles;
}

__device__ __forceinline__ void combine_phase(KP_T P, int lyr, int vcu, int G) {
    const int tid = opq_tid(), lane = tid & 63, wid = __builtin_amdgcn_readfirstlane(tid >> 6);
    const bf16_t* X1B = (const bf16_t*)(P->ws + WS_X1B); const unsigned char* YM = (const unsigned char*)(P->ws + WS_YMOE); const int* SLOT = (const int*)(P->ws + WS_SLOT); const int* EOFF = (const int*)(P->ws + WS_EOFF);
    bf16_t* XB = (bf16_t*)(P->ws + WS_XB);
    const float* g2 = P->ln2_g + lyr * DM; const float* b2 = P->ln2_b + lyr * DM; const float* EW = (const float*)(P->ws + WS_EW);
    const int shoff = EOFF[64];
    for (int tok = vcu * NWAVES + wid; tok < T; tok += G * NWAVES) {
        int slot[9]; float gw[9];
#pragma unroll
        for (int k = 0; k < 8; ++k) { slot[k] = SLOT[(size_t)tok * 8 + k]; gw[k] = EW[(size_t)tok * 8 + k] * 0.125f; }
        slot[8] = shoff + tok; gw[8] = 0.125f;
        u32x4 yw[9][2];
#pragma unroll
        for (int k = 0; k < 9; ++k)
#pragma unroll
            for (int j = 0; j < 2; ++j) yw[k][j] = *(const u32x4*)(YM + (size_t)slot[k] * DM + 16 * lane + 1024 * j);
        f32x4 v[2][4];
#pragma unroll
        for (int j = 0; j < 2; ++j) { const bf16_t* xp = X1B + (size_t)tok * XSTR + 16 * lane + 1024 * j; const u32x4 w0 = *(const u32x4*)xp, w1 = *(const u32x4*)(xp + 8);
            v[j][0] = (f32x4){bflo(w0.x), bfhi(w0.x), bflo(w0.y), bfhi(w0.y)} * DN_ALPHA; v[j][1] = (f32x4){bflo(w0.z), bfhi(w0.z), bflo(w0.w), bfhi(w0.w)} * DN_ALPHA;
            v[j][2] = (f32x4){bflo(w1.x), bfhi(w1.x), bflo(w1.y), bfhi(w1.y)} * DN_ALPHA; v[j][3] = (f32x4){bflo(w1.z), bfhi(w1.z), bflo(w1.w), bfhi(w1.w)} * DN_ALPHA; }
#pragma unroll
        for (int k = 0; k < 9; ++k)
#pragma unroll
            for (int j = 0; j < 2; ++j) { const u32x4 w = yw[k][j]; const float g = gw[k];
                v[j][0] += (f32x4){__builtin_amdgcn_cvt_f32_fp8((int)w.x, 0), __builtin_amdgcn_cvt_f32_fp8((int)w.x, 1), __builtin_amdgcn_cvt_f32_fp8((int)w.x, 2), __builtin_amdgcn_cvt_f32_fp8((int)w.x, 3)} * g;
                v[j][1] += (f32x4){__builtin_amdgcn_cvt_f32_fp8((int)w.y, 0), __builtin_amdgcn_cvt_f32_fp8((int)w.y, 1), __builtin_amdgcn_cvt_f32_fp8((int)w.y, 2), __builtin_amdgcn_cvt_f32_fp8((int)w.y, 3)} * g;
                v[j][2] += (f32x4){__builtin_amdgcn_cvt_f32_fp8((int)w.z, 0), __builtin_amdgcn_cvt_f32_fp8((int)w.z, 1), __builtin_amdgcn_cvt_f32_fp8((int)w.z, 2), __builtin_amdgcn_cvt_f32_fp8((int)w.z, 3)} * g;
                v[j][3] += (f32x4){__builtin_amdgcn_cvt_f32_fp8((int)w.w, 0), __builtin_amdgcn_cvt_f32_fp8((int)w.w, 1), __builtin_amdgcn_cvt_f32_fp8((int)w.w, 2), __builtin_amdgcn_cvt_f32_fp8((int)w.w, 3)} * g; }
        float s = 0.f;
#pragma unroll
        for (int j = 0; j < 2; ++j)
#pragma unroll
            for (int q = 0; q < 4; ++q) s += (v[j][q][0] + v[j][q][1]) + (v[j][q][2] + v[j][q][3]);
        const float mean = wave_sum(s) * (1.0f / DM); float qq = 0.f;
#pragma unroll
        for (int j = 0; j < 2; ++j)
#pragma unroll
            for (int q = 0; q < 4; ++q) { v[j][q] = v[j][q] - mean; qq += (v[j][q][0] * v[j][q][0] + v[j][q][1] * v[j][q][1]) + (v[j][q][2] * v[j][q][2] + v[j][q][3] * v[j][q][3]); }
        const float rstd = rsqrtf(wave_sum(qq) * (1.0f / DM) + 1e-5f);
#pragma unroll
        for (int j = 0; j < 2; ++j) { const int col = 16 * lane + 1024 * j; f32x4 o[4];
#pragma unroll
            for (int q = 0; q < 4; ++q) o[q] = v[j][q] * rstd * *(const f32x4*)(g2 + col + 4 * q) + *(const f32x4*)(b2 + col + 4 * q);
            if (lyr == NLAYER - 1) {
#pragma unroll
                for (int q = 0; q < 4; ++q) *(f32x4*)(P->out + (size_t)tok * DM + col + 4 * q) = o[q]; }
            else { *(u32x4*)(XB + (size_t)tok * DM + col) = pack8(o[0], o[1]); *(u32x4*)(XB + (size_t)tok * DM + col + 8) = pack8(o[2], o[3]); } }
    }
}
#ifndef MK_EN
#define MK_EN 0x3ff
#endif
#define EN(k) ((MK_EN >> (k)) & 1)
__global__ void __launch_bounds__(NTHREADS, 2) fwd(Params Parg) {
    extern __shared__ __attribute__((aligned(16))) unsigned char lds_raw[];
    LAS unsigned char* lds0 = (LAS unsigned char*)lds_raw;
    KP_T KP = (KP_T)__builtin_amdgcn_kernarg_segment_ptr();
    const int tid = threadIdx.x, G0 = gridDim.x, bx0 = blockIdx.x;
    const int vcu0 = (G0 % 8 == 0) ? (bx0 % 8) * (G0 / 8) + bx0 / 8 : bx0;
    for (int i = tid; i < (LDS_BYTES - LDS_MISC) / 4; i += NTHREADS) ((LAS unsigned*)(lds0 + LDS_MISC))[i] = 0u;
    __syncthreads();
    const int ph_lo = KP->ph_lo, ph_hi = KP->ph_hi, use_bar = KP->use_bar;
    XcdBarrier bar; bar.bar = (unsigned*)(KP->ws + WS_CTL) + CW_BAR; bar.x = 0; bar.st = (volatile LAS unsigned*)(lds0 + LDS_MISC);
    if (use_bar) bar = xcd_barrier_post(bar.bar, (volatile LAS unsigned*)(lds0 + LDS_MISC));
#define IN(k) (ph_lo <= (k) && (k) < ph_hi)
#define PHASE_BEGIN() KP_T P = KP; int G = G0, bx = bx0, vcu = vcu0, l = l0; unsigned lo_ = 0u; asm volatile("" : "+s"(P), "+s"(G), "+s"(bx), "+s"(vcu), "+s"(lo_), "+s"(l)); LAS unsigned char* lds = lds0 + lo_; (void)G; (void)bx; (void)vcu; (void)lds; (void)l
#define SEAM(k) do { if (IN(k) && IN((k) + 1) && use_bar) xcd_barrier(bar); } while (0)
#ifdef MK_STAMP
    unsigned long long st_dur = 0ull, st_t0 = 0ull;
    unsigned long long st_c0 = 0ull, st_dc = 0ull, st_dr = 0ull;
#define ST_BEGIN(ty) do { if ((ty) == MK_STAMP) st_t0 = __builtin_amdgcn_s_memrealtime(); if (MK_STAMP == 77 && (ty) == 7) { st_t0 = __builtin_amdgcn_s_memrealtime(); st_c0 = __builtin_amdgcn_s_memtime(); } } while (0)
#define ST_END(ty) do { if ((ty) == MK_STAMP) st_dur += __builtin_amdgcn_s_memrealtime() - st_t0; if (MK_STAMP == 77 && (ty) == 7) { st_dr += __builtin_amdgcn_s_memrealtime() - st_t0; st_dc += __builtin_amdgcn_s_memtime() - st_c0; } } while (0)
#else
    unsigned long long st_dur = 0ull;
#define ST_BEGIN(ty) do {} while (0)
#define ST_END(ty) do {} while (0)
#endif

    unsigned long long gstv[2] = {0ull, 0ull}; unsigned long long* gstp = nullptr;
#ifdef MK_STAMP
    if (MK_STAMP == 61 || MK_STAMP == 62) gstp = gstv;
#endif
    ST_BEGIN(0);
    { const int l0 = 0; if (EN(0) && IN(PH_PRO)) { PHASE_BEGIN(); prologue_phase(P, lds, vcu, G); } }
    SEAM(PH_PRO);
    ST_END(0);
    for (int l0 = 0; l0 < NLAYER; ++l0) {
        const int pb = PH_L0 + PHL_N * l0;
        ST_BEGIN(1);
        if (EN(1) && IN(pb + PHL_G1)) {
            PHASE_BEGIN(); unsigned char* ws = P->ws;
            SchedDense S{DM, DM, T / 256, 8, 0, G, bx};
            Epi1 E{(bf16_t*)(ws + WS_HB), (float*)(ws + WS_RSS), (bf16_t*)(ws + WS_KB), (const float*)(ws + WS_ROPE), (const float*)(ws + WS_ROPE) + SEQ * 32};
            pg8::gemm_phase<Epi1, SchedDense, false>(nullptr, lds, (const char*)(ws + WS_XB), (const char*)(ws + WS_WIN + l * SZ_WIN), nullptr, DM, DM, DM, S, E);
        }
        SEAM(pb + PHL_G1);
        ST_END(1);
        ST_BEGIN(2);
        if (EN(2) && IN(pb + PHL_G2)) {
            PHASE_BEGIN(); unsigned char* ws = P->ws;
            { SchedDense S{DM, DM, T / 256, 6, 8, 192, bx};
              Epi1 E{(bf16_t*)(ws + WS_HB), (float*)(ws + WS_RSS), (bf16_t*)(ws + WS_KB), (const float*)(ws + WS_ROPE), (const float*)(ws + WS_ROPE) + SEQ * 32};
              pg8::gemm_phase<Epi1, SchedDense, false>(nullptr, lds, (const char*)(ws + WS_XB), (const char*)(ws + WS_WIN + l * SZ_WIN), nullptr, DM, DM, DM, S, E); }
            { SchedDense S{HW, 512, T / 256, 1536 / 256, 0, 64, bx - 192};
              Epi2 E{0, (const float*)(ws + WS_RSS), (bf16_t*)(ws + WS_QB), (bf16_t*)(ws + WS_KB), (bf16_t*)(ws + WS_VB), (const float*)(ws + WS_ROPE), (const float*)(ws + WS_ROPE) + SEQ * 32};
              pg8::gemm_phase<Epi2, SchedDense, false>(nullptr, lds, (const char*)(ws + WS_HB) + HC_CQ * 2, (const char*)(ws + WS_WUQ + l * SZ_WUQ), nullptr, 512, HW, 512, S, E); }
            { SchedDense S{HW, 256, T / 256, 2048 / 256, 0, G, bx};
              Epi2 E{1, (const float*)(ws + WS_RSS), (bf16_t*)(ws + WS_QB), (bf16_t*)(ws + WS_KB), (bf16_t*)(ws + WS_VB), (const float*)(ws + WS_ROPE), (const float*)(ws + WS_ROPE) + SEQ * 32};
              pg8::gemm_phase<Epi2, SchedDense, false>(nullptr, lds, (const char*)(ws + WS_HB) + HC_CKV * 2, (const char*)(ws + WS_WUKV + l * SZ_WUKV), nullptr, 256, HW, 256, S, E); }
        }
        SEAM(pb + PHL_G2);
        ST_END(2);
        ST_BEGIN(3);
        if (EN(3) && IN(pb + PHL_MIX)) { PHASE_BEGIN(); mixer_phase(P, lds, l, st_dur); }
        SEAM(pb + PHL_MIX);
        ST_END(3);
        ST_BEGIN(4);
        if (EN(4) && IN(pb + PHL_WO)) {
            PHASE_BEGIN(); unsigned char* ws = P->ws;
            SchedDense S{DM, DM, T / 256, DM / 256, 0, G, bx};
            EpiWO E{(bf16_t*)(ws + WS_Y1)};
            pg8::gemm_phase<EpiWO, SchedDense, false>(nullptr, lds, (const char*)(ws + WS_MIX), (const char*)(ws + WS_WO + l * SZ_WO), nullptr, DM, DM, DM, S, E);
        }
        SEAM(pb + PHL_WO);
        ST_END(4);
        ST_BEGIN(5);
        if (EN(5) && IN(pb + PHL_LNR)) { PHASE_BEGIN(); lnr_phase(P, lds, l, vcu, G, st_dur); }
        SEAM(pb + PHL_LNR);
        ST_END(5);
        ST_BEGIN(6);
        if (EN(6) && IN(pb + PHL_SLOT)) { PHASE_BEGIN(); slot_phase(P, lds, vcu, G); }
        SEAM(pb + PHL_SLOT);
        ST_END(6);
        ST_BEGIN(7);
        if (EN(7) && IN(pb + PHL_GU)) {
            PHASE_BEGIN(); unsigned char* ws = P->ws;
            const int ntiles = moe_tables(P, lds);
            SchedMoE S{(const LAS int*)(lds + LDS_MISC + 1024), (unsigned)SZ_WGU1, 0, WGSTR, 4, ntiles * 4, G, vcu};
            EpiGU E{(bf16_t*)(ws + WS_HMOE)};
            LAS int* gidx = (LAS int*)(lds + LDS_GIDX);
            { const int* RI = (const int*)(ws + WS_ROWIDX); const int t_ = opq_tid(), hi_ = t_ >> 8, row_ = t_ & 255; int iv_[4];
#pragma unroll
              for (int s_ = 0; s_ < 4; ++s_) { pg8::Unit u_; iv_[s_] = S.next(2 * s_ + hi_, u_) ? RI[u_.r0 + row_] : 0; }
#pragma unroll
              for (int s_ = 0; s_ < 4; ++s_) gidx[(2 * s_ + hi_) * 256 + row_] = iv_[s_];
              __syncthreads(); }
            pg8::gemm_phase<EpiGU, SchedMoE, true>(gstp, lds, (const char*)(ws + WS_X1B), (const char*)(ws + WS_WGU + l * SZ_WGU), gidx, DM, XSTR, WGSTR, S, E);
        }
        SEAM(pb + PHL_GU);
        ST_END(7);
        ST_BEGIN(8);
        if (EN(8) && IN(pb + PHL_DN)) {
            PHASE_BEGIN(); unsigned char* ws = P->ws;
            const int ntiles = use_bar ? ((const LAS int*)(lds + LDS_MISC + 384))[66] : moe_tables(P, lds);
            SchedMoE S{(const LAS int*)(lds + LDS_MISC + 1024), (unsigned)SZ_WD1, HSTR * 2, WDSTR, 8, ntiles * 8, G, vcu};
            EpiDN E{(unsigned char*)(ws + WS_YMOE)};
            pg8::gemm_phase<EpiDN, SchedMoE, false>(nullptr, lds, (const char*)(ws + WS_HMOE), (const char*)(ws + WS_WD + l * SZ_WD), nullptr, EDIM, HSTR, WDSTR, S, E);
        }
        SEAM(pb + PHL_DN);
        ST_END(8);
        ST_BEGIN(9);
        if (EN(9) && IN(pb + PHL_CMB)) { PHASE_BEGIN(); combine_phase(P, l, vcu, G); }
        SEAM(pb + PHL_CMB);
        ST_END(9);
    }
#ifdef MK_STAMP
    if (MK_STAMP == 61) st_dur = gstv[0]; if (MK_STAMP == 62) st_dur = gstv[1];
    if (MK_STAMP >= 34 && MK_STAMP <= 37) st_dur = __hip_atomic_load((unsigned*)(KP->ws + WS_CTL) + CW_ERR + 16, __ATOMIC_RELAXED, __HIP_MEMORY_SCOPE_AGENT) / 256u;
    if (MK_STAMP == 77) st_dur = st_dr ? 2500ull * st_dc / st_dr : 0ull;
    if (bx0 == 0 && threadIdx.x == 0) { const unsigned long long te = __builtin_amdgcn_s_memrealtime(); while (__builtin_amdgcn_s_memrealtime() - te < 4ull * st_dur) __builtin_amdgcn_s_sleep(8); }
#endif
#undef IN
#undef SEAM
}
#ifndef MK_MULTI
#define MK_MULTI 0
#endif
extern "C" void kernel_launch(void* const* d_in, const int* in_sizes, int n_in, void* d_out, int out_size, void* d_ws, size_t ws_size, hipStream_t stream) {
    static int grid = 0;
    if (grid == 0) {
        if (n_in != 29 || out_size != T * DM || ws_size < WS_END) { fprintf(stderr, "kernel_launch: unexpected shapes (n_in %d, out %d, ws %zu < %zu)\n", n_in, out_size, ws_size, (size_t)WS_END); grid = -1; return; }
        int dev = 0, cus = 0, per_cu = 0;
        if (hipGetDevice(&dev) != hipSuccess || hipDeviceGetAttribute(&cus, hipDeviceAttributeMultiprocessorCount, dev) != hipSuccess) { grid = -1; return; }
        if (hipFuncSetAttribute((const void*)fwd, hipFuncAttributeMaxDynamicSharedMemorySize, LDS_BYTES) != hipSuccess) { fprintf(stderr, "kernel_launch: hipFuncSetAttribute failed\n"); grid = -1; return; }
        if (hipOccupancyMaxActiveBlocksPerMultiprocessor(&per_cu, (const void*)fwd, NTHREADS, LDS_BYTES) != hipSuccess || per_cu < 1) { fprintf(stderr, "kernel_launch: occupancy query says %d\n", per_cu); }
        (void)hipGetLastError();
        grid = cus;
    }
    if (grid < 0) return;
    (void)hipMemsetAsync((char*)d_ws + WS_CTL, 0, CTL_ZERO_BYTES, stream);
    Params p{};
    const float** f = (const float**)&p;
    for (int i = 0; i < 29; ++i) f[i] = (const float*)d_in[i];
    p.out = (float*)d_out; p.ws = (unsigned char*)d_ws; p.dbg = 0;
    p.lam_init0 = (float)(0.8 - 0.6 * exp(-0.3 * 0.0)); p.lam_init1 = (float)(0.8 - 0.6 * exp(-0.3 * 1.0));
#if MK_MULTI
    for (int ph = 0; ph < PH_END; ++ph) {
        p.ph_lo = ph; p.ph_hi = ph + 1; p.use_bar = 0;
        hipLaunchKernelGGL(fwd, dim3(grid), dim3(NTHREADS), LDS_BYTES, stream, p);
#if MK_DBG
        dbg_after_phase(p, ph, stream);
#endif
    }
#if MK_DBG
    hipLaunchKernelGGL(dbg_report, dim3(256), dim3(256), 0, stream, p);
#endif
#else
    p.ph_lo = 0; p.ph_hi = PH_END; p.use_bar = 1;
    hipLaunchKernelGGL(fwd, dim3(grid), dim3(NTHREADS), LDS_BYTES, stream, p);
#endif
}
```

```cpp
#include <hip/hip_runtime.h>
#include <cstdio>
#include <cstdint>
#include <cmath>

#define LAS __attribute__((address_space(3)))
#define GAS __attribute__((address_space(1)))
typedef unsigned short bf16_t;
typedef short bf16x8 __attribute__((ext_vector_type(8)));
typedef short s16x4 __attribute__((ext_vector_type(4)));
typedef float f32x2 __attribute__((ext_vector_type(2)));
typedef float f32x4 __attribute__((ext_vector_type(4)));
typedef float f32x16 __attribute__((ext_vector_type(16)));
typedef unsigned u32x2 __attribute__((ext_vector_type(2)));
typedef unsigned u32x4 __attribute__((ext_vector_type(4)));
typedef __bf16 bf16x2_t __attribute__((ext_vector_type(2)));

constexpr int NB = 2, SEQ = 4096, T = NB * SEQ, DM = 2048, NLAYER = 2;
constexpr int IN_W = 3392;
constexpr int HW = 3584;
constexpr int HC_CQ = 0, HC_CKV = 512, HC_GU = 768, HC_GV = 1280, HC_DQ = 1792, HC_DK = 2304, HC_DV = 2816, HC_KR = 3328;
constexpr int NEXP = 64, NEXP1 = 65, EDIM = 512, TOPK = 8;
constexpr int MAXTILES = 352, NSLOT = MAXTILES * 256;
constexpr int NWAVES = 8, NTHREADS = 512;
constexpr float LOG2E = 1.4426950408889634f;
constexpr float DN_ALPHA = 1.4142135623730951f;
constexpr int RT_TOK = 16, RT_UNITS = T / RT_TOK;

__device__ __forceinline__ unsigned cvtpk(float lo, float hi) { f32x2 v = {lo, hi}; bf16x2_t b = __builtin_convertvector(v, bf16x2_t); return __builtin_bit_cast(unsigned, b); }
__device__ __forceinline__ float bf2f(unsigned short h) { return __uint_as_float(((unsigned)h) << 16); }
__device__ __forceinline__ float bflo(unsigned w) { return __uint_as_float(w << 16); }
__device__ __forceinline__ float bfhi(unsigned w) { return __uint_as_float(w & 0xffff0000u); }
__device__ __forceinline__ float wave_sum(float v) {
#pragma unroll
    for (int o = 1; o < 64; o <<= 1) v += __shfl_xor(v, o);
    return v;
}
__device__ __forceinline__ float wave_max(float v) {
#pragma unroll
    for (int o = 1; o < 64; o <<= 1) v = fmaxf(v, __shfl_xor(v, o));
    return v;
}
__device__ __forceinline__ float gelu_tanh(float x) {
    const float u = 0.7978845608028654f * (x + 0.044715f * x * x * x);
    const float e = __builtin_amdgcn_exp2f(u * (2.0f * LOG2E));
    const float th = 1.0f - 2.0f * __builtin_amdgcn_rcpf(e + 1.0f);
    return 0.5f * x * (1.0f + th);
}
__device__ __forceinline__ float sigmoidf_(float x) { return __builtin_amdgcn_rcpf(1.0f + __builtin_amdgcn_exp2f(-LOG2E * x)); }
__device__ __forceinline__ int opq_tid() { int t = threadIdx.x; asm volatile("" : "+v"(t)); return t; }
#define LDS_WAIT() asm volatile("s_waitcnt lgkmcnt(0)" ::: "memory")
#define VM_WAIT() asm volatile("s_waitcnt vmcnt(0)" ::: "memory")

#define XB_TMO      128
#define XB_XCNT(j)  (256  + 64 * (j))
#define XB_XSUB(j)  (1280 + 64 * (j))
#define XB_XGEN(j)  (2304 + 64 * (j))
#define XB_TOP      3328
#define XB_TOPGEN   3392
#define XCD_BAR_WORDS 3456
#define XB_SPIN_CAP (1u << 18)
__device__ __forceinline__ unsigned xb_ld(unsigned* p)              { return __hip_atomic_load(p, __ATOMIC_RELAXED, __HIP_MEMORY_SCOPE_AGENT); }
__device__ __forceinline__ unsigned xb_add(unsigned* p, unsigned v) { return __hip_atomic_fetch_add(p, v, __ATOMIC_RELAXED, __HIP_MEMORY_SCOPE_AGENT); }
__device__ __forceinline__ unsigned xb_xcc_id() { return (unsigned)__builtin_amdgcn_s_getreg((3 << 11) | 20) & 0xFu; }
#define XB_SPIN(cond, bar) do { unsigned _sp = 0; while (cond) { __builtin_amdgcn_s_sleep(1); \
    if ((++_sp & 255u) == 0u) { if (xb_ld(&(bar)[XB_TMO])) break; if (_sp > XB_SPIN_CAP) { atomicAdd(&(bar)[XB_TMO], 1u); break; } } } } while (0)
struct XcdBarrier { unsigned* bar; unsigned x; volatile LAS unsigned* st; };
__device__ __forceinline__ XcdBarrier xcd_barrier_post(unsigned* bar, volatile LAS unsigned* st) {
    XcdBarrier b; b.bar = bar; b.x = xb_xcc_id(); b.st = st;
    if (threadIdx.x == 0) (void)xb_add(&bar[XB_XCNT(b.x)], 1u);
    return b;
}
__device__ __forceinline__ void xcd_barrier_complete(unsigned* bar, unsigned x, unsigned& nloc, unsigned& nx) {
    const unsigned G = gridDim.x * gridDim.y * gridDim.z;
    unsigned sum, cnt, mine, sp = 0u;
    for (;;) {
        sum = 0u; cnt = 0u; mine = 0u;
#pragma unroll 1
        for (unsigned j = 0; j < 16; ++j) { const unsigned c = xb_ld(&bar[XB_XCNT(j)]); sum += c; cnt += (c > 0u) ? 1u : 0u; mine = (j == x) ? c : mine; }
        if (sum == G) break;
        __builtin_amdgcn_s_sleep(1);
        if ((++sp & 255u) == 0u) { if (xb_ld(&bar[XB_TMO])) break; if (sp > XB_SPIN_CAP) { atomicAdd(&bar[XB_TMO], 1u); break; } }
    }
    nloc = mine > 0u ? mine : 1u; nx = cnt > 0u ? cnt : 1u;
}
__device__ __forceinline__ void xcd_barrier(const XcdBarrier& b) {
    asm volatile("s_waitcnt vmcnt(0)" ::: "memory");
    __syncthreads();
    if (threadIdx.x == 0) {
        unsigned* bar = b.bar; asm volatile("" : "+s"(bar));
        __builtin_amdgcn_s_waitcnt(0);
        volatile LAS unsigned* st = b.st; asm volatile("" : "+s"(st));
        unsigned nloc = st[0], nx = st[1];
        if (nloc == 0u) { xcd_barrier_complete(bar, b.x, nloc, nx); st[0] = nloc; st[1] = nx; }
        const unsigned old = xb_add(&bar[XB_XSUB(b.x)], 1u);
        const unsigned gen = old / nloc;
        if (old + 1u == (gen + 1u) * nloc) {
            __builtin_amdgcn_fence(__ATOMIC_RELEASE, "agent");
            asm volatile("s_waitcnt vmcnt(0)" ::: "memory");
            const unsigned og = xb_add(&bar[XB_TOP], 1u);
            const unsigned tg = og / nx;
            if (og + 1u == (tg + 1u) * nx) xb_add(&bar[XB_TOPGEN], 1u);
            else XB_SPIN(xb_ld(&bar[XB_TOPGEN]) == tg, bar);
            __builtin_amdgcn_fence(__ATOMIC_ACQUIRE, "agent");
            xb_add(&bar[XB_XGEN(b.x)], 1u);
            asm volatile("s_waitcnt vmcnt(0)" ::: "memory");
        } else {
            XB_SPIN(xb_ld(&bar[XB_XGEN(b.x)]) == gen, bar);
            __builtin_amdgcn_fence(__ATOMIC_ACQUIRE, "agent");
            asm volatile("s_waitcnt vmcnt(0)" ::: "memory");
        }
    }
    __syncthreads();
}

namespace pg8 {
constexpr int BM = 256, BK = 64, HALF = 128, HTB = HALF * BK * 2, STAGE_BYTES = 8 * HTB, NXCD = 8, WGM = 8;
__host__ __device__ __forceinline__ int lds_byte(int r, int c) { const int st = (r >> 4) * 2 + (c >> 5), rr = r & 15, cc = c & 31, ob = rr * 64 + cc * 2; return st * 1024 + (ob ^ (((ob >> 9) & 1) << 5)); }
__host__ __device__ __forceinline__ void stage_rc(int b, int& R, int& C) { const int st = b / 1024, sb = b % 1024, swz = sb ^ (((sb >> 9) & 1) << 5); R = (st >> 1) * 16 + swz / 64; C = (st & 1) * 32 + (swz % 64) / 2; }
__host__ __device__ __forceinline__ int perm32(int rho) { const int n = rho >> 4, i = rho & 15; return 8 * (i >> 2) + 4 * n + (i & 3); }

struct Unit { unsigned a, b; int r0, pn, half; };

__device__ __forceinline__ bool dense_tile(int i, int G, int c, int nM, int nN, int& pm, int& pn) {
    const int nwg = nM * nN; const long L = (long)i * G + c; if (L >= nwg) return false;
    int wgid = (int)L; { const int q = nwg / NXCD, r = nwg % NXCD, xcd = wgid % NXCD, off = wgid / NXCD; wgid = (xcd < r ? xcd * (q + 1) : r * (q + 1) + (xcd - r) * q) + off; }
    const int nig = WGM * nN, gid = wgid / nig, fm = gid * WGM, gsz = (nM - fm) < WGM ? (nM - fm) : WGM;
    pm = fm + ((wgid % nig) % gsz); pn = (wgid % nig) / gsz; return true;
}

template <class Epi, class Sched, bool GATHER, bool ALIGN_EPI = true>
__device__ __forceinline__ void gemm_phase(unsigned long long* gst, LAS unsigned char* lds, const char* Ab, const char* Bb, const LAS int* rowidx, const int K, const int lda, const int ldb, const Sched& S, const Epi& E) {
    const int tid = opq_tid(), wid = __builtin_amdgcn_readfirstlane(tid >> 6), lane = tid & 63, wr = wid >> 2, wc = wid & 3, fr = lane & 15, fq = lane >> 4;
    const int nt = K / BK;
    int Rr[2], Cc[2];
    unsigned voffA[2][2], voffB[2];
#pragma unroll
    for (int i = 0; i < 2; ++i) { int R, C; stage_rc(tid * 16 + i * 8192, R, C); Rr[i] = R; Cc[i] = C; const int Rb = Epi::PERM ? ((R & ~31) + perm32(R & 31)) : R;
        voffB[i] = (unsigned)(Rb * ldb + C) * 2u;
        voffA[0][i] = (unsigned)(R * lda + C) * 2u; voffA[1][i] = (unsigned)((R + HALF) * lda + C) * 2u; }
    const size_t kstep = (size_t)(BK * 2);
    const size_t hstepB = (size_t)HALF * ldb * 2;
    const unsigned ldsw = (unsigned)wid * 1024u;
    const int aoff = lds_byte(wr * 64 + fr, fq * 8), boff = lds_byte(wc * 32 + fr, fq * 8);
#define PG8_SA(b, h) (((b) * 2 + (h)) * HTB)
#define PG8_SB(b, h) ((4 + (b) * 2 + (h)) * HTB)
#define PG8_STAGE(bufoff, gbase, voff) do { _Pragma("unroll") for (int _i = 0; _i < 2; ++_i) \
        __builtin_amdgcn_global_load_lds((const unsigned*)((const char*)(gbase) + (voff)[_i]), (LAS unsigned*)(lds + (bufoff) + ldsw + _i * 8192), 16, 0, 0); } while (0)
#define PG8_LDA(dst, b, h) do { _Pragma("unroll") for (int m = 0; m < 4; ++m) _Pragma("unroll") for (int k = 0; k < 2; ++k) dst[m][k] = *(const LAS bf16x8*)(lds + PG8_SA(b, h) + aoff + m * 2048 + k * 1024); } while (0)
#define PG8_LDB(dst, b, h) do { _Pragma("unroll") for (int n = 0; n < 2; ++n) _Pragma("unroll") for (int k = 0; k < 2; ++k) dst[n][k] = *(const LAS bf16x8*)(lds + PG8_SB(b, h) + boff + n * 2048 + k * 1024); } while (0)
#define PG8_MMA(ai, bj, At, Bt) do { __builtin_amdgcn_s_setprio(1); _Pragma("unroll") for (int m = 0; m < 4; ++m) _Pragma("unroll") for (int n = 0; n < 2; ++n) _Pragma("unroll") for (int k = 0; k < 2; ++k) \
        acc[ai][bj][m][n] = __builtin_amdgcn_mfma_f32_16x16x32_bf16(Bt[n][k], At[m][k], acc[ai][bj][m][n], 0, 0, 0); __builtin_amdgcn_s_setprio(0); } while (0)
#define PG8_WAIT_V(n) asm volatile("s_waitcnt vmcnt(" #n ")" ::: "memory")
#define PG8_WAIT_L(n) asm volatile("s_waitcnt lgkmcnt(" #n ")" ::: "memory")
#define PG8_BAR __builtin_amdgcn_s_barrier()
#define PG8_SCHED __builtin_amdgcn_sched_barrier(0)
    Unit cur, nxt; int ui = 0;
    if (!S.next(0, cur)) return;
    if constexpr (GATHER) {
#pragma unroll
        for (int h = 0; h < 2; ++h)
#pragma unroll
            for (int i = 0; i < 2; ++i) voffA[h][i] = (unsigned)(rowidx[h * HALF + Rr[i]] * lda + Cc[i]) * 2u;
    }
    f32x4 acc[2][2][4][2];
#pragma unroll
    for (int a = 0; a < 2; ++a)
#pragma unroll
        for (int b = 0; b < 2; ++b)
#pragma unroll
            for (int m = 0; m < 4; ++m)
#pragma unroll
                for (int n = 0; n < 2; ++n) acc[a][b][m][n] = (f32x4){0.f, 0.f, 0.f, 0.f};
    bf16x8 At[4][2], B0[2][2], B1[2][2];
    const char* cA = Ab + cur.a; const char* cB = Bb + cur.b;
    PG8_STAGE(PG8_SB(0, 0), cB, voffB); PG8_STAGE(PG8_SB(0, 1), cB + hstepB, voffB); PG8_STAGE(PG8_SA(0, 0), cA, voffA[0]); PG8_STAGE(PG8_SA(0, 1), cA, voffA[1]);
    if (wr == 1) PG8_BAR;
    PG8_WAIT_V(2); PG8_BAR;
    PG8_STAGE(PG8_SB(1, 0), cB + kstep, voffB); PG8_STAGE(PG8_SA(1, 0), cA + kstep, voffA[0]); PG8_STAGE(PG8_SB(1, 1), cB + hstepB + kstep, voffB);
    PG8_WAIT_V(6); PG8_BAR;
    unsigned long long gt0 = gst ? __builtin_amdgcn_s_memrealtime() : 0ull;
#define GST(k) do { if (gst) { const unsigned long long t1_ = __builtin_amdgcn_s_memrealtime(); gst[k] += t1_ - gt0; gt0 = t1_; } } while (0)
    for (;;) {
        const bool has_next = S.next(ui + 1, nxt);
        GST(1);
        const char* nA = has_next ? Ab + nxt.a : cA; const char* nB = has_next ? Bb + nxt.b : cB;
        unsigned nvoff[2][2];
#pragma unroll
        for (int h = 0; h < 2; ++h)
#pragma unroll
            for (int i = 0; i < 2; ++i) nvoff[h][i] = voffA[h][i];
        if constexpr (GATHER) {
            if (has_next) {
#pragma unroll
                for (int h = 0; h < 2; ++h)
#pragma unroll
                    for (int i = 0; i < 2; ++i) nvoff[h][i] = (unsigned)(rowidx[(ui + 1) * 256 + h * HALF + Rr[i]] * lda + Cc[i]) * 2u;
            }
        }
        for (int t = 0; t < nt; t += 2) {
            const bool last = (t == nt - 2);
            const char* a1 = cA + (size_t)(t + 1) * kstep;
            const char* a2 = last ? nA : cA + (size_t)(t + 2) * kstep; const char* b2 = last ? nB : cB + (size_t)(t + 2) * kstep;
            const char* a3 = a2 + kstep; const char* b3 = b2 + kstep;
            unsigned v2[2][2];
#pragma unroll
            for (int h = 0; h < 2; ++h)
#pragma unroll
                for (int i = 0; i < 2; ++i) v2[h][i] = (GATHER && last) ? nvoff[h][i] : voffA[h][i];
            PG8_LDB(B0, 0, 0); PG8_LDB(B1, 0, 1); PG8_SCHED; PG8_LDA(At, 0, 0); PG8_STAGE(PG8_SA(1, 1), a1, voffA[1]);
            PG8_WAIT_V(8); PG8_WAIT_L(0); PG8_BAR; PG8_MMA(0, 0, At, B0); PG8_MMA(0, 1, At, B1); PG8_BAR; PG8_SCHED;
            PG8_LDA(At, 0, 1); PG8_STAGE(PG8_SB(0, 0), b2, voffB); PG8_STAGE(PG8_SB(0, 1), b2 + hstepB, voffB); PG8_STAGE(PG8_SA(0, 0), a2, v2[0]);
            PG8_WAIT_V(8); PG8_WAIT_L(0); PG8_BAR; if (!cur.half) { PG8_MMA(1, 0, At, B0); PG8_MMA(1, 1, At, B1); } PG8_BAR; PG8_SCHED;
            PG8_LDB(B0, 1, 0); PG8_LDB(B1, 1, 1); PG8_SCHED; PG8_LDA(At, 1, 0); PG8_STAGE(PG8_SA(0, 1), a2, v2[1]);
            PG8_WAIT_V(8); PG8_WAIT_L(0); PG8_BAR; PG8_MMA(0, 0, At, B0); PG8_MMA(0, 1, At, B1); PG8_BAR; PG8_SCHED;
            PG8_LDA(At, 1, 1); PG8_STAGE(PG8_SB(1, 0), b3, voffB); PG8_STAGE(PG8_SB(1, 1), b3 + hstepB, voffB); PG8_STAGE(PG8_SA(1, 0), a3, v2[0]);
            PG8_WAIT_V(8); PG8_WAIT_L(0); PG8_BAR; if (!cur.half) { PG8_MMA(1, 0, At, B0); PG8_MMA(1, 1, At, B1); } PG8_BAR; PG8_SCHED;
        }
        GST(0);
        if constexpr (ALIGN_EPI) { if (wr == 0) PG8_BAR; }
        E(acc, cur.r0, cur.pn, cur.half, wr, wc, fr, fq);
        if (!has_next) break;
#pragma unroll
        for (int a = 0; a < 2; ++a)
#pragma unroll
            for (int b = 0; b < 2; ++b)
#pragma unroll
                for (int m = 0; m < 4; ++m)
#pragma unroll
                    for (int n = 0; n < 2; ++n) acc[a][b][m][n] = (f32x4){0.f, 0.f, 0.f, 0.f};
        cur = nxt; cA = nA; cB = nB; ++ui;
#pragma unroll
        for (int h = 0; h < 2; ++h)
#pragma unroll
            for (int i = 0; i < 2; ++i) voffA[h][i] = nvoff[h][i];
        if constexpr (ALIGN_EPI) { if (wr == 1) PG8_BAR; }
    }
    PG8_WAIT_V(0);
    if constexpr (!ALIGN_EPI) { if (wr == 0) PG8_BAR; }
    PG8_BAR;
#undef PG8_SA
#undef PG8_SB
#undef PG8_STAGE
#undef PG8_LDA
#undef PG8_LDB
#undef PG8_MMA
#undef PG8_WAIT_V
#undef PG8_WAIT_L
#undef PG8_BAR
#undef PG8_SCHED
}
}
#define MK_MULTI 0
#define MK_DBG 0
struct Params {
    const float *x, *rel_bias, *w_in, *mla_q_norm, *mla_w_uq, *mla_kv_norm, *mla_w_ukv, *gmlp_ln_g, *gmlp_ln_b, *gmlp_w_s, *gmlp_b_s,
                *diff_lq1, *diff_lk1, *diff_lq2, *diff_lk2, *diff_subln, *w_o, *ln1_g, *ln1_b, *router_w, *router_bias,
                *exp_w_gate, *exp_w_up, *exp_w_down, *shared_w_gate, *shared_w_up, *shared_w_down, *ln2_g, *ln2_b;
    float* out;
    unsigned char* ws;
    int ph_lo, ph_hi;
    int use_bar;
    int dbg;
    float lam_init0, lam_init1;
};

typedef const __attribute__((address_space(4))) Params* KP_T;
#define OPQ(p) asm volatile("" : "+s"(p))
constexpr size_t al256(size_t x) { return (x + 255) & ~(size_t)255; }
constexpr size_t WS_CTL = 0, CTL_ZERO_BYTES = 65536;
constexpr size_t WS_ROPE = 1u << 20;
constexpr size_t SZ_ROPE = (size_t)SEQ * 32 * 4 * 2;
constexpr size_t WS_WIN = al256(WS_ROPE + SZ_ROPE);
constexpr size_t SZ_WIN = (size_t)HW * DM * 2;
constexpr size_t WS_WUQ = al256(WS_WIN + NLAYER * SZ_WIN);
constexpr size_t SZ_WUQ = (size_t)1536 * 512 * 2;
constexpr size_t WS_WUKV = al256(WS_WUQ + NLAYER * SZ_WUQ);
constexpr size_t SZ_WUKV = (size_t)2048 * 256 * 2;
constexpr size_t WS_WO = al256(WS_WUKV + NLAYER * SZ_WUKV);
constexpr size_t SZ_WO = (size_t)DM * DM * 2;
constexpr size_t WS_WGU = al256(WS_WO + NLAYER * SZ_WO);
constexpr int WGSTR = DM + 64, WDSTR = 512 + 64, XSTR = DM + 64;
constexpr size_t SZ_WGU1 = (size_t)1024 * WGSTR * 2, SZ_WGU = NEXP1 * SZ_WGU1;
constexpr size_t WS_WD = al256(WS_WGU + NLAYER * SZ_WGU);
constexpr size_t SZ_WD1 = (size_t)DM * WDSTR * 2, SZ_WD = NEXP1 * SZ_WD1;
constexpr size_t WS_XB = al256(WS_WD + NLAYER * SZ_WD);
constexpr size_t WS_XF = al256(WS_XB + (size_t)T * DM * 2);
constexpr size_t WS_HB = al256(WS_XF + (size_t)T * DM * 4);
constexpr size_t WS_RSS = al256(WS_HB + (size_t)T * HW * 2);
constexpr size_t WS_QB = al256(WS_RSS + (size_t)T * 12 * 4);
constexpr size_t WS_KB = al256(WS_QB + (size_t)T * 8 * 192 * 2);
constexpr size_t WS_VB = al256(WS_KB + (size_t)T * 8 * 192 * 2);
constexpr size_t WS_MIX = al256(WS_VB + (size_t)T * 8 * 128 * 2);
constexpr size_t WS_Y1 = al256(WS_MIX + (size_t)T * DM * 2);
constexpr size_t WS_X1F = al256(WS_Y1 + (size_t)T * DM * 4);
constexpr size_t WS_RTR = WS_X1F;
constexpr size_t WS_X1B = al256(WS_X1F + (size_t)T * DM * 4);
constexpr size_t WS_EIDX = al256(WS_X1B + (size_t)T * XSTR * 2);
constexpr size_t WS_EW = al256(WS_EIDX + (size_t)T * 8 * 4);
constexpr size_t WS_ELR = al256(WS_EW + (size_t)T * 8 * 4);
constexpr size_t WS_HIST = al256(WS_ELR + (size_t)T * 8 * 4);
constexpr size_t WS_EOFF = al256(WS_HIST + (size_t)RT_UNITS * 64 * 4);
constexpr size_t WS_SLOT = al256(WS_EOFF + 160 * 4);
constexpr size_t WS_ROWIDX = al256(WS_SLOT + (size_t)T * 8 * 4);
constexpr size_t WS_GATEW = al256(WS_ROWIDX + (size_t)NSLOT * 4);
constexpr size_t WS_HMOE = al256(WS_GATEW + (size_t)NSLOT * 4);
constexpr int HSTR = EDIM + 64;
constexpr size_t WS_YMOE = al256(WS_HMOE + (size_t)NSLOT * HSTR * 2);
constexpr size_t WS_END = al256(WS_YMOE + (size_t)NSLOT * DM);
constexpr int CW_BAR = 4096;
constexpr int CW_QUEUE = 8192;
constexpr int CW_ERR = 9216;

constexpr int LDS_STAGE = 131072;
constexpr int LDS_MISC = LDS_STAGE;
constexpr int LDS_GIDX = LDS_MISC + 4096;
constexpr int LDS_BYTES = LDS_STAGE + 4096 + 8192;

enum { PH_PRO = 0, PH_L0 = 1, PHL_G1 = 0, PHL_G2 = 1, PHL_MIX = 2, PHL_WO = 3, PHL_LNR = 4, PHL_SLOT = 5, PHL_GU = 6, PHL_DN = 7, PHL_CMB = 8, PHL_N = 9, PH_END = 1 + 2 * PHL_N };
using pg8::Unit;
typedef const f32x4 (&AccRef)[2][2][4][2];

__device__ __forceinline__ u32x4 pack8(f32x4 v0, f32x4 v1) { u32x4 w; w.x = cvtpk(v0[0], v0[1]); w.y = cvtpk(v0[2], v0[3]); w.z = cvtpk(v1[0], v1[1]); w.w = cvtpk(v1[2], v1[3]); return w; }
__device__ __forceinline__ u32x2 pack4(f32x4 v) { u32x2 w; w.x = cvtpk(v[0], v[1]); w.y = cvtpk(v[2], v[3]); return w; }

struct Epi1 {
    static constexpr bool PERM = true;
    bf16_t* HB; float* RSS; bf16_t* KB; const float* rc; const float* rs;
    __device__ __forceinline__ void operator()(AccRef acc, const int r0, const int pn, const int half, int wr, int wc, int fr, int fq) const {
        const int row0 = r0 + wr * 64 + fr;
        if (pn == 13) {
            if (wc < 2) {
                const int i0 = 4 * (wc * 4 + fq);
#pragma unroll
                for (int ai = 0; ai < 2; ++ai)
#pragma unroll
                    for (int m = 0; m < 4; ++m) {
                        const int row = row0 + ai * 128 + m * 16, pos = row & (SEQ - 1);
                        const f32x4 c = *(const f32x4*)(rc + pos * 32 + i0), s = *(const f32x4*)(rs + pos * 32 + i0);
                        const f32x4 x1 = acc[ai][0][m][0], x2 = acc[ai][0][m][1];
                        const u32x2 y1 = pack4(x1 * c - x2 * s), y2 = pack4(x2 * c + x1 * s);
                        bf16_t* kp = KB + (size_t)row * (8 * 192) + 128 + i0;
#pragma unroll
                        for (int h = 0; h < 8; ++h) { *(u32x2*)(kp + h * 192) = y1; *(u32x2*)(kp + h * 192 + 32) = y2; }
                    }
            }
            return;
        }
        const int mode = (pn <= 2) ? 0 : (pn <= 6) ? 1 : (pn <= 8) ? 2 : 3;
#pragma unroll
        for (int ai = 0; ai < 2; ++ai)
#pragma unroll
            for (int m = 0; m < 4; ++m) {
                const int row = row0 + ai * 128 + m * 16;
                bf16_t* rowp = HB + (size_t)row * HW + pn * 256 + wc * 32 + 8 * fq;
                float ss = 0.f;
#pragma unroll
                for (int bj = 0; bj < 2; ++bj) {
                    f32x4 v0 = acc[ai][bj][m][0], v1 = acc[ai][bj][m][1];
                    if (mode == 0) { ss += (v0[0] * v0[0] + v0[1] * v0[1]) + (v0[2] * v0[2] + v0[3] * v0[3]) + (v1[0] * v1[0] + v1[1] * v1[1]) + (v1[2] * v1[2] + v1[3] * v1[3]); }
                    if (mode == 1) {
#pragma unroll
                        for (int j = 0; j < 4; ++j) { v0[j] = gelu_tanh(v0[j]); v1[j] = gelu_tanh(v1[j]); } }
                    if (mode == 2) { v0 = v0 * (0.125f * LOG2E); v1 = v1 * (0.125f * LOG2E); }
                    *(u32x4*)(rowp + bj * 128) = pack8(v0, v1);
                }
                if (mode == 0) { ss += __shfl_xor(ss, 16); ss += __shfl_xor(ss, 32); if (fq == 0) RSS[(size_t)row * 12 + pn * 4 + wc] = ss; }
            }
    }
};

struct Epi2 {
    static constexpr bool PERM = true;
    int mode; const float* RSS; bf16_t *QB, *KB, *VB; const float* rc; const float* rs;
    __device__ __forceinline__ void operator()(AccRef acc, const int r0, const int pn, const int half, int wr, int wc, int fr, int fq) const {
        const int row0 = r0 + wr * 64 + fr;
#pragma unroll
        for (int ai = 0; ai < 2; ++ai)
#pragma unroll
            for (int m = 0; m < 4; ++m) {
                const int row = row0 + ai * 128 + m * 16;
                const float* rp = RSS + (size_t)row * 12;
                float sc;
                if (mode == 0) { const f32x4 a = *(const f32x4*)rp, b = *(const f32x4*)(rp + 4); const float ss = ((a[0] + a[1]) + (a[2] + a[3])) + ((b[0] + b[1]) + (b[2] + b[3]));
                    sc = rsqrtf(ss * (1.0f / 512.0f) + 1e-6f) * (0.07216878364870322f * LOG2E); }
                else { const f32x4 a = *(const f32x4*)(rp + 8); const float ss = (a[0] + a[1]) + (a[2] + a[3]); sc = rsqrtf(ss * (1.0f / 256.0f) + 1e-6f); }
#pragma unroll
                for (int bj = 0; bj < 2; ++bj) {
                    const f32x4 v0 = acc[ai][bj][m][0] * sc, v1 = acc[ai][bj][m][1] * sc;
                    if (mode == 0) {
                        const int col8 = pn * 256 + bj * 128 + wc * 32 + 8 * fq, head = col8 / 192, w = col8 - head * 192;
                        bf16_t* qp = QB + ((size_t)row * 8 + head) * 192;
                        if (w < 128) *(u32x4*)(qp + w) = pack8(v0, v1);
                        else { const int i0 = 4 * ((w - 128) >> 3), pos = row & (SEQ - 1);
                            const f32x4 c = *(const f32x4*)(rc + pos * 32 + i0), s = *(const f32x4*)(rs + pos * 32 + i0);
                            *(u32x2*)(qp + 128 + i0) = pack4(v0 * c - v1 * s); *(u32x2*)(qp + 160 + i0) = pack4(v1 * c + v0 * s); }
                    } else {
                        if (bj == 0) *(u32x4*)(KB + ((size_t)row * 8 + pn) * 192 + wc * 32 + 8 * fq) = pack8(v0, v1);
                        else         *(u32x4*)(VB + ((size_t)row * 8 + pn) * 128 + wc * 32 + 8 * fq) = pack8(v0, v1);
                    }
                }
            }
    }
};

struct EpiWO {
    static constexpr bool PERM = true;
    bf16_t* Y1;
    __device__ __forceinline__ void operator()(AccRef acc, const int r0, const int pn, const int half, int wr, int wc, int fr, int fq) const {
        const int row0 = r0 + wr * 64 + fr, col0 = pn * 256 + wc * 32 + 8 * fq;
#pragma unroll
        for (int ai = 0; ai < 2; ++ai)
#pragma unroll
            for (int m = 0; m < 4; ++m) { const size_t o = (size_t)(row0 + ai * 128 + m * 16) * DM + col0;
#pragma unroll
                for (int bj = 0; bj < 2; ++bj) *(u32x4*)(Y1 + o + bj * 128) = pack8(acc[ai][bj][m][0], acc[ai][bj][m][1]); }
    }
};

struct EpiGU {
    static constexpr bool PERM = true;
    bf16_t* HM;
    __device__ __forceinline__ void operator()(AccRef acc, const int r0, const int pn, const int half, int wr, int wc, int fr, int fq) const {
        const int s0 = r0 + wr * 64 + fr;
#pragma unroll
        for (int ai = 0; ai < 2; ++ai) { if (ai == 1 && half) break;
#pragma unroll
            for (int m = 0; m < 4; ++m) {
                const int slot = s0 + ai * 128 + m * 16;
                f32x4 h0, h1;
#pragma unroll
                for (int j = 0; j < 4; ++j) { const float g0 = acc[ai][0][m][0][j], g1 = acc[ai][0][m][1][j];
                    h0[j] = g0 * sigmoidf_(g0) * acc[ai][1][m][0][j]; h1[j] = g1 * sigmoidf_(g1) * acc[ai][1][m][1][j]; }
                *(u32x4*)(HM + (size_t)slot * HSTR + pn * 128 + wc * 32 + 8 * fq) = pack8(h0, h1);
            } }
    }
};

__device__ __forceinline__ u32x2 pack8_fp8(f32x4 v0, f32x4 v1) { u32x2 w;
    int a, b; asm volatile("" : "=v"(a), "=v"(b));
    a = __builtin_amdgcn_cvt_pk_fp8_f32(v0[0], v0[1], a, false); a = __builtin_amdgcn_cvt_pk_fp8_f32(v0[2], v0[3], a, true);
    b = __builtin_amdgcn_cvt_pk_fp8_f32(v1[0], v1[1], b, false); b = __builtin_amdgcn_cvt_pk_fp8_f32(v1[2], v1[3], b, true);
    w.x = (unsigned)a; w.y = (unsigned)b; return w; }
struct EpiDN {
    static constexpr bool PERM = true;
    unsigned char* YM;
    __device__ __forceinline__ void operator()(AccRef acc, const int r0, const int pn, const int half, int wr, int wc, int fr, int fq) const {
        const int s0 = r0 + wr * 64 + fr;
#pragma unroll
        for (int ai = 0; ai < 2; ++ai) { if (ai == 1 && half) break;
#pragma unroll
            for (int m = 0; m < 4; ++m) { unsigned char* yp = YM + (size_t)(s0 + ai * 128 + m * 16) * DM + pn * 256 + wc * 32 + 8 * fq;
#pragma unroll
                for (int bj = 0; bj < 2; ++bj) *(u32x2*)(yp + bj * 128) = pack8_fp8(acc[ai][bj][m][0], acc[ai][bj][m][1]); } }
    }
};

struct SchedDense {
    int lda, K, nM, nN, pn0, Gs, c;
    __device__ __forceinline__ bool next(int i, Unit& u) const {
        if (c < 0 || c >= Gs) return false;
        int pm, pn; if (!pg8::dense_tile(i, Gs, c, nM, nN, pm, pn)) return false;
        pn += pn0;
        u.a = (unsigned)pm * 256u * (unsigned)lda * 2u; u.b = (unsigned)pn * 256u * (unsigned)K * 2u; u.r0 = pm * 256; u.pn = pn; u.half = 0; return true;
    }
};
struct SchedMoE {
    const LAS int* t2e; unsigned wstride; int rowbytes, K, NJ, nunits, G, v;
    __device__ __forceinline__ bool next(int i, Unit& u) const {
        const int L = i * G + ((i & 1) ? G - 1 - v : v); if (L >= nunits) return false;
        const int q = L / NJ, j = L - q * NJ, ent = t2e[MAXTILES + q], mt = ent & 0xffff, e = t2e[mt];
        u.a = (unsigned)mt * 256u * (unsigned)rowbytes; u.b = (unsigned)e * wstride + (unsigned)j * 256u * (unsigned)K * 2u; u.r0 = mt * 256; u.pn = j; u.half = ent >> 16; return true;
    }
};
__device__ __forceinline__ void tr_item(const float* colp, int ldn, const float* gain, bf16_t* dst, int K, int k0, int n0, LAS unsigned char* scr, int lane) {
    const int kq = lane >> 4, nq = lane & 15;
    f32x4 v[32];
#pragma unroll
    for (int i = 0; i < 32; ++i) { const int kk = 64 * (i >> 4) + 8 * ((i & 15) >> 1) + 2 * kq + (i & 1); v[i] = colp ? __builtin_nontemporal_load((const f32x4*)(colp + (size_t)(k0 + kk) * ldn)) : (f32x4){0.f, 0.f, 0.f, 0.f}; }
    if (gain) {
#pragma unroll
        for (int i = 0; i < 32; ++i) { const int kk = 64 * (i >> 4) + 8 * ((i & 15) >> 1) + 2 * kq + (i & 1); v[i] = v[i] * gain[k0 + kk]; } }
#pragma unroll
    for (int hb = 0; hb < 2; ++hb) {
#pragma unroll
        for (int m = 0; m < 8; ++m) { const int kk = 8 * m + 2 * kq;
#pragma unroll
            for (int c = 0; c < 4; ++c) *(LAS unsigned*)(scr + (4 * nq + c) * 128 + 4 * ((kk >> 1) ^ (4 * (nq & 7)))) = cvtpk(v[16 * hb + 2 * m][c], v[16 * hb + 2 * m + 1][c]); }
        LDS_WAIT(); asm volatile("" ::: "memory");
#pragma unroll
        for (int j = 0; j < 8; ++j) { const int n = 8 * j + (lane >> 3), c = lane & 7;
            const u32x4 o = *(const LAS u32x4*)(scr + n * 128 + 16 * (c ^ ((n >> 2) & 7)));
            __builtin_nontemporal_store(o, (u32x4*)(dst + (size_t)(n0 + n) * K + k0 + 64 * hb + 8 * c)); }
        LDS_WAIT(); asm volatile("" ::: "memory");
    }
}
__device__ __forceinline__ int rope_unperm(int p) { const int g = p >> 3, w = p & 7; return 4 * g + (w & 3) + ((w >= 4) ? 32 : 0); }

constexpr int IT_WIN = (DM / 128) * (HW / 64), IT_WUQ = (512 / 128) * (1536 / 64), IT_WUKV = (256 / 128) * (2048 / 64), IT_WO = (DM / 128) * (DM / 64),
              IT_WGU1 = (DM / 128) * (1024 / 64), IT_WD1 = (EDIM / 128) * (DM / 64);
constexpr int IT_LAYER = IT_WIN + IT_WUQ + IT_WUKV + IT_WO + NEXP1 * (IT_WGU1 + IT_WD1);

constexpr int IT_DENSE = IT_WIN + IT_WUQ + IT_WUKV + IT_WO;
constexpr int IT_EXPERT = NEXP1 * (IT_WGU1 + IT_WD1);
constexpr int CV_CHUNK = 128, CV_NCHUNK = IT_EXPERT / CV_CHUNK;
static_assert(IT_LAYER == IT_DENSE + IT_EXPERT && IT_EXPERT % CV_CHUNK == 0 && IT_WGU1 == 256 && IT_WD1 == 128 && (CV_CHUNK == 128 || CV_CHUNK == 64), "conversion chunks");
__device__ __forceinline__ void conv_item(KP_T P, unsigned char* ws, int l, int r, LAS unsigned char* scr, int lane) {
    const int ln = 4 * (lane & 15);
    if (r < IT_WIN) {
        const int nblk = HW / 64, kb = r / nblk, nb = r - kb * nblk, np = nb * 64 + ln;
        int oc; if (np < 768) oc = np; else if (np < HC_KR) oc = np + 64; else if (np < HC_KR + 64) oc = 768 + rope_unperm(np - HC_KR); else oc = -1;
        const float* cp = oc >= 0 ? P->w_in + (size_t)l * DM * IN_W + oc : nullptr;
        tr_item(cp, IN_W, nullptr, (bf16_t*)(ws + WS_WIN + l * SZ_WIN), DM, kb * 128, nb * 64, scr, lane); return; }
    r -= IT_WIN;
    if (r < IT_WUQ) {
        const int nblk = 1536 / 64, kb = r / nblk, nb = r - kb * nblk, np = nb * 64 + ln, head = np / 192, w = np - head * 192;
        const int oc = (w < 128) ? np : head * 192 + 128 + rope_unperm(w - 128);
        tr_item(P->mla_w_uq + (size_t)l * 512 * 1536 + oc, 1536, P->mla_q_norm + l * 512, (bf16_t*)(ws + WS_WUQ + l * SZ_WUQ), 512, kb * 128, nb * 64, scr, lane); return; }
    r -= IT_WUQ;
    if (r < IT_WUKV) {
        const int nblk = 2048 / 64, kb = r / nblk, nb = r - kb * nblk, np = nb * 64 + ln;
        tr_item(P->mla_w_ukv + (size_t)l * 256 * 2048 + np, 2048, P->mla_kv_norm + l * 256, (bf16_t*)(ws + WS_WUKV + l * SZ_WUKV), 256, kb * 128, nb * 64, scr, lane); return; }
    r -= IT_WUKV;
    if (r < IT_WO) {
        const int nblk = DM / 64, kb = r / nblk, nb = r - kb * nblk, np = nb * 64 + ln;
        tr_item(P->w_o + (size_t)l * DM * DM + np, DM, nullptr, (bf16_t*)(ws + WS_WO + l * SZ_WO), DM, kb * 128, nb * 64, scr, lane); return; }
    r -= IT_WO;
    if (r < NEXP1 * IT_WGU1) {
        const int e = r / IT_WGU1, rr = r - e * IT_WGU1, nblk = 1024 / 64, kb = rr / nblk, nb = rr - kb * nblk, np = nb * 64 + ln;
        const int tj = np >> 8, w = np & 255, col = tj * 128 + (w & 127); const bool up = w >= 128;
        const float* src = (e < NEXP) ? (up ? P->exp_w_up : P->exp_w_gate) + ((size_t)l * NEXP + e) * DM * EDIM : (up ? P->shared_w_up : P->shared_w_gate) + (size_t)l * DM * EDIM;
        tr_item(src + col, EDIM, nullptr, (bf16_t*)(ws + WS_WGU + l * SZ_WGU + e * SZ_WGU1), DM, kb * 128, nb * 64, scr, lane); return; }
    r -= NEXP1 * IT_WGU1;
    {
        const int e = r / IT_WD1, rr = r - e * IT_WD1, nblk = DM / 64, kb = rr / nblk, nb = rr - kb * nblk, np = nb * 64 + ln;
        const float* src = (e < NEXP) ? P->exp_w_down + ((size_t)l * NEXP + e) * EDIM * DM : P->shared_w_down + (size_t)l * EDIM * DM;
        tr_item(src + np, DM, nullptr, (bf16_t*)(ws + WS_WD + l * SZ_WD + e * SZ_WD1), EDIM, kb * 128, nb * 64, scr, lane); }
}
#ifndef CV_STORE
#define CV_STORE(v, p) __builtin_nontemporal_store(v, p)
#endif
struct CvDesc { const float* colp; bf16_t* dst; int ldn, K, k0, n0; float sc; };
__device__ __forceinline__ CvDesc conv_desc(KP_T P, unsigned char* ws, int l, int r, int lane) {
    const int ln = 4 * (lane & 15); CvDesc d;
    if (r < NEXP1 * IT_WGU1) {
        const int e = r / IT_WGU1, rr = r - e * IT_WGU1, nb = 8 * (rr >> 7) + (rr & 7), kb = (rr >> 3) & 15, np = nb * 64 + ln;
        const int tj = np >> 8, w = np & 255, col = tj * 128 + (w & 127); const bool up = w >= 128;
        const float* src = (e < NEXP) ? (up ? P->exp_w_up : P->exp_w_gate) + ((size_t)l * NEXP + e) * DM * EDIM : (up ? P->shared_w_up : P->shared_w_gate) + (size_t)l * DM * EDIM;
        d.colp = src + col; d.dst = (bf16_t*)(ws + WS_WGU + l * SZ_WGU + e * SZ_WGU1); d.ldn = EDIM; d.K = WGSTR; d.k0 = kb * 128; d.n0 = nb * 64; d.sc = 1.0f;
    } else { r -= NEXP1 * IT_WGU1;
        const int e = r / IT_WD1, rr = r - e * IT_WD1, nb = (rr & 7) + 8 * (rr >> 5), kb = (rr >> 3) & 3, np = nb * 64 + ln;
        const float* src = (e < NEXP) ? P->exp_w_down + ((size_t)l * NEXP + e) * EDIM * DM : P->shared_w_down + (size_t)l * EDIM * DM;
        d.colp = src + np; d.dst = (bf16_t*)(ws + WS_WD + l * SZ_WD + e * SZ_WD1); d.ldn = DM; d.K = WDSTR; d.k0 = kb * 128; d.n0 = nb * 64; d.sc = 8.0f; }
    return d;
}
__device__ __forceinline__ void tr_load16(const CvDesc& d, int hb, f32x4 (&v)[16], int lane) {
    const int kq = lane >> 4;
#pragma unroll
    for (int i = 0; i < 16; ++i) { const int kk = 64 * hb + 8 * (i >> 1) + 2 * kq + (i & 1); v[i] = __builtin_nontemporal_load((const f32x4*)(d.colp + (size_t)(d.k0 + kk) * d.ldn)); }
}
__device__ __forceinline__ void tr_store16(const CvDesc& d, int hb, const f32x4 (&v)[16], LAS unsigned char* scr, int lane) {
    const int kq = lane >> 4, nq = lane & 15, sw = 4 * (nq & 7);
#pragma unroll
    for (int m = 0; m < 8; ++m) {
#pragma unroll
        for (int c = 0; c < 4; ++c) *(LAS unsigned*)(scr + (4 * nq + c) * 128 + 4 * ((4 * m + kq) ^ sw)) = cvtpk(v[2 * m][c] * d.sc, v[2 * m + 1][c] * d.sc); }
    LDS_WAIT(); asm volatile("" ::: "memory");
#pragma unroll
    for (int j = 0; j < 8; ++j) { const int n = 8 * j + (lane >> 3), c = lane & 7;
        const u32x4 o = *(const LAS u32x4*)(scr + n * 128 + 16 * (c ^ ((n >> 2) & 7)));
        CV_STORE(o, (u32x4*)(d.dst + (size_t)(d.n0 + n) * d.K + d.k0 + 64 * hb + 8 * c)); }
    LDS_WAIT(); asm volatile("" ::: "memory");
}
__device__ __forceinline__ void convert_chunk(KP_T P, LAS unsigned char* lds, int l, int chunk) {
    const int tid = opq_tid(), lane = tid & 63, wave = __builtin_amdgcn_readfirstlane(tid >> 6);
    LAS unsigned char* scr = lds + wave * 16384; unsigned char* ws = P->ws;
    const int r0 = chunk * CV_CHUNK + wave;
    CvDesc d = conv_desc(P, ws, l, r0, lane);
    f32x4 va[16], vb[16];
    tr_load16(d, 0, va, lane);
#pragma unroll 1
    for (int i = 0; i < CV_CHUNK / NWAVES; ++i) {
        tr_load16(d, 1, vb, lane);
        tr_store16(d, 0, va, scr, lane);
        const bool more = i + 1 < CV_CHUNK / NWAVES;
        const CvDesc dn = more ? conv_desc(P, ws, l, r0 + NWAVES * (i + 1), lane) : d;
        if (more) tr_load16(dn, 0, va, lane);
        tr_store16(d, 1, vb, scr, lane);
        d = dn;
    }
}

__device__ __forceinline__ void prologue_phase(KP_T P, LAS unsigned char* lds, int vcu, int G) {
    const int tid = opq_tid(), lane = tid & 63, wave = __builtin_amdgcn_readfirstlane(tid >> 6);
    LAS unsigned char* scr = lds + wave * 16384;
    const int gw = vcu * NWAVES + wave, NGW = G * NWAVES;
    unsigned char* ws = P->ws;
    for (int it = gw; it < NLAYER * IT_DENSE; it += NGW) { const int l = it / IT_DENSE; conv_item(P, ws, l, it - l * IT_DENSE, scr, lane); }
    { u32x4* WH = (u32x4*)(ws + WS_RTR); u32x4* WL = WH + NLAYER * 16384;
      for (int idx = gw * 64 + lane; idx < NLAYER * 16384; idx += NGW * 64) { const int l = idx >> 14, rem = idx & 16383, ks = rem >> 8, n = (rem >> 6) & 3, ln = rem & 63, e = 4 * (ln & 15) + n;
          const float* p = P->router_w + ((size_t)l * DM + 32 * ks + 8 * (ln >> 4)) * NEXP + e;
          f32x4 a, b;
#pragma unroll
          for (int t = 0; t < 4; ++t) { a[t] = p[(size_t)t * NEXP]; b[t] = p[(size_t)(t + 4) * NEXP]; }
          const u32x4 hi = pack8(a, b);
          const f32x4 ra = a - (f32x4){bflo(hi.x), bfhi(hi.x), bflo(hi.y), bfhi(hi.y)}, rb = b - (f32x4){bflo(hi.z), bfhi(hi.z), bflo(hi.w), bfhi(hi.w)};
          WH[idx] = hi; WL[idx] = pack8(ra, rb); } }
    { bf16_t* XB = (bf16_t*)(ws + WS_XB);
      for (int ch = gw; ch < T * DM / 512; ch += 4 * NGW) { f32x4 a[4], b[4];
#pragma unroll
          for (int q = 0; q < 4; ++q) { const int c = ch + q * NGW; const size_t o = (size_t)(c < T * DM / 512 ? c : ch) * 512 + lane * 8; a[q] = *(const f32x4*)(P->x + o); b[q] = *(const f32x4*)(P->x + o + 4); }
#pragma unroll
          for (int q = 0; q < 4; ++q) { const int c = ch + q * NGW; if (c < T * DM / 512) *(u32x4*)(XB + (size_t)c * 512 + lane * 8) = pack8(a[q], b[q]); } } }
    { float* rc = (float*)(ws + WS_ROPE); float* rs = rc + SEQ * 32;
      for (int i = gw * 64 + lane; i < SEQ * 32; i += NGW * 64) { const int pos = i >> 5, f = i & 31;
          const float inv = exp2f(-(float)f * (1.0f / 32.0f) * 13.287712379549449f);
          const float ang = (float)pos * inv;
          const double q = (double)ang * 0.15915494309189535; const double fr = q - __builtin_rint(q);
          const float rad = (float)(fr * 6.283185307179586);
          rc[i] = __cosf(rad); rs[i] = __sinf(rad); } }
}
#define CVSEL2 7

typedef short v4i16_t __attribute__((ext_vector_type(4)));
__device__ __forceinline__ s16x4 vtr(const LAS char* p) { return __builtin_bit_cast(s16x4, __builtin_amdgcn_ds_read_tr16_b64_v4i16((LAS v4i16_t*)p)); }
#define FRAG8(lo, hi) ((bf16x8){(lo)[0], (lo)[1], (lo)[2], (lo)[3], (hi)[0], (hi)[1], (hi)[2], (hi)[3]})
constexpr int VROW = 320;
constexpr int KROW_M = 400;
constexpr int KROW_D = 272;
constexpr int ATT_TAB = 98304;
static_assert(4 * 66 * 64 * 4 <= ATT_TAB && ATT_TAB + 512 <= LDS_STAGE, "attention LDS map");

__device__ __forceinline__ float half_max(float x) { auto rr = __builtin_amdgcn_permlane32_swap(__float_as_uint(x), __float_as_uint(x), false, false); return fmaxf(__uint_as_float(rr[0]), __uint_as_float(rr[1])); }
__device__ __forceinline__ float half_sum(float x) { auto rr = __builtin_amdgcn_permlane32_swap(__float_as_uint(x), __float_as_uint(x), false, false); return __uint_as_float(rr[0]) + __uint_as_float(rr[1]); }
template <int NT>
__device__ __forceinline__ void smax_update(f32x16 (&S)[NT], float& m, float& l, f32x16 (&O)[4], bf16x8 (&pf)[NT][2]) {
    float mx = fmaxf(S[0][0], S[0][1]);
#pragma unroll
    for (int t = 0; t < NT; ++t)
#pragma unroll
        for (int r = (t == 0 ? 2 : 0); r < 16; r += 2) mx = fmaxf(mx, fmaxf(S[t][r], S[t][r + 1]));
    mx = half_max(mx);
    if (__any(mx > m + 8.0f)) {
        const float mn = fmaxf(m, mx), alpha = __builtin_amdgcn_exp2f(m - mn);
        m = mn; l *= alpha;
#pragma unroll
        for (int d = 0; d < 4; ++d) O[d] = O[d] * alpha;
    }
    float sum = 0.f;
#pragma unroll
    for (int t = 0; t < NT; ++t)
#pragma unroll
        for (int r = 0; r < 16; ++r) { const float p = __builtin_amdgcn_exp2f(S[t][r] - m); S[t][r] = p; sum += p; }
    l += sum;
#pragma unroll
    for (int t = 0; t < NT; ++t)
#pragma unroll
        for (int s = 0; s < 2; ++s) { u32x4 w; w.x = cvtpk(S[t][8 * s + 0], S[t][8 * s + 1]); w.y = cvtpk(S[t][8 * s + 2], S[t][8 * s + 3]); w.z = cvtpk(S[t][8 * s + 4], S[t][8 * s + 5]); w.w = cvtpk(S[t][8 * s + 6], S[t][8 * s + 7]);
            pf[t][s] = __builtin_bit_cast(bf16x8, w); }
}
__device__ __forceinline__ void pv_tile(f32x16 (&O)[4], const LAS char* vp, const bf16x8 (&pf)[2]) {
    s16x4 lo[4][2], hi[4][2];
#pragma unroll
    for (int dt = 0; dt < 4; ++dt)
#pragma unroll
        for (int s = 0; s < 2; ++s) { lo[dt][s] = vtr(vp + (16 * s) * VROW + dt * 64); hi[dt][s] = vtr(vp + (16 * s + 8) * VROW + dt * 64); }
    __builtin_amdgcn_sched_barrier(0);
#pragma unroll
    for (int dt = 0; dt < 4; ++dt)
#pragma unroll
        for (int s = 0; s < 2; ++s) O[dt] = __builtin_amdgcn_mfma_f32_32x32x16_bf16(FRAG8(lo[dt][s], hi[dt][s]), pf[s], O[dt], 0, 0, 0);
}

constexpr int MLA_KT = 64 * 384, MLA_SLOT = MLA_KT + 64 * 256;
constexpr int DIF_KT = 64 * 256, DIF_SLOT = DIF_KT + 64 * 256;
static_assert(3 * MLA_SLOT <= LDS_STAGE && 3 * DIF_SLOT <= ATT_TAB, "attention ring");
#define ATT_DMA(gp, ldsp) __builtin_amdgcn_global_load_lds((const unsigned*)(gp), (LAS unsigned*)(ldsp), 16, 0, 0)
__device__ __forceinline__ void pv_tile_sw(f32x16 (&O)[4], const LAS char* slotv, const int (&vb)[4], const bf16x8 (&pf)[2]) {
    s16x4 lo[4][2], hi[4][2];
    const unsigned sv = (unsigned)(__UINTPTR_TYPE__)slotv;
#pragma unroll
    for (int dt = 0; dt < 4; ++dt) { const unsigned a = sv + (unsigned)vb[dt];
        asm volatile("ds_read_b64_tr_b16 %0, %4\n\tds_read_b64_tr_b16 %1, %4 offset:2048\n\tds_read_b64_tr_b16 %2, %4 offset:4096\n\tds_read_b64_tr_b16 %3, %4 offset:6144"
                     : "=&v"(lo[dt][0]), "=&v"(hi[dt][0]), "=&v"(lo[dt][1]), "=&v"(hi[dt][1]) : "v"(a) : "memory"); }
    asm volatile("s_waitcnt lgkmcnt(0)" ::: "memory");
    __builtin_amdgcn_sched_barrier(0);
#pragma unroll
    for (int dt = 0; dt < 4; ++dt)
#pragma unroll
        for (int s = 0; s < 2; ++s) O[dt] = __builtin_amdgcn_mfma_f32_32x32x16_bf16(FRAG8(lo[dt][s], hi[dt][s]), pf[s], O[dt], 0, 0, 0);
}

__device__ __forceinline__ void mla_unit(KP_T P, LAS unsigned char* lds, int b, int h, int qb) {
    const int tid = opq_tid(), lane = tid & 63, wid = __builtin_amdgcn_readfirstlane(tid >> 6), rg = wid & 3, kg = wid >> 2, ql = lane & 31, hh = lane >> 5;
    const bf16_t* QB = (const bf16_t*)(P->ws + WS_QB); const bf16_t* KB = (const bf16_t*)(P->ws + WS_KB); const bf16_t* VB = (const bf16_t*)(P->ws + WS_VB); bf16_t* MIX = (bf16_t*)(P->ws + WS_MIX);
    const int q0 = qb * 128, nsteps = 2 * (qb + 1), rowmin = q0 + 32 * rg, row = rowmin + ql;
    int gk[3], gv[2];
#pragma unroll
    for (int t = 0; t < 3; ++t) { const int p16 = (3 * wid + t) * 64 + lane, r = p16 / 24, ph = p16 - r * 24, lg = (ph & ~7) | ((ph ^ (r >> 1)) & 7); gk[t] = r * (8 * 192 * 2) + lg * 16; }
#pragma unroll
    for (int t = 0; t < 2; ++t) { const int p16 = (2 * wid + t) * 64 + lane, r = p16 >> 4, ph = p16 & 15, lg = ph ^ ((r & 3) << 2); gv[t] = r * (8 * 128 * 2) + lg * 16; }
    const char* kg0 = (const char*)(KB + ((size_t)b * SEQ * 8 + h) * 192); const char* vg0 = (const char*)(VB + ((size_t)b * SEQ * 8 + h) * 128);
#define MLA_DMA(j, slot) do { const char* kt_ = kg0 + (size_t)(j) * 64 * (8 * 192 * 2); const char* vt_ = vg0 + (size_t)(j) * 64 * (8 * 128 * 2); LAS unsigned char* sb_ = lds + (slot) * MLA_SLOT; \
        _Pragma("unroll") for (int t = 0; t < 3; ++t) ATT_DMA(kt_ + gk[t], sb_ + (3 * wid + t) * 1024); \
        _Pragma("unroll") for (int t = 0; t < 2; ++t) ATT_DMA(vt_ + gv[t], sb_ + MLA_KT + (2 * wid + t) * 1024); } while (0)
    bf16x8 qf[12];
    { const bf16_t* qp = QB + (((size_t)b * SEQ + row) * 8 + h) * 192 + 8 * hh;
#pragma unroll
      for (int ks = 0; ks < 12; ++ks) qf[ks] = *(const bf16x8*)(qp + 16 * ks); }
    MLA_DMA(0, 0); MLA_DMA(1, 1);
#pragma unroll
    for (int ks = 0; ks < 12; ++ks) asm volatile("" : "+v"(qf[ks]));
    f32x16 O[4];
#pragma unroll
    for (int d = 0; d < 4; ++d)
#pragma unroll
        for (int r = 0; r < 16; ++r) O[d][r] = 0.f;
    float m = -1e30f, l = 0.f;
    const int rk = 32 * kg + ql; int ko[4];
#pragma unroll
    for (int c = 0; c < 4; ++c) ko[c] = rk * 384 + 16 * ((2 * c + hh) ^ ((rk >> 1) & 7));
    const int q4 = (lane & 15) >> 2; int vb[4];
#pragma unroll
    for (int dt = 0; dt < 4; ++dt) vb[dt] = MLA_KT + (32 * kg + 4 * hh + q4) * 256 + 64 * (dt ^ q4) + 32 * ((lane >> 4) & 1) + 8 * (lane & 3);
    int slot = 0;
    for (int j = 0; j < nsteps; ++j) {
        if (j + 1 < nsteps) asm volatile("s_waitcnt vmcnt(5)" ::: "memory"); else asm volatile("s_waitcnt vmcnt(0)" ::: "memory");
        __builtin_amdgcn_s_barrier(); asm volatile("" ::: "memory");
        if (j + 2 < nsteps) { const int s2 = slot >= 1 ? slot - 1 : 2; MLA_DMA(j + 2, s2); }
        const int kbase = 64 * j + 32 * kg;
        if (kbase <= rowmin + 31) {
            const LAS unsigned char* buf = lds + slot * MLA_SLOT;
            f32x16 S[1];
#pragma unroll
            for (int r = 0; r < 16; ++r) S[0][r] = 0.f;
            { bf16x8 kf[12];
#pragma unroll
              for (int ks = 0; ks < 12; ++ks) kf[ks] = *(const LAS bf16x8*)(buf + ko[ks & 3] + 128 * (ks >> 2));
              __builtin_amdgcn_sched_barrier(0);
#pragma unroll
              for (int ks = 0; ks < 12; ++ks) S[0] = __builtin_amdgcn_mfma_f32_32x32x16_bf16(kf[ks], qf[ks], S[0], 0, 0, 0); }
            if (kbase + 31 > rowmin) {
#pragma unroll
                for (int r = 0; r < 16; ++r) { const int key = kbase + (r & 3) + 8 * (r >> 2) + 4 * hh; if (key > row) S[0][r] = -INFINITY; }
            }
            bf16x8 pf[1][2];
            smax_update<1>(S, m, l, O, pf);
            pv_tile_sw(O, (const LAS char*)buf, vb, pf[0]);
        }
        slot = slot == 2 ? 0 : slot + 1;
    }
    __syncthreads();
    LAS float* xb = (LAS float*)lds + rg * (66 * 64) + lane;
    if (kg == 1) {
#pragma unroll
        for (int d = 0; d < 4; ++d)
#pragma unroll
            for (int r = 0; r < 16; ++r) xb[(d * 16 + r) * 64] = O[d][r];
        xb[64 * 64] = m; xb[65 * 64] = l;
    }
    __syncthreads();
    if (kg == 0) {
        const float m1 = xb[64 * 64], l1 = xb[65 * 64];
        const float mt = fmaxf(m, m1), a0 = __builtin_amdgcn_exp2f(m - mt), a1 = __builtin_amdgcn_exp2f(m1 - mt);
        float lt = l * a0 + l1 * a1; lt = half_sum(lt);
        const float inv = 1.0f / lt;
        bf16_t* op = MIX + ((size_t)b * SEQ + row) * DM + h * 128 + 4 * hh;
#pragma unroll
        for (int d = 0; d < 4; ++d)
#pragma unroll
            for (int g4 = 0; g4 < 4; ++g4) { f32x4 v;
#pragma unroll
                for (int j = 0; j < 4; ++j) { const int r = 4 * g4 + j; v[j] = (O[d][r] * a0 + xb[(d * 16 + r) * 64] * a1) * inv; }
                *(u32x2*)(op + 32 * d + 8 * g4) = pack4(v); }
    }
    __syncthreads();
#undef MLA_DMA
}

__device__ __forceinline__ void diff_unit(KP_T P, LAS unsigned char* lds, int lyr, int b, int h, int qb, float lam_init) {
    const int tid = opq_tid(), lane = tid & 63, wid = __builtin_amdgcn_readfirstlane(tid >> 6), rg = wid & 3, mp = wid >> 2, ql = lane & 31, hh = lane >> 5;
    const bf16_t* HB = (const bf16_t*)(P->ws + WS_HB); bf16_t* MIX = (bf16_t*)(P->ws + WS_MIX);
    const int q0 = qb * 128, nsteps = 2 * (qb + 1), rowmin = q0 + 32 * rg, row = rowmin + ql;
    LAS float* tab = (LAS float*)(lds + ATT_TAB);
    if (tid < 128) { const int n = tid; int bk;
        if (n < 16) bk = n; else { bk = 16 + (int)(logf((float)n * (1.0f / 16.0f)) / 2.0794415416798357f * 16.0f); bk = bk > 31 ? 31 : bk; }
        tab[n] = P->rel_bias[bk * 4 + h] * LOG2E; }
    float lam;
    { const float a = P->diff_lq1[lyr * 64 + lane] * P->diff_lk1[lyr * 64 + lane], c = P->diff_lq2[lyr * 64 + lane] * P->diff_lk2[lyr * 64 + lane];
      lam = expf(wave_sum(a)) - expf(wave_sum(c)) + lam_init; }
    int gk[2], gv[2];
#pragma unroll
    for (int t = 0; t < 2; ++t) { const int p16 = (2 * wid + t) * 64 + lane, r = p16 >> 4, ph = p16 & 15;
        gk[t] = r * (HW * 2) + HC_DK * 2 + (ph ^ (r & 15)) * 16; gv[t] = r * (HW * 2) + HC_DV * 2 + (ph ^ ((r & 3) << 2)) * 16; }
    const char* hg0 = (const char*)(HB + (size_t)b * SEQ * HW + h * 128);
#define DIF_DMA(j, slot) do { const char* t_ = hg0 + (size_t)(j) * 64 * (HW * 2); LAS unsigned char* sb_ = lds + (slot) * DIF_SLOT; \
        _Pragma("unroll") for (int t = 0; t < 2; ++t) ATT_DMA(t_ + gk[t], sb_ + (2 * wid + t) * 1024); \
        _Pragma("unroll") for (int t = 0; t < 2; ++t) ATT_DMA(t_ + gv[t], sb_ + DIF_KT + (2 * wid + t) * 1024); } while (0)
    bf16x8 qf[4];
    { const bf16_t* qp = HB + ((size_t)b * SEQ + row) * HW + HC_DQ + h * 128 + mp * 64 + 8 * hh;
#pragma unroll
      for (int ks = 0; ks < 4; ++ks) qf[ks] = *(const bf16x8*)(qp + 16 * ks); }
    DIF_DMA(0, 0); DIF_DMA(1, 1);
#pragma unroll
    for (int ks = 0; ks < 4; ++ks) asm volatile("" : "+v"(qf[ks]));
    asm volatile("" : "+v"(lam));
    f32x16 O[4];
#pragma unroll
    for (int d = 0; d < 4; ++d)
#pragma unroll
        for (int r = 0; r < 16; ++r) O[d][r] = 0.f;
    float m = -1e30f, l = 0.f;
    int ko[4];
#pragma unroll
    for (int c = 0; c < 4; ++c) ko[c] = ql * 256 + 16 * ((8 * mp + 2 * c + hh) ^ (ql & 15));
    const int q4 = (lane & 15) >> 2; int vb[4];
#pragma unroll
    for (int dt = 0; dt < 4; ++dt) vb[dt] = DIF_KT + (4 * hh + q4) * 256 + 64 * (dt ^ q4) + 32 * ((lane >> 4) & 1) + 8 * (lane & 3);
    float c31 = 0.f; int slot = 0;
    for (int j = 0; j < nsteps; ++j) {
        if (j + 1 < nsteps) asm volatile("s_waitcnt vmcnt(4)" ::: "memory"); else asm volatile("s_waitcnt vmcnt(0)" ::: "memory");
        asm volatile("s_waitcnt lgkmcnt(0)" ::: "memory"); __builtin_amdgcn_s_barrier(); asm volatile("" ::: "memory");
        if (j == 0) c31 = tab[127];
        if (j + 2 < nsteps) { const int s2 = slot >= 1 ? slot - 1 : 2; DIF_DMA(j + 2, s2); }
        const int kbase = 64 * j;
        if (kbase <= rowmin + 31) {
            const LAS unsigned char* buf = lds + slot * DIF_SLOT;
            f32x16 S[2];
            { bf16x8 kf[2][4];
#pragma unroll
              for (int t = 0; t < 2; ++t)
#pragma unroll
                  for (int ks = 0; ks < 4; ++ks) kf[t][ks] = *(const LAS bf16x8*)(buf + ko[ks] + t * 32 * 256);
              __builtin_amdgcn_sched_barrier(0);
#pragma unroll
              for (int t = 0; t < 2; ++t) {
#pragma unroll
                  for (int r = 0; r < 16; ++r) S[t][r] = 0.f;
#pragma unroll
                  for (int ks = 0; ks < 4; ++ks) S[t] = __builtin_amdgcn_mfma_f32_32x32x16_bf16(kf[t][ks], qf[ks], S[t], 0, 0, 0); } }
            if (rowmin - (kbase + 63) >= 127) {
#pragma unroll
                for (int t = 0; t < 2; ++t)
#pragma unroll
                    for (int r = 0; r < 16; ++r) S[t][r] += c31;
            } else {
#pragma unroll
                for (int t = 0; t < 2; ++t)
#pragma unroll
                    for (int r = 0; r < 16; ++r) { const int key = kbase + 32 * t + (r & 3) + 8 * (r >> 2) + 4 * hh; int n = row - key; const bool ok = n >= 0; n = n < 0 ? 0 : (n > 127 ? 127 : n);
                        S[t][r] = ok ? S[t][r] + tab[n] : -INFINITY; }
            }
            bf16x8 pf[2][2];
            smax_update<2>(S, m, l, O, pf);
            pv_tile_sw(O, (const LAS char*)buf, vb, pf[0]);
            pv_tile_sw(O, (const LAS char*)buf + 32 * 256, vb, pf[1]);
        }
        slot = slot == 2 ? 0 : slot + 1;
    }
    __syncthreads();
    { float lt = half_sum(l); const float inv = 1.0f / lt;
#pragma unroll
      for (int d = 0; d < 4; ++d) O[d] = O[d] * inv; }
    LAS float* xb = (LAS float*)lds + rg * (64 * 64) + lane;
    if (mp == 1) {
#pragma unroll
        for (int d = 0; d < 4; ++d)
#pragma unroll
            for (int r = 0; r < 16; ++r) xb[(d * 16 + r) * 64] = O[d][r];
    }
    __syncthreads();
    if (mp == 0) {
        float ss = 0.f;
#pragma unroll
        for (int d = 0; d < 4; ++d)
#pragma unroll
            for (int r = 0; r < 16; ++r) { const float o = O[d][r] - lam * xb[(d * 16 + r) * 64]; O[d][r] = o; ss += o * o; }
        ss = half_sum(ss);
        const float rs = rsqrtf(ss * (1.0f / 128.0f) + 1e-6f) * (1.0f - lam_init);
        bf16_t* op = MIX + ((size_t)b * SEQ + row) * DM + 1536 + h * 128 + 4 * hh;
        const float* gp = P->diff_subln + lyr * 128 + 4 * hh;
#pragma unroll
        for (int d = 0; d < 4; ++d)
#pragma unroll
            for (int g4 = 0; g4 < 4; ++g4) { const f32x4 g = *(const f32x4*)(gp + 32 * d + 8 * g4); f32x4 v;
#pragma unroll
                for (int j = 0; j < 4; ++j) v[j] = O[d][4 * g4 + j] * rs * g[j];
                *(u32x2*)(op + 32 * d + 8 * g4) = pack4(v); }
    }
    __syncthreads();
#undef DIF_DMA
}

constexpr int GM_W = 0, GM_V = 128 * KROW_D, GM_ST = GM_V + 128 * VROW;
__device__ __forceinline__ void gmlp_unit(KP_T P, LAS unsigned char* lds, int lyr, int b, int c) {
    const int tid = opq_tid(), lane = tid & 63, wid = __builtin_amdgcn_readfirstlane(tid >> 6), ql = lane & 31, hh = lane >> 5;
    const bf16_t* HB = (const bf16_t*)(P->ws + WS_HB); bf16_t* MIX = (bf16_t*)(P->ws + WS_MIX);
    const size_t R0 = (size_t)b * SEQ + c * 128;
    LAS f32x2* stats = (LAS f32x2*)(lds + GM_ST);
    { const int r = 16 * wid + (lane >> 2), q = lane & 3; const bf16_t* vp = HB + (R0 + r) * HW + HC_GV + 128 * q;
      u32x4 w[16];
#pragma unroll
      for (int i = 0; i < 16; ++i) w[i] = *(const u32x4*)(vp + 8 * i);
      float s = 0.f;
#pragma unroll
      for (int i = 0; i < 16; ++i) s += ((bflo(w[i].x) + bfhi(w[i].x)) + (bflo(w[i].y) + bfhi(w[i].y))) + ((bflo(w[i].z) + bfhi(w[i].z)) + (bflo(w[i].w) + bfhi(w[i].w)));
      s += __shfl_xor(s, 1); s += __shfl_xor(s, 2);
      const float mean = s * (1.0f / 512.0f); float qv = 0.f;
#pragma unroll
      for (int i = 0; i < 16; ++i) { const float d0 = bflo(w[i].x) - mean, d1 = bfhi(w[i].x) - mean, d2 = bflo(w[i].y) - mean, d3 = bfhi(w[i].y) - mean, d4 = bflo(w[i].z) - mean, d5 = bfhi(w[i].z) - mean, d6 = bflo(w[i].w) - mean, d7 = bfhi(w[i].w) - mean;
          qv += ((d0 * d0 + d1 * d1) + (d2 * d2 + d3 * d3)) + ((d4 * d4 + d5 * d5) + (d6 * d6 + d7 * d7)); }
      qv += __shfl_xor(qv, 1); qv += __shfl_xor(qv, 2);
      if (q == 0) stats[r] = (f32x2){mean, rsqrtf(qv * (1.0f / 512.0f) + 1e-5f)}; }
    const int tt = wid & 3, dp = wid >> 2;
    const int woff = GM_W + (32 * tt + ql) * KROW_D + 16 * hh;
    const int voff = GM_V + (8 * hh + ((lane & 15) >> 2)) * VROW + (16 * ((lane >> 4) & 1) + 4 * (lane & 3)) * 2;
    f32x4 wa[4], wb[4]; u32x4 vv[4];
#define GM_FETCH(g) do { _Pragma("unroll") for (int i = 0; i < 4; ++i) { const int cid = tid + 512 * i, t = cid >> 4, s0 = (cid & 15) * 8; \
        const float* wp = P->gmlp_w_s + (((size_t)lyr * 4 + (g)) * 128 + t) * 128 + s0; wa[i] = *(const f32x4*)wp; wb[i] = *(const f32x4*)(wp + 4); \
        vv[i] = *(const u32x4*)(HB + (R0 + t) * HW + HC_GV + (g) * 128 + s0); } } while (0)
    GM_FETCH(0);
    __syncthreads();
    for (int g = 0; g < 4; ++g) {
#pragma unroll
        for (int i = 0; i < 4; ++i) { const int cid = tid + 512 * i, t = cid >> 4, s0 = (cid & 15) * 8;
            f32x4 a2, b2;
#pragma unroll
            for (int j = 0; j < 4; ++j) { a2[j] = (s0 + j <= t) ? wa[i][j] : 0.f; b2[j] = (s0 + 4 + j <= t) ? wb[i][j] : 0.f; }
            *(LAS u32x4*)(lds + GM_W + t * KROW_D + s0 * 2) = pack8(a2, b2);
            const f32x2 ms = stats[t]; const u32x4 w = vv[i];
            const float* gp = P->gmlp_ln_g + lyr * 512 + g * 128 + s0; const float* bp = P->gmlp_ln_b + lyr * 512 + g * 128 + s0;
            const f32x4 g0 = *(const f32x4*)gp, g1 = *(const f32x4*)(gp + 4), b0 = *(const f32x4*)bp, b1 = *(const f32x4*)(bp + 4);
            f32x4 v0 = {bflo(w.x), bfhi(w.x), bflo(w.y), bfhi(w.y)}, v1 = {bflo(w.z), bfhi(w.z), bflo(w.w), bfhi(w.w)};
            v0 = (v0 - ms.x) * ms.y * g0 + b0; v1 = (v1 - ms.x) * ms.y * g1 + b1;
            *(LAS u32x4*)(lds + GM_V + t * VROW + s0 * 2) = pack8(v0, v1); }
        const int t = 32 * tt + ql; const float bs = P->gmlp_b_s[((size_t)lyr * 4 + g) * 128 + t];
        const bf16_t* up = HB + (R0 + t) * HW + HC_GU + g * 128 + 4 * hh; u32x2 uw[2][4];
#pragma unroll
        for (int dd = 0; dd < 2; ++dd)
#pragma unroll
            for (int g4 = 0; g4 < 4; ++g4) uw[dd][g4] = *(const u32x2*)(up + 32 * (2 * dp + dd) + 8 * g4);
        if (g < 3) GM_FETCH(g + 1);
        __syncthreads();
        f32x16 acc[2];
#pragma unroll
        for (int dd = 0; dd < 2; ++dd)
#pragma unroll
            for (int r = 0; r < 16; ++r) acc[dd][r] = 0.f;
#pragma unroll
        for (int kp = 0; kp < 4; ++kp) {
            if (kp <= tt) {
                bf16x8 bw[2]; s16x4 lo[2][2], hi[2][2];
#pragma unroll
                for (int q = 0; q < 2; ++q) { const int ks = 2 * kp + q; bw[q] = *(const LAS bf16x8*)(lds + woff + 32 * ks);
#pragma unroll
                    for (int dd = 0; dd < 2; ++dd) { const int dt = 2 * dp + dd; lo[q][dd] = vtr((const LAS char*)(lds + voff + (16 * ks) * VROW + dt * 64)); hi[q][dd] = vtr((const LAS char*)(lds + voff + (16 * ks + 4) * VROW + dt * 64)); } }
#pragma unroll
                for (int q = 0; q < 2; ++q)
#pragma unroll
                    for (int dd = 0; dd < 2; ++dd) acc[dd] = __builtin_amdgcn_mfma_f32_32x32x16_bf16(FRAG8(lo[q][dd], hi[q][dd]), bw[q], acc[dd], 0, 0, 0);
            }
        }
        { bf16_t* op = MIX + (R0 + t) * DM + 1024 + g * 128 + 4 * hh;
#pragma unroll
          for (int dd = 0; dd < 2; ++dd)
#pragma unroll
              for (int g4 = 0; g4 < 4; ++g4) { const int d0 = 32 * (2 * dp + dd) + 8 * g4; const u32x2 u2 = uw[dd][g4];
                  f32x4 v; v[0] = bflo(u2.x) * (acc[dd][4 * g4 + 0] + bs); v[1] = bfhi(u2.x) * (acc[dd][4 * g4 + 1] + bs); v[2] = bflo(u2.y) * (acc[dd][4 * g4 + 2] + bs); v[3] = bfhi(u2.y) * (acc[dd][4 * g4 + 3] + bs);
                  *(u32x2*)(op + d0) = pack4(v); } }
        __syncthreads();
    }
#undef GM_FETCH
}

__device__ __forceinline__ int queue_pop(unsigned* q, volatile LAS unsigned* slot) {
    if (opq_tid() == 0) *slot = __hip_atomic_fetch_add(q, 1u, __ATOMIC_RELAXED, __HIP_MEMORY_SCOPE_AGENT);
    __syncthreads();
    const int v = (int)*slot;
    __syncthreads();
    return v;
}
__device__ __forceinline__ void mixer_phase(KP_T P, LAS unsigned char* lds, int lyr, unsigned long long& st_dur) {
    unsigned* ctl = (unsigned*)(P->ws + WS_CTL);
    volatile LAS unsigned* slot = (volatile LAS unsigned*)(lds + LDS_MISC + 8);
    const float lam_init = lyr == 0 ? P->lam_init0 : P->lam_init1;
#ifndef MK_MX
#define MK_MX 7
#endif
#ifdef MK_STAMP
    unsigned long long t0_ = __builtin_amdgcn_s_memrealtime();
#define SUBST(id) do { const unsigned long long t1_ = __builtin_amdgcn_s_memrealtime(); if (MK_STAMP == (id)) st_dur += t1_ - t0_; t0_ = t1_; } while (0)
#define AGG(id) do { const unsigned long long t1_ = __builtin_amdgcn_s_memrealtime(); if (MK_STAMP == (id) && threadIdx.x == 0) __hip_atomic_fetch_add(ctl + CW_ERR + 16, (unsigned)(t1_ - t0_), __ATOMIC_RELAXED, __HIP_MEMORY_SCOPE_AGENT); t0_ = t1_; } while (0)
#else
#define SUBST(id) do {} while (0)
#define AGG(id) do {} while (0)
#endif
    unsigned* cvq = ctl + CW_QUEUE + 384 + 64 * lyr;
    if ((int)(2 * ((blockIdx.x >> 3) & 7) + ((blockIdx.x >> 6) & 1)) < CVSEL2) for (;;) { const int i = queue_pop(cvq, slot); if (i >= CV_NCHUNK) break; convert_chunk(P, lds, lyr, i); }
    AGG(34);
    if (MK_MX & 4) for (;;) { const int i = queue_pop(ctl + CW_QUEUE + 192 * lyr + 128, slot); if (i >= (T / 128)) break;
        gmlp_unit(P, lds, lyr, i >> 5, i & 31); }
    AGG(35);
    if (MK_MX & 1) for (;;) { const int i = queue_pop(ctl + CW_QUEUE + 192 * lyr, slot); if (i >= 256) break;
        diff_unit(P, lds, lyr, (i & 7) >> 2, i & 3, 31 - (i >> 3), lam_init); }
    AGG(36);
    if (MK_MX & 2) for (;;) { const int i = queue_pop(ctl + CW_QUEUE + 192 * lyr + 64, slot); if (i >= 512) break;
        mla_unit(P, lds, (i & 15) >> 3, i & 7, 31 - (i >> 4)); }
    AGG(37);
    for (;;) { const int i = queue_pop(cvq, slot); if (i >= CV_NCHUNK) break; convert_chunk(P, lds, lyr, i); }
    AGG(34);
}
__device__ __forceinline__ void lnr_phase(KP_T P, LAS unsigned char* lds, int lyr, int vcu, int G, unsigned long long& st_dur) {
#ifdef MK_STAMP
    unsigned long long t0_ = __builtin_amdgcn_s_memrealtime();
#define LSUB(id) do { const unsigned long long t1_ = __builtin_amdgcn_s_memrealtime(); if (MK_STAMP == (id)) st_dur += t1_ - t0_; t0_ = t1_; } while (0)
#else
#define LSUB(id) do {} while (0)
#endif
    const int tid = opq_tid(), lane = tid & 63, wid = __builtin_amdgcn_readfirstlane(tid >> 6);
    const bf16_t* Y1 = (const bf16_t*)(P->ws + WS_Y1); const bf16_t* XBr = (const bf16_t*)(P->ws + WS_XB); bf16_t* X1B = (bf16_t*)(P->ws + WS_X1B);
    int* EIDX = (int*)(P->ws + WS_EIDX); float* EW = (float*)(P->ws + WS_EW); int* ELR = (int*)(P->ws + WS_ELR); int* HIST = (int*)(P->ws + WS_HIST);
    LAS float* xs = (LAS float*)lds;
    volatile LAS unsigned long long* selm = (volatile LAS unsigned long long*)(lds + LDS_MISC + 256);
    const float* g1 = P->ln1_g + lyr * DM; const float* b1 = P->ln1_b + lyr * DM;
    const float* rw = P->router_w + (size_t)lyr * DM * NEXP;
    const float rbias = P->router_bias[lyr * NEXP + lane];
    for (int u = vcu; u < RT_UNITS; u += G) {
        const int tok0 = u * RT_TOK;
        LSUB(44);
        const unsigned char* sbh = P->ws + WS_RTR + ((size_t)(lyr * 64 + 8 * wid) * 4) * 1024; asm volatile("" : "+s"(sbh));
        const unsigned char* sbl = sbh + (size_t)NLAYER * 16384 * 16; const unsigned lo16 = (unsigned)lane * 16u;
#define RT_LDH(q_) (*(const u32x4*)(sbh + (q_) * 1024 + lo16))
#define RT_LDL(q_) (*(const u32x4*)(sbl + (q_) * 1024 + lo16))
        u32x4 qh[8], ql[8];
#pragma unroll
        for (int q = 0; q < 8; ++q) { qh[q] = RT_LDH(q); ql[q] = RT_LDL(q); }
#pragma unroll
        for (int rr = 0; rr < 2; ++rr) { const int mrow = 2 * wid + rr; const size_t row = (size_t)(tok0 + mrow);
            f32x4 v[4][2]; float s = 0.f;
#pragma unroll
            for (int j = 0; j < 4; ++j) { const u32x4 w = *(const u32x4*)(Y1 + row * DM + 8 * lane + 512 * j), xw = *(const u32x4*)(XBr + row * DM + 8 * lane + 512 * j);
                v[j][0] = (f32x4){bflo(w.x), bfhi(w.x), bflo(w.y), bfhi(w.y)} + (f32x4){bflo(xw.x), bfhi(xw.x), bflo(xw.y), bfhi(xw.y)} * DN_ALPHA;
                v[j][1] = (f32x4){bflo(w.z), bfhi(w.z), bflo(w.w), bfhi(w.w)} + (f32x4){bflo(xw.z), bfhi(xw.z), bflo(xw.w), bfhi(xw.w)} * DN_ALPHA;
                s += ((v[j][0][0] + v[j][0][1]) + (v[j][0][2] + v[j][0][3])) + ((v[j][1][0] + v[j][1][1]) + (v[j][1][2] + v[j][1][3])); }
            const float mean = wave_sum(s) * (1.0f / DM); float q = 0.f;
#pragma unroll
            for (int j = 0; j < 4; ++j)
#pragma unroll
                for (int h = 0; h < 2; ++h) { v[j][h] = v[j][h] - mean; q += (v[j][h][0] * v[j][h][0] + v[j][h][1] * v[j][h][1]) + (v[j][h][2] * v[j][h][2] + v[j][h][3] * v[j][h][3]); }
            const float rstd = rsqrtf(wave_sum(q) * (1.0f / DM) + 1e-5f);
#pragma unroll
            for (int j = 0; j < 4; ++j) { const int col = 8 * lane + 512 * j;
                const f32x4 o0 = v[j][0] * rstd * *(const f32x4*)(g1 + col) + *(const f32x4*)(b1 + col), o1 = v[j][1] * rstd * *(const f32x4*)(g1 + col + 4) + *(const f32x4*)(b1 + col + 4);
                const u32x4 hi = pack8(o0, o1);
                *(u32x4*)(X1B + row * XSTR + col) = hi;
                const f32x4 r0 = o0 - (f32x4){bflo(hi.x), bfhi(hi.x), bflo(hi.y), bfhi(hi.y)}, r1 = o1 - (f32x4){bflo(hi.z), bfhi(hi.z), bflo(hi.w), bfhi(hi.w)};
                const int ch = (col >> 3) ^ (mrow & 7);
                *(LAS u32x4*)(lds + mrow * 4096 + 16 * ch) = hi; *(LAS u32x4*)(lds + 65536 + mrow * 4096 + 16 * ch) = pack8(r0, r1); } }
        __syncthreads();
        LSUB(41);
        f32x4 acc[4];
#pragma unroll
        for (int n = 0; n < 4; ++n) acc[n] = (f32x4){0.f, 0.f, 0.f, 0.f};
        { const int i = lane & 15, g = lane >> 4, sw = i & 7;
          const LAS unsigned char* ah = lds + i * 4096; const LAS unsigned char* al = ah + 65536;
#pragma unroll
          for (int s = 0; s < 8; ++s) {
              const bf16x8 Ah = *(const LAS bf16x8*)(ah + 16 * ((4 * (8 * wid + s) + g) ^ sw)), Al = *(const LAS bf16x8*)(al + 16 * ((4 * (8 * wid + s) + g) ^ sw));
              bf16x8 Bh[4], Bl[4];
#pragma unroll
              for (int n = 0; n < 4; ++n) { const int q = (s & 1) * 4 + n; Bh[n] = __builtin_bit_cast(bf16x8, qh[q]); Bl[n] = __builtin_bit_cast(bf16x8, ql[q]);
                  if (s < 6) { qh[q] = RT_LDH((s + 2) * 4 + n); ql[q] = RT_LDL((s + 2) * 4 + n); } }
#pragma unroll
              for (int n = 0; n < 4; ++n) acc[n] = __builtin_amdgcn_mfma_f32_16x16x32_bf16(Ah, Bh[n], acc[n], 0, 0, 0);
#pragma unroll
              for (int n = 0; n < 4; ++n) acc[n] = __builtin_amdgcn_mfma_f32_16x16x32_bf16(Ah, Bl[n], acc[n], 0, 0, 0);
#pragma unroll
              for (int n = 0; n < 4; ++n) acc[n] = __builtin_amdgcn_mfma_f32_16x16x32_bf16(Al, Bh[n], acc[n], 0, 0, 0);
              __builtin_amdgcn_sched_barrier(0); } }
#undef RT_LDH
#undef RT_LDL
        __syncthreads();
        LSUB(42);
        { LAS float* part = xs + wid * (16 * 64);
#pragma unroll
          for (int n = 0; n < 4; ++n)
#pragma unroll
              for (int r = 0; r < 4; ++r) part[(4 * (lane >> 4) + r) * 64 + 4 * (lane & 15) + n] = acc[n][r]; }
        __syncthreads();
#pragma unroll
        for (int rr = 0; rr < 2; ++rr) { const int tk = 2 * wid + rr; float logit = 0.f;
#pragma unroll
            for (int w = 0; w < 8; ++w) logit += xs[w * (16 * 64) + tk * 64 + lane];
            const float score = 1.0f / (1.0f + expf(-logit));
            const float biased = score + rbias;
            float t1 = -INFINITY, t2 = -INFINITY;
#pragma unroll
            for (int j = 0; j < 8; ++j) { const float o = __shfl(biased, (lane & ~7) + j); const float lo = fminf(t1, o); t1 = fmaxf(t1, o); t2 = fmaxf(t2, lo); }
            const float gs = t1 + t2; int grank = 0;
#pragma unroll
            for (int gp = 0; gp < 8; ++gp) { const float o = __int_as_float(__builtin_amdgcn_readlane(__float_as_int(gs), 8 * gp)); grank += (o > gs || (o == gs && gp < (lane >> 3))) ? 1 : 0; }
            const float v = (grank < 4) ? biased : -INFINITY;
            int rank = 0;
#pragma unroll
            for (int e = 0; e < 64; ++e) { const float o = __int_as_float(__builtin_amdgcn_readlane(__float_as_int(v), e)); rank += (o > v || (o == v && e < lane)) ? 1 : 0; }
            const bool chosen = rank < TOPK;
            const unsigned long long sm = __ballot(chosen);
            const float ssum = wave_sum(chosen ? score : 0.f);
            const int kpos = __builtin_popcountll(sm & ((1ull << lane) - 1ull));
            if (chosen) { EIDX[(size_t)(tok0 + tk) * 8 + kpos] = lane; EW[(size_t)(tok0 + tk) * 8 + kpos] = score / ssum * 2.5f; }
            if (lane == 0) selm[tk] = sm; }
        __syncthreads();
        { int bit[RT_TOK];
#pragma unroll
          for (int t2 = 0; t2 < RT_TOK; ++t2) bit[t2] = (int)((((const LAS unsigned long long*)(lds + LDS_MISC + 256))[t2] >> lane) & 1ull);
#pragma unroll
          for (int rr = 0; rr < 2; ++rr) { const int tk = 2 * wid + rr; const unsigned long long sm = ((const LAS unsigned long long*)(lds + LDS_MISC + 256))[tk];
              int lr = 0;
#pragma unroll
              for (int t2 = 0; t2 < RT_TOK; ++t2) lr += (t2 < tk) ? bit[t2] : 0;
              if ((sm >> lane) & 1ull) ELR[(size_t)(tok0 + tk) * 8 + __builtin_popcountll(sm & ((1ull << lane) - 1ull))] = lr; }
          if (wid == 0) { int hc = 0;
#pragma unroll
              for (int t2 = 0; t2 < RT_TOK; ++t2) hc += bit[t2];
              HIST[(size_t)u * 64 + lane] = hc; } }
        __syncthreads();
        LSUB(43);
    }
}

__device__ __forceinline__ void slot_phase(KP_T P, LAS unsigned char* lds, int vcu, int G) {
    const int tid = opq_tid(), lane = tid & 63, wid = __builtin_amdgcn_readfirstlane(tid >> 6);
    const int* HIST = (const int*)(P->ws + WS_HIST); const int* EIDX = (const int*)(P->ws + WS_EIDX); const float* EW = (const float*)(P->ws + WS_EW); const int* ELR = (const int*)(P->ws + WS_ELR);
    int* EOFF = (int*)(P->ws + WS_EOFF); int* SLOT = (int*)(P->ws + WS_SLOT); int* ROWIDX = (int*)(P->ws + WS_ROWIDX); float* GATEW = (float*)(P->ws + WS_GATEW);
    LAS int* tmp = (LAS int*)lds;
    LAS int* tot = tmp + 512;
    LAS int* off = tot + 64;
    LAS int* base = off + 72;
    LAS int* pre = base + 64;
    const int ua = vcu, ub = vcu + G;
    { int s = 0, sa = 0, sb = 0;
#pragma unroll 16
      for (int u = wid; u < RT_UNITS; u += 8) { const int hv = HIST[(size_t)u * 64 + lane]; s += hv; sa += (u < ua) ? hv : 0; sb += (u < ub) ? hv : 0; }
      tmp[wid * 64 + lane] = s; pre[wid * 64 + lane] = sa; pre[512 + wid * 64 + lane] = sb; }
    __syncthreads();
    if (tid < 64) { int s = 0;
#pragma unroll
        for (int w = 0; w < 8; ++w) s += tmp[w * 64 + tid]; tot[tid] = s; }
    __syncthreads();
    if (tid == 0) { int o = 0; for (int e = 0; e < NEXP; ++e) { off[e] = o; o += (tot[e] + 255) & ~255; } off[64] = o; off[65] = o + T; }
    __syncthreads();
    if (vcu == 0 && tid < 67) EOFF[tid] = tid < 66 ? off[tid] : off[65] / 256;
    if (vcu == 0 && tid >= 128 && tid < 192) EOFF[80 + tid - 128] = tot[tid - 128];
    for (int u = vcu, ui = 0; u < RT_UNITS; u += G, ++ui) {
        const LAS int* pp = ui < 2 ? pre + ui * 512 : tmp;
        if (ui >= 2) {
            int s = 0;
#pragma unroll 16
            for (int u2 = wid; u2 < RT_UNITS; u2 += 8) { const int hv = HIST[(size_t)u2 * 64 + lane]; s += (u2 < u) ? hv : 0; }
            tmp[wid * 64 + lane] = s;
            __syncthreads(); }
        if (tid < 64) { int s = off[tid];
#pragma unroll
            for (int w = 0; w < 8; ++w) s += pp[w * 64 + tid]; base[tid] = s; }
        __syncthreads();
        if (tid < RT_TOK * 8) { const size_t i = (size_t)u * (RT_TOK * 8) + tid; const int e = EIDX[i], slot = base[e] + ELR[i];
            SLOT[i] = slot; ROWIDX[slot] = (int)(i >> 3); }
        __syncthreads();
    }
    for (int e = vcu; e < NEXP; e += G) for (int s = off[e] + tot[e] + tid; s < off[e + 1]; s += NTHREADS) ROWIDX[s] = 0;
    for (int t = vcu * NTHREADS + tid; t < T; t += G * NTHREADS) ROWIDX[off[64] + t] = t;
}

__device__ __forceinline__ int moe_tables(KP_T P, LAS unsigned char* lds) {
    const int* EOFF = (const int*)(P->ws + WS_EOFF);
    LAS int* eo = (LAS int*)(lds + LDS_MISC + 384);
    LAS int* t2e = (LAS int*)(lds + LDS_MISC + 1024);
    const int tid = opq_tid();
    if (tid < 67) eo[tid] = EOFF[tid];
    if (tid >= 128 && tid < 192) eo[80 + tid - 128] = EOFF[80 + tid - 128];
    __syncthreads();
    const int ntiles = eo[66];
    for (int mt = tid; mt < ntiles; mt += NTHREADS) { int e = 0; for (int k = 1; k <= NEXP; ++k) e = (mt * 256 >= eo[k]) ? k : e; t2e[mt] = e; }
    __syncthreads();
    { const int lane = tid & 63, w = tid >> 6; const bool act = tid < ntiles; int valid = 0;
      if (act) { const int e = t2e[tid]; valid = (e == NEXP ? T : eo[80 + e]) - (tid * 256 - eo[e]); }
      const bool heavy = act && valid > 128, light = act && valid <= 128;
      const unsigned long long hb = __ballot(heavy), lb = __ballot(light);
      LAS int* wc = (LAS int*)(lds + LDS_MISC + 64);
      if (lane == 0) { wc[w] = __builtin_popcountll(hb); wc[8 + w] = __builtin_popcountll(lb); }
      __syncthreads();
      int ph = 0, pl = 0, nh = 0;
#pragma unroll
      for (int k = 0; k < 8; ++k) { const int ch = wc[k], cl = wc[8 + k]; nh += ch; if (k < w) { ph += ch; pl += cl; } }
      const unsigned long long lt = (1ull << lane) - 1ull;
      if (heavy) t2e[MAXTILES + ph + __builtin_popcountll(hb & lt)] = tid;
      if (light) t2e[MAXTILES + nh + pl + __builtin_popcountll(lb & lt)] = tid | (1 << 16); }
    __syncthreads();
    return ntiles;
}

__device__ __forceinline__ void combine_phase(KP_T P, int lyr, int vcu, int G) {
    const int tid = opq_tid(), lane = tid & 63, wid = __builtin_amdgcn_readfirstlane(tid >> 6);
    const bf16_t* X1B = (const bf16_t*)(P->ws + WS_X1B); const unsigned char* YM = (const unsigned char*)(P->ws + WS_YMOE); const int* SLOT = (const int*)(P->ws + WS_SLOT); const int* EOFF = (const int*)(P->ws + WS_EOFF);
    bf16_t* XB = (bf16_t*)(P->ws + WS_XB);
    const float* g2 = P->ln2_g + lyr * DM; const float* b2 = P->ln2_b + lyr * DM; const float* EW = (const float*)(P->ws + WS_EW);
    const int shoff = EOFF[64];
    for (int tok = vcu * NWAVES + wid; tok < T; tok += G * NWAVES) {
        int slot[9]; float gw[9];
#pragma unroll
        for (int k = 0; k < 8; ++k) { slot[k] = SLOT[(size_t)tok * 8 + k]; gw[k] = EW[(size_t)tok * 8 + k] * 0.125f; }
        slot[8] = shoff + tok; gw[8] = 0.125f;
        u32x4 yw[9][2];
#pragma unroll
        for (int k = 0; k < 9; ++k)
#pragma unroll
            for (int j = 0; j < 2; ++j) yw[k][j] = *(const u32x4*)(YM + (size_t)slot[k] * DM + 16 * lane + 1024 * j);
        f32x4 v[2][4];
#pragma unroll
        for (int j = 0; j < 2; ++j) { const bf16_t* xp = X1B + (size_t)tok * XSTR + 16 * lane + 1024 * j; const u32x4 w0 = *(const u32x4*)xp, w1 = *(const u32x4*)(xp + 8);
            v[j][0] = (f32x4){bflo(w0.x), bfhi(w0.x), bflo(w0.y), bfhi(w0.y)} * DN_ALPHA; v[j][1] = (f32x4){bflo(w0.z), bfhi(w0.z), bflo(w0.w), bfhi(w0.w)} * DN_ALPHA;
            v[j][2] = (f32x4){bflo(w1.x), bfhi(w1.x), bflo(w1.y), bfhi(w1.y)} * DN_ALPHA; v[j][3] = (f32x4){bflo(w1.z), bfhi(w1.z), bflo(w1.w), bfhi(w1.w)} * DN_ALPHA; }
#pragma unroll
        for (int k = 0; k < 9; ++k)
#pragma unroll
            for (int j = 0; j < 2; ++j) { const u32x4 w = yw[k][j]; const float g = gw[k];
                v[j][0] += (f32x4){__builtin_amdgcn_cvt_f32_fp8((int)w.x, 0), __builtin_amdgcn_cvt_f32_fp8((int)w.x, 1), __builtin_amdgcn_cvt_f32_fp8((int)w.x, 2), __builtin_amdgcn_cvt_f32_fp8((int)w.x, 3)} * g;
                v[j][1] += (f32x4){__builtin_amdgcn_cvt_f32_fp8((int)w.y, 0), __builtin_amdgcn_cvt_f32_fp8((int)w.y, 1), __builtin_amdgcn_cvt_f32_fp8((int)w.y, 2), __builtin_amdgcn_cvt_f32_fp8((int)w.y, 3)} * g;
                v[j][2] += (f32x4){__builtin_amdgcn_cvt_f32_fp8((int)w.z, 0), __builtin_amdgcn_cvt_f32_fp8((int)w.z, 1), __builtin_amdgcn_cvt_f32_fp8((int)w.z, 2), __builtin_amdgcn_cvt_f32_fp8((int)w.z, 3)} * g;
                v[j][3] += (f32x4){__builtin_amdgcn_cvt_f32_fp8((int)w.w, 0), __builtin_amdgcn_cvt_f32_fp8((int)w.w, 1), __builtin_amdgcn_cvt_f32_fp8((int)w.w, 2), __builtin_amdgcn_cvt_f32_fp8((int)w.w, 3)} * g; }
        float s = 0.f;
#pragma unroll
        for (int j = 0; j < 2; ++j)
#pragma unroll
            for (int q = 0; q < 4; ++q) s += (v[j][q][0] + v[j][q][1]) + (v[j][q][2] + v[j][q][3]);
        const float mean = wave_sum(s) * (1.0f / DM); float qq = 0.f;
#pragma unroll
        for (int j = 0; j < 2; ++j)
#pragma unroll
            for (int q = 0; q < 4; ++q) { v[j][q] = v[j][q] - mean; qq += (v[j][q][0] * v[j][q][0] + v[j][q][1] * v[j][q][1]) + (v[j][q][2] * v[j][q][2] + v[j][q][3] * v[j][q][3]); }
        const float rstd = rsqrtf(wave_sum(qq) * (1.0f / DM) + 1e-5f);
#pragma unroll
        for (int j = 0; j < 2; ++j) { const int col = 16 * lane + 1024 * j; f32x4 o[4];
#pragma unroll
            for (int q = 0; q < 4; ++q) o[q] = v[j][q] * rstd * *(const f32x4*)(g2 + col + 4 * q) + *(const f32x4*)(b2 + col + 4 * q);
            if (lyr == NLAYER - 1) {
#pragma unroll
                for (int q = 0; q < 4; ++q) *(f32x4*)(P->out + (size_t)tok * DM + col + 4 * q) = o[q]; }
            else { *(u32x4*)(XB + (size_t)tok * DM + col) = pack8(o[0], o[1]); *(u32x4*)(XB + (size_t)tok * DM + col + 8) = pack8(o[2], o[3]); } }
    }
}
#ifndef MK_EN
#define MK_EN 0x3ff
#endif
#define EN(k) ((MK_EN >> (k)) & 1)
__global__ void __launch_bounds__(NTHREADS, 2) fwd(Params Parg) {
    extern __shared__ __attribute__((aligned(16))) unsigned char lds_raw[];
    LAS unsigned char* lds0 = (LAS unsigned char*)lds_raw;
    KP_T KP = (KP_T)__builtin_amdgcn_kernarg_segment_ptr();
    const int tid = threadIdx.x, G0 = gridDim.x, bx0 = blockIdx.x;
    const int vcu0 = (G0 % 8 == 0) ? (bx0 % 8) * (G0 / 8) + bx0 / 8 : bx0;
    for (int i = tid; i < (LDS_BYTES - LDS_MISC) / 4; i += NTHREADS) ((LAS unsigned*)(lds0 + LDS_MISC))[i] = 0u;
    __syncthreads();
    const int ph_lo = KP->ph_lo, ph_hi = KP->ph_hi, use_bar = KP->use_bar;
    XcdBarrier bar; bar.bar = (unsigned*)(KP->ws + WS_CTL) + CW_BAR; bar.x = 0; bar.st = (volatile LAS unsigned*)(lds0 + LDS_MISC);
    if (use_bar) bar = xcd_barrier_post(bar.bar, (volatile LAS unsigned*)(lds0 + LDS_MISC));
#define IN(k) (ph_lo <= (k) && (k) < ph_hi)
#define PHASE_BEGIN() KP_T P = KP; int G = G0, bx = bx0, vcu = vcu0, l = l0; unsigned lo_ = 0u; asm volatile("" : "+s"(P), "+s"(G), "+s"(bx), "+s"(vcu), "+s"(lo_), "+s"(l)); LAS unsigned char* lds = lds0 + lo_; (void)G; (void)bx; (void)vcu; (void)lds; (void)l
#define SEAM(k) do { if (IN(k) && IN((k) + 1) && use_bar) xcd_barrier(bar); } while (0)
#ifdef MK_STAMP
    unsigned long long st_dur = 0ull, st_t0 = 0ull;
    unsigned long long st_c0 = 0ull, st_dc = 0ull, st_dr = 0ull;
#define ST_BEGIN(ty) do { if ((ty) == MK_STAMP) st_t0 = __builtin_amdgcn_s_memrealtime(); if (MK_STAMP == 77 && (ty) == 7) { st_t0 = __builtin_amdgcn_s_memrealtime(); st_c0 = __builtin_amdgcn_s_memtime(); } } while (0)
#define ST_END(ty) do { if ((ty) == MK_STAMP) st_dur += __builtin_amdgcn_s_memrealtime() - st_t0; if (MK_STAMP == 77 && (ty) == 7) { st_dr += __builtin_amdgcn_s_memrealtime() - st_t0; st_dc += __builtin_amdgcn_s_memtime() - st_c0; } } while (0)
#else
    unsigned long long st_dur = 0ull;
#define ST_BEGIN(ty) do {} while (0)
#define ST_END(ty) do {} while (0)
#endif

    unsigned long long gstv[2] = {0ull, 0ull}; unsigned long long* gstp = nullptr;
#ifdef MK_STAMP
    if (MK_STAMP == 61 || MK_STAMP == 62) gstp = gstv;
#endif
    ST_BEGIN(0);
    { const int l0 = 0; if (EN(0) && IN(PH_PRO)) { PHASE_BEGIN(); prologue_phase(P, lds, vcu, G); } }
    SEAM(PH_PRO);
    ST_END(0);
    for (int l0 = 0; l0 < NLAYER; ++l0) {
        const int pb = PH_L0 + PHL_N * l0;
        ST_BEGIN(1);
        if (EN(1) && IN(pb + PHL_G1)) {
            PHASE_BEGIN(); unsigned char* ws = P->ws;
            SchedDense S{DM, DM, T / 256, 8, 0, G, bx};
            Epi1 E{(bf16_t*)(ws + WS_HB), (float*)(ws + WS_RSS), (bf16_t*)(ws + WS_KB), (const float*)(ws + WS_ROPE), (const float*)(ws + WS_ROPE) + SEQ * 32};
            pg8::gemm_phase<Epi1, SchedDense, false>(nullptr, lds, (const char*)(ws + WS_XB), (const char*)(ws + WS_WIN + l * SZ_WIN), nullptr, DM, DM, DM, S, E);
        }
        SEAM(pb + PHL_G1);
        ST_END(1);
        ST_BEGIN(2);
        if (EN(2) && IN(pb + PHL_G2)) {
            PHASE_BEGIN(); unsigned char* ws = P->ws;
            { SchedDense S{DM, DM, T / 256, 6, 8, 192, bx};
              Epi1 E{(bf16_t*)(ws + WS_HB), (float*)(ws + WS_RSS), (bf16_t*)(ws + WS_KB), (const float*)(ws + WS_ROPE), (const float*)(ws + WS_ROPE) + SEQ * 32};
              pg8::gemm_phase<Epi1, SchedDense, false>(nullptr, lds, (const char*)(ws + WS_XB), (const char*)(ws + WS_WIN + l * SZ_WIN), nullptr, DM, DM, DM, S, E); }
            { SchedDense S{HW, 512, T / 256, 1536 / 256, 0, 64, bx - 192};
              Epi2 E{0, (const float*)(ws + WS_RSS), (bf16_t*)(ws + WS_QB), (bf16_t*)(ws + WS_KB), (bf16_t*)(ws + WS_VB), (const float*)(ws + WS_ROPE), (const float*)(ws + WS_ROPE) + SEQ * 32};
              pg8::gemm_phase<Epi2, SchedDense, false>(nullptr, lds, (const char*)(ws + WS_HB) + HC_CQ * 2, (const char*)(ws + WS_WUQ + l * SZ_WUQ), nullptr, 512, HW, 512, S, E); }
            { SchedDense S{HW, 256, T / 256, 2048 / 256, 0, G, bx};
              Epi2 E{1, (const float*)(ws + WS_RSS), (bf16_t*)(ws + WS_QB), (bf16_t*)(ws + WS_KB), (bf16_t*)(ws + WS_VB), (const float*)(ws + WS_ROPE), (const float*)(ws + WS_ROPE) + SEQ * 32};
              pg8::gemm_phase<Epi2, SchedDense, false>(nullptr, lds, (const char*)(ws + WS_HB) + HC_CKV * 2, (const char*)(ws + WS_WUKV + l * SZ_WUKV), nullptr, 256, HW, 256, S, E); }
        }
        SEAM(pb + PHL_G2);
        ST_END(2);
        ST_BEGIN(3);
        if (EN(3) && IN(pb + PHL_MIX)) { PHASE_BEGIN(); mixer_phase(P, lds, l, st_dur); }
        SEAM(pb + PHL_MIX);
        ST_END(3);
        ST_BEGIN(4);
        if (EN(4) && IN(pb + PHL_WO)) {
            PHASE_BEGIN(); unsigned char* ws = P->ws;
            SchedDense S{DM, DM, T / 256, DM / 256, 0, G, bx};
            EpiWO E{(bf16_t*)(ws + WS_Y1)};
            pg8::gemm_phase<EpiWO, SchedDense, false>(nullptr, lds, (const char*)(ws + WS_MIX), (const char*)(ws + WS_WO + l * SZ_WO), nullptr, DM, DM, DM, S, E);
        }
        SEAM(pb + PHL_WO);
        ST_END(4);
        ST_BEGIN(5);
        if (EN(5) && IN(pb + PHL_LNR)) { PHASE_BEGIN(); lnr_phase(P, lds, l, vcu, G, st_dur); }
        SEAM(pb + PHL_LNR);
        ST_END(5);
        ST_BEGIN(6);
        if (EN(6) && IN(pb + PHL_SLOT)) { PHASE_BEGIN(); slot_phase(P, lds, vcu, G); }
        SEAM(pb + PHL_SLOT);
        ST_END(6);
        ST_BEGIN(7);
        if (EN(7) && IN(pb + PHL_GU)) {
            PHASE_BEGIN(); unsigned char* ws = P->ws;
            const int ntiles = moe_tables(P, lds);
            SchedMoE S{(const LAS int*)(lds + LDS_MISC + 1024), (unsigned)SZ_WGU1, 0, WGSTR, 4, ntiles * 4, G, vcu};
            EpiGU E{(bf16_t*)(ws + WS_HMOE)};
            LAS int* gidx = (LAS int*)(lds + LDS_GIDX);
            { const int* RI = (const int*)(ws + WS_ROWIDX); const int t_ = opq_tid(), hi_ = t_ >> 8, row_ = t_ & 255; int iv_[4];
#pragma unroll
              for (int s_ = 0; s_ < 4; ++s_) { pg8::Unit u_; iv_[s_] = S.next(2 * s_ + hi_, u_) ? RI[u_.r0 + row_] : 0; }
#pragma unroll
              for (int s_ = 0; s_ < 4; ++s_) gidx[(2 * s_ + hi_) * 256 + row_] = iv_[s_];
              __syncthreads(); }
            pg8::gemm_phase<EpiGU, SchedMoE, true>(gstp, lds, (const char*)(ws + WS_X1B), (const char*)(ws + WS_WGU + l * SZ_WGU), gidx, DM, XSTR, WGSTR, S, E);
        }
        SEAM(pb + PHL_GU);
        ST_END(7);
        ST_BEGIN(8);
        if (EN(8) && IN(pb + PHL_DN)) {
            PHASE_BEGIN(); unsigned char* ws = P->ws;
            const int ntiles = use_bar ? ((const LAS int*)(lds + LDS_MISC + 384))[66] : moe_tables(P, lds);
            SchedMoE S{(const LAS int*)(lds + LDS_MISC + 1024), (unsigned)SZ_WD1, HSTR * 2, WDSTR, 8, ntiles * 8, G, vcu};
            EpiDN E{(unsigned char*)(ws + WS_YMOE)};
            pg8::gemm_phase<EpiDN, SchedMoE, false>(nullptr, lds, (const char*)(ws + WS_HMOE), (const char*)(ws + WS_WD + l * SZ_WD), nullptr, EDIM, HSTR, WDSTR, S, E);
        }
        SEAM(pb + PHL_DN);
        ST_END(8);
        ST_BEGIN(9);
        if (EN(9) && IN(pb + PHL_CMB)) { PHASE_BEGIN(); combine_phase(P, l, vcu, G); }
        SEAM(pb + PHL_CMB);
        ST_END(9);
    }
#ifdef MK_STAMP
    if (MK_STAMP == 61) st_dur = gstv[0]; if (MK_STAMP == 62) st_dur = gstv[1];
    if (MK_STAMP >= 34 && MK_STAMP <= 37) st_dur = __hip_atomic_load((unsigned*)(KP->ws + WS_CTL) + CW_ERR + 16, __ATOMIC_RELAXED, __HIP_MEMORY_SCOPE_AGENT) / 256u;
    if (MK_STAMP == 77) st_dur = st_dr ? 2500ull * st_dc / st_dr : 0ull;
    if (bx0 == 0 && threadIdx.x == 0) { const unsigned long long te = __builtin_amdgcn_s_memrealtime(); while (__builtin_amdgcn_s_memrealtime() - te < 4ull * st_dur) __builtin_amdgcn_s_sleep(8); }
#endif
#undef IN
#undef SEAM
}
#ifndef MK_MULTI
#define MK_MULTI 0
#endif
extern "C" void kernel_launch(void* const* d_in, const int* in_sizes, int n_in, void* d_out, int out_size, void* d_ws, size_t ws_size, hipStream_t stream) {
    static int grid = 0;
    if (grid == 0) {
        if (n_in != 29 || out_size != T * DM || ws_size < WS_END) { fprintf(stderr, "kernel_launch: unexpected shapes (n_in %d, out %d, ws %zu < %zu)\n", n_in, out_size, ws_size, (size_t)WS_END); grid = -1; return; }
        int dev = 0, cus = 0, per_cu = 0;
        if (hipGetDevice(&dev) != hipSuccess || hipDeviceGetAttribute(&cus, hipDeviceAttributeMultiprocessorCount, dev) != hipSuccess) { grid = -1; return; }
        if (hipFuncSetAttribute((const void*)fwd, hipFuncAttributeMaxDynamicSharedMemorySize, LDS_BYTES) != hipSuccess) { fprintf(stderr, "kernel_launch: hipFuncSetAttribute failed\n"); grid = -1; return; }
        if (hipOccupancyMaxActiveBlocksPerMultiprocessor(&per_cu, (const void*)fwd, NTHREADS, LDS_BYTES) != hipSuccess || per_cu < 1) { fprintf(stderr, "kernel_launch: occupancy query says %d\n", per_cu); }
        (void)hipGetLastError();
        grid = cus;
    }
    if (grid < 0) return;
    (void)hipMemsetAsync((char*)d_ws + WS_CTL, 0, CTL_ZERO_BYTES, stream);
    Params p{};
    const float** f = (const float**)&p;
    for (int i = 0; i < 29; ++i) f[i] = (const float*)d_in[i];
    p.out = (float*)d_out; p.ws = (unsigned char*)d_ws; p.dbg = 0;
    p.lam_init0 = (float)(0.8 - 0.6 * exp(-0.3 * 0.0)); p.lam_init1 = (float)(0.8 - 0.6 * exp(-0.3 * 1.0));
#if MK_MULTI
    for (int ph = 0; ph < PH_END; ++ph) {
        p.ph_lo = ph; p.ph_hi = ph + 1; p.use_bar = 0;
        hipLaunchKernelGGL(fwd, dim3(grid), dim3(NTHREADS), LDS_BYTES, stream, p);
#if MK_DBG
        dbg_after_phase(p, ph, stream);
#endif
    }
#if MK_DBG
    hipLaunchKernelGGL(dbg_report, dim3(256), dim3(256), 0, stream, p);
#endif
#else
    p.ph_lo = 0; p.ph_hi = PH_END; p.use_bar = 1;
    hipLaunchKernelGGL(fwd, dim3(grid), dim3(NTHREADS), LDS_BYTES, stream, p);
#endif
}
```

```cpp
#include <hip/hip_runtime.h>
#include <cstdio>
#include <cstdint>
#include <cmath>

#define LAS __attribute__((address_space(3)))
#define GAS __attribute__((address_space(1)))
typedef unsigned short bf16_t;
typedef short bf16x8 __attribute__((ext_vector_type(8)));
typedef short s16x4 __attribute__((ext_vector_type(4)));
typedef float f32x2 __attribute__((ext_vector_type(2)));
typedef float f32x4 __attribute__((ext_vector_type(4)));
typedef float f32x16 __attribute__((ext_vector_type(16)));
typedef unsigned u32x2 __attribute__((ext_vector_type(2)));
typedef unsigned u32x4 __attribute__((ext_vector_type(4)));
typedef __bf16 bf16x2_t __attribute__((ext_vector_type(2)));

constexpr int NB = 2, SEQ = 4096, T = NB * SEQ, DM = 2048, NLAYER = 2;
constexpr int IN_W = 3392;
constexpr int HW = 3584;
constexpr int HC_CQ = 0, HC_CKV = 512, HC_GU = 768, HC_GV = 1280, HC_DQ = 1792, HC_DK = 2304, HC_DV = 2816, HC_KR = 3328;
constexpr int NEXP = 64, NEXP1 = 65, EDIM = 512, TOPK = 8;
constexpr int MAXTILES = 352, NSLOT = MAXTILES * 256;
constexpr int NWAVES = 8, NTHREADS = 512;
constexpr float LOG2E = 1.4426950408889634f;
constexpr float DN_ALPHA = 1.4142135623730951f;
constexpr int RT_TOK = 16, RT_UNITS = T / RT_TOK;

__device__ __forceinline__ unsigned cvtpk(float lo, float hi) { f32x2 v = {lo, hi}; bf16x2_t b = __builtin_convertvector(v, bf16x2_t); return __builtin_bit_cast(unsigned, b); }
__device__ __forceinline__ float bf2f(unsigned short h) { return __uint_as_float(((unsigned)h) << 16); }
__device__ __forceinline__ float bflo(unsigned w) { return __uint_as_float(w << 16); }
__device__ __forceinline__ float bfhi(unsigned w) { return __uint_as_float(w & 0xffff0000u); }
__device__ __forceinline__ float wave_sum(float v) {
#pragma unroll
    for (int o = 1; o < 64; o <<= 1) v += __shfl_xor(v, o);
    return v;
}
__device__ __forceinline__ float wave_max(float v) {
#pragma unroll
    for (int o = 1; o < 64; o <<= 1) v = fmaxf(v, __shfl_xor(v, o));
    return v;
}
__device__ __forceinline__ float gelu_tanh(float x) {
    const float p = __builtin_fmaf(x * x, -0.044715f * 1.5957691216057308f * LOG2E, -1.5957691216057308f * LOG2E);
    return x * __builtin_amdgcn_rcpf(1.0f + __builtin_amdgcn_exp2f(x * p));
}
__device__ __forceinline__ float sigmoidf_(float x) { return __builtin_amdgcn_rcpf(1.0f + __builtin_amdgcn_exp2f(-LOG2E * x)); }
__device__ __forceinline__ int opq_tid() { int t = threadIdx.x; asm volatile("" : "+v"(t)); return t; }
#define LDS_WAIT() asm volatile("s_waitcnt lgkmcnt(0)" ::: "memory")
#define VM_WAIT() asm volatile("s_waitcnt vmcnt(0)" ::: "memory")

#define XB_TMO      128
#define XB_XCNT(j)  (256  + 64 * (j))
#define XB_XSUB(j)  (1280 + 64 * (j))
#define XB_XGEN(j)  (2304 + 64 * (j))
#define XB_TOP      3328
#define XB_TOPGEN   3392
#define XCD_BAR_WORDS 3456
#define XB_SPIN_CAP (1u << 18)
__device__ __forceinline__ unsigned xb_ld(unsigned* p)              { return __hip_atomic_load(p, __ATOMIC_RELAXED, __HIP_MEMORY_SCOPE_AGENT); }
__device__ __forceinline__ unsigned xb_add(unsigned* p, unsigned v) { return __hip_atomic_fetch_add(p, v, __ATOMIC_RELAXED, __HIP_MEMORY_SCOPE_AGENT); }
__device__ __forceinline__ unsigned xb_xcc_id() { return (unsigned)__builtin_amdgcn_s_getreg((3 << 11) | 20) & 0xFu; }
#define XB_SPIN(cond, bar) do { unsigned _sp = 0; while (cond) { __builtin_amdgcn_s_sleep(1); \
    if ((++_sp & 255u) == 0u) { if (xb_ld(&(bar)[XB_TMO])) break; if (_sp > XB_SPIN_CAP) { atomicAdd(&(bar)[XB_TMO], 1u); break; } } } } while (0)
struct XcdBarrier { unsigned* bar; unsigned x; volatile LAS unsigned* st; };
__device__ __forceinline__ XcdBarrier xcd_barrier_post(unsigned* bar, volatile LAS unsigned* st) {
    XcdBarrier b; b.bar = bar; b.x = xb_xcc_id(); b.st = st;
    if (threadIdx.x == 0) (void)xb_add(&bar[XB_XCNT(b.x)], 1u);
    return b;
}
__device__ __forceinline__ void xcd_barrier_complete(unsigned* bar, unsigned x, unsigned& nloc, unsigned& nx) {
    const unsigned G = gridDim.x * gridDim.y * gridDim.z;
    unsigned sum, cnt, mine, sp = 0u;
    for (;;) {
        sum = 0u; cnt = 0u; mine = 0u;
#pragma unroll 1
        for (unsigned j = 0; j < 16; ++j) { const unsigned c = xb_ld(&bar[XB_XCNT(j)]); sum += c; cnt += (c > 0u) ? 1u : 0u; mine = (j == x) ? c : mine; }
        if (sum == G) break;
        __builtin_amdgcn_s_sleep(1);
        if ((++sp & 255u) == 0u) { if (xb_ld(&bar[XB_TMO])) break; if (sp > XB_SPIN_CAP) { atomicAdd(&bar[XB_TMO], 1u); break; } }
    }
    nloc = mine > 0u ? mine : 1u; nx = cnt > 0u ? cnt : 1u;
}
__device__ __forceinline__ void xcd_barrier(const XcdBarrier& b) {
    asm volatile("s_waitcnt vmcnt(0)" ::: "memory");
    __syncthreads();
    if (threadIdx.x == 0) {
        unsigned* bar = b.bar; asm volatile("" : "+s"(bar));
        __builtin_amdgcn_s_waitcnt(0);
        volatile LAS unsigned* st = b.st; asm volatile("" : "+s"(st));
        unsigned nloc = st[0], nx = st[1];
        if (nloc == 0u) { xcd_barrier_complete(bar, b.x, nloc, nx); st[0] = nloc; st[1] = nx; }
        const unsigned old = xb_add(&bar[XB_XSUB(b.x)], 1u);
        const unsigned gen = old / nloc;
        if (old + 1u == (gen + 1u) * nloc) {
            __builtin_amdgcn_fence(__ATOMIC_RELEASE, "agent");
            asm volatile("s_waitcnt vmcnt(0)" ::: "memory");
            const unsigned og = xb_add(&bar[XB_TOP], 1u);
            const unsigned tg = og / nx;
            if (og + 1u == (tg + 1u) * nx) xb_add(&bar[XB_TOPGEN], 1u);
            else XB_SPIN(xb_ld(&bar[XB_TOPGEN]) == tg, bar);
            __builtin_amdgcn_fence(__ATOMIC_ACQUIRE, "agent");
            xb_add(&bar[XB_XGEN(b.x)], 1u);
            asm volatile("s_waitcnt vmcnt(0)" ::: "memory");
        } else {
            XB_SPIN(xb_ld(&bar[XB_XGEN(b.x)]) == gen, bar);
            __builtin_amdgcn_fence(__ATOMIC_ACQUIRE, "agent");
            asm volatile("s_waitcnt vmcnt(0)" ::: "memory");
        }
    }
    __syncthreads();
}

namespace pg8 {
constexpr int BM = 256, BK = 64, HALF = 128, HTB = HALF * BK * 2, STAGE_BYTES = 8 * HTB, NXCD = 8, WGM = 8;
__host__ __device__ __forceinline__ int lds_byte(int r, int c) { const int st = (r >> 4) * 2 + (c >> 5), rr = r & 15, cc = c & 31, ob = rr * 64 + cc * 2; return st * 1024 + (ob ^ (((ob >> 9) & 1) << 5)); }
__host__ __device__ __forceinline__ void stage_rc(int b, int& R, int& C) { const int st = b / 1024, sb = b % 1024, swz = sb ^ (((sb >> 9) & 1) << 5); R = (st >> 1) * 16 + swz / 64; C = (st & 1) * 32 + (swz % 64) / 2; }
__host__ __device__ __forceinline__ int perm32(int rho) { const int n = rho >> 4, i = rho & 15; return 8 * (i >> 2) + 4 * n + (i & 3); }

struct Unit { unsigned a, b; int r0, pn, half; };

__device__ __forceinline__ bool dense_tile(int i, int G, int c, int nM, int nN, int& pm, int& pn) {
    const int nwg = nM * nN; const long L = (long)i * G + c; if (L >= nwg) return false;
    int wgid = (int)L; { const int q = nwg / NXCD, r = nwg % NXCD, xcd = wgid % NXCD, off = wgid / NXCD; wgid = (xcd < r ? xcd * (q + 1) : r * (q + 1) + (xcd - r) * q) + off; }
    const int nig = WGM * nN, gid = wgid / nig, fm = gid * WGM, gsz = (nM - fm) < WGM ? (nM - fm) : WGM;
    pm = fm + ((wgid % nig) % gsz); pn = (wgid % nig) / gsz; return true;
}

template <class Epi, class Sched, bool GATHER, bool ALIGN_EPI = true>
__device__ __forceinline__ void gemm_phase(unsigned long long* gst, LAS unsigned char* lds, const char* Ab, const char* Bb, const LAS int* rowidx, const int K, const int lda, const int ldb, const Sched& S, const Epi& E) {
    const int tid = opq_tid(), wid = __builtin_amdgcn_readfirstlane(tid >> 6), lane = tid & 63, wr = wid >> 2, wc = wid & 3, fr = lane & 15, fq = lane >> 4;
    const int nt = K / BK;
    int Rr[2], Cc[2];
    unsigned voffA[2][2], voffB[2];
#pragma unroll
    for (int i = 0; i < 2; ++i) { int R, C; stage_rc(tid * 16 + i * 8192, R, C); Rr[i] = R; Cc[i] = C; const int Rb = Epi::PERM ? ((R & ~31) + perm32(R & 31)) : R;
        voffB[i] = (unsigned)(Rb * ldb + C) * 2u;
        voffA[0][i] = (unsigned)(R * lda + C) * 2u; voffA[1][i] = (unsigned)((R + HALF) * lda + C) * 2u; }
    const size_t kstep = (size_t)(BK * 2);
    const size_t hstepB = (size_t)HALF * ldb * 2;
    const unsigned ldsw = (unsigned)wid * 1024u;
    const int aoff = lds_byte(wr * 64 + fr, fq * 8), boff = lds_byte(wc * 32 + fr, fq * 8);
#define PG8_SA(b, h) (((b) * 2 + (h)) * HTB)
#define PG8_SB(b, h) ((4 + (b) * 2 + (h)) * HTB)
#define PG8_STAGE(bufoff, gbase, voff) do { _Pragma("unroll") for (int _i = 0; _i < 2; ++_i) \
        __builtin_amdgcn_global_load_lds((const unsigned*)((const char*)(gbase) + (voff)[_i]), (LAS unsigned*)(lds + (bufoff) + ldsw + _i * 8192), 16, 0, 0); } while (0)
#define PG8_LDA(dst, b, h) do { _Pragma("unroll") for (int m = 0; m < 4; ++m) _Pragma("unroll") for (int k = 0; k < 2; ++k) dst[m][k] = *(const LAS bf16x8*)(lds + PG8_SA(b, h) + aoff + m * 2048 + k * 1024); } while (0)
#define PG8_LDB(dst, b, h) do { _Pragma("unroll") for (int n = 0; n < 2; ++n) _Pragma("unroll") for (int k = 0; k < 2; ++k) dst[n][k] = *(const LAS bf16x8*)(lds + PG8_SB(b, h) + boff + n * 2048 + k * 1024); } while (0)
#define PG8_MMA(ai, bj, At, Bt) do { __builtin_amdgcn_s_setprio(1); _Pragma("unroll") for (int m = 0; m < 4; ++m) _Pragma("unroll") for (int n = 0; n < 2; ++n) _Pragma("unroll") for (int k = 0; k < 2; ++k) \
        acc[ai][bj][m][n] = __builtin_amdgcn_mfma_f32_16x16x32_bf16(Bt[n][k], At[m][k], acc[ai][bj][m][n], 0, 0, 0); __builtin_amdgcn_s_setprio(0); } while (0)
#define PG8_WAIT_V(n) asm volatile("s_waitcnt vmcnt(" #n ")" ::: "memory")
#define PG8_WAIT_L(n) asm volatile("s_waitcnt lgkmcnt(" #n ")" ::: "memory")
#define PG8_BAR __builtin_amdgcn_s_barrier()
#define PG8_SCHED __builtin_amdgcn_sched_barrier(0)
    Unit cur, nxt; int ui = 0;
    if (!S.next(0, cur)) return;
    if constexpr (GATHER) {
#pragma unroll
        for (int h = 0; h < 2; ++h)
#pragma unroll
            for (int i = 0; i < 2; ++i) voffA[h][i] = (unsigned)(rowidx[h * HALF + Rr[i]] * lda + Cc[i]) * 2u;
    }
    f32x4 acc[2][2][4][2];
#pragma unroll
    for (int a = 0; a < 2; ++a)
#pragma unroll
        for (int b = 0; b < 2; ++b)
#pragma unroll
            for (int m = 0; m < 4; ++m)
#pragma unroll
                for (int n = 0; n < 2; ++n) acc[a][b][m][n] = (f32x4){0.f, 0.f, 0.f, 0.f};
    bf16x8 At[4][2], B0[2][2], B1[2][2];
    const char* cA = Ab + cur.a; const char* cB = Bb + cur.b;
    PG8_STAGE(PG8_SB(0, 0), cB, voffB); PG8_STAGE(PG8_SB(0, 1), cB + hstepB, voffB); PG8_STAGE(PG8_SA(0, 0), cA, voffA[0]); PG8_STAGE(PG8_SA(0, 1), cA, voffA[1]);
    if (wr == 1) PG8_BAR;
    PG8_WAIT_V(2); PG8_BAR;
    PG8_STAGE(PG8_SB(1, 0), cB + kstep, voffB); PG8_STAGE(PG8_SA(1, 0), cA + kstep, voffA[0]); PG8_STAGE(PG8_SB(1, 1), cB + hstepB + kstep, voffB);
    PG8_WAIT_V(6); PG8_BAR;
    unsigned long long gt0 = gst ? __builtin_amdgcn_s_memrealtime() : 0ull;
#define GST(k) do { if (gst) { const unsigned long long t1_ = __builtin_amdgcn_s_memrealtime(); gst[k] += t1_ - gt0; gt0 = t1_; } } while (0)
    for (;;) {
        const bool has_next = S.next(ui + 1, nxt);
        GST(1);
        const char* nA = has_next ? Ab + nxt.a : cA; const char* nB = has_next ? Bb + nxt.b : cB;
        unsigned nvoff[2][2];
#pragma unroll
        for (int h = 0; h < 2; ++h)
#pragma unroll
            for (int i = 0; i < 2; ++i) nvoff[h][i] = voffA[h][i];
        if constexpr (GATHER) {
            if (has_next) {
#pragma unroll
                for (int h = 0; h < 2; ++h)
#pragma unroll
                    for (int i = 0; i < 2; ++i) nvoff[h][i] = (unsigned)(rowidx[(ui + 1) * 256 + h * HALF + Rr[i]] * lda + Cc[i]) * 2u;
            }
        }
        for (int t = 0; t < nt; t += 2) {
            const bool last = (t == nt - 2);
            const char* a1 = cA + (size_t)(t + 1) * kstep;
            const char* a2 = last ? nA : cA + (size_t)(t + 2) * kstep; const char* b2 = last ? nB : cB + (size_t)(t + 2) * kstep;
            const char* a3 = a2 + kstep; const char* b3 = b2 + kstep;
            unsigned v2[2][2];
#pragma unroll
            for (int h = 0; h < 2; ++h)
#pragma unroll
                for (int i = 0; i < 2; ++i) v2[h][i] = (GATHER && last) ? nvoff[h][i] : voffA[h][i];
            PG8_LDB(B0, 0, 0); PG8_LDB(B1, 0, 1); PG8_SCHED; PG8_LDA(At, 0, 0); PG8_STAGE(PG8_SA(1, 1), a1, voffA[1]);
            PG8_WAIT_V(8); PG8_WAIT_L(0); PG8_BAR; PG8_MMA(0, 0, At, B0); PG8_MMA(0, 1, At, B1); PG8_BAR; PG8_SCHED;
            PG8_LDA(At, 0, 1); PG8_STAGE(PG8_SB(0, 0), b2, voffB); PG8_STAGE(PG8_SB(0, 1), b2 + hstepB, voffB); PG8_STAGE(PG8_SA(0, 0), a2, v2[0]);
            PG8_WAIT_V(8); PG8_WAIT_L(0); PG8_BAR; if (!cur.half) { PG8_MMA(1, 0, At, B0); PG8_MMA(1, 1, At, B1); } PG8_BAR; PG8_SCHED;
            PG8_LDB(B0, 1, 0); PG8_LDB(B1, 1, 1); PG8_SCHED; PG8_LDA(At, 1, 0); PG8_STAGE(PG8_SA(0, 1), a2, v2[1]);
            PG8_WAIT_V(8); PG8_WAIT_L(0); PG8_BAR; PG8_MMA(0, 0, At, B0); PG8_MMA(0, 1, At, B1); PG8_BAR; PG8_SCHED;
            PG8_LDA(At, 1, 1); PG8_STAGE(PG8_SB(1, 0), b3, voffB); PG8_STAGE(PG8_SB(1, 1), b3 + hstepB, voffB); PG8_STAGE(PG8_SA(1, 0), a3, v2[0]);
            PG8_WAIT_V(8); PG8_WAIT_L(0); PG8_BAR; if (!cur.half) { PG8_MMA(1, 0, At, B0); PG8_MMA(1, 1, At, B1); } PG8_BAR; PG8_SCHED;
        }
        GST(0);
        if constexpr (ALIGN_EPI) { if (wr == 0) PG8_BAR; }
        E(acc, cur.r0, cur.pn, cur.half, wr, wc, fr, fq);
        if (!has_next) break;
#pragma unroll
        for (int a = 0; a < 2; ++a)
#pragma unroll
            for (int b = 0; b < 2; ++b)
#pragma unroll
                for (int m = 0; m < 4; ++m)
#pragma unroll
                    for (int n = 0; n < 2; ++n) acc[a][b][m][n] = (f32x4){0.f, 0.f, 0.f, 0.f};
        cur = nxt; cA = nA; cB = nB; ++ui;
#pragma unroll
        for (int h = 0; h < 2; ++h)
#pragma unroll
            for (int i = 0; i < 2; ++i) voffA[h][i] = nvoff[h][i];
        if constexpr (ALIGN_EPI) { if (wr == 1) PG8_BAR; }
    }
    PG8_WAIT_V(0);
    if constexpr (!ALIGN_EPI) { if (wr == 0) PG8_BAR; }
    PG8_BAR;
#undef PG8_SA
#undef PG8_SB
#undef PG8_STAGE
#undef PG8_LDA
#undef PG8_LDB
#undef PG8_MMA
#undef PG8_WAIT_V
#undef PG8_WAIT_L
#undef PG8_BAR
#undef PG8_SCHED
}
}
#define MK_MULTI 0
#define MK_DBG 0
struct Params {
    const float *x, *rel_bias, *w_in, *mla_q_norm, *mla_w_uq, *mla_kv_norm, *mla_w_ukv, *gmlp_ln_g, *gmlp_ln_b, *gmlp_w_s, *gmlp_b_s,
                *diff_lq1, *diff_lk1, *diff_lq2, *diff_lk2, *diff_subln, *w_o, *ln1_g, *ln1_b, *router_w, *router_bias,
                *exp_w_gate, *exp_w_up, *exp_w_down, *shared_w_gate, *shared_w_up, *shared_w_down, *ln2_g, *ln2_b;
    float* out;
    unsigned char* ws;
    int ph_lo, ph_hi;
    int use_bar;
    int dbg;
    float lam_init0, lam_init1;
};

typedef const __attribute__((address_space(4))) Params* KP_T;
#define OPQ(p) asm volatile("" : "+s"(p))
constexpr size_t al256(size_t x) { return (x + 255) & ~(size_t)255; }
constexpr size_t WS_CTL = 0, CTL_ZERO_BYTES = 65536;
constexpr size_t WS_ROPE = 1u << 20;
constexpr size_t SZ_ROPE = (size_t)SEQ * 32 * 4 * 2;
constexpr size_t WS_WIN = al256(WS_ROPE + SZ_ROPE);
constexpr size_t SZ_WIN = (size_t)HW * DM * 2;
constexpr size_t WS_WUQ = al256(WS_WIN + NLAYER * SZ_WIN);
constexpr int WQSTR = 512 + 64, WKSTR = 256 + 64, VSTR = 8 * 128 + 64;
constexpr size_t SZ_WUQ = (size_t)1536 * WQSTR * 2;
constexpr size_t WS_WUKV = al256(WS_WUQ + NLAYER * SZ_WUQ);
constexpr size_t SZ_WUKV = (size_t)2048 * WKSTR * 2;
constexpr size_t WS_WO = al256(WS_WUKV + NLAYER * SZ_WUKV);
constexpr size_t SZ_WO = (size_t)DM * DM * 2;
constexpr size_t WS_WGU = al256(WS_WO + NLAYER * SZ_WO);
constexpr int WGSTR = DM + 64, WDSTR = 512 + 64, XSTR = DM + 64;
constexpr size_t SZ_WGU1 = (size_t)1024 * WGSTR * 2, SZ_WGU = NEXP1 * SZ_WGU1;
constexpr size_t WS_WD = al256(WS_WGU + NLAYER * SZ_WGU);
constexpr size_t SZ_WD1 = (size_t)DM * WDSTR * 2, SZ_WD = NEXP1 * SZ_WD1;
constexpr size_t WS_XB = al256(WS_WD + NLAYER * SZ_WD);
constexpr size_t WS_XF = al256(WS_XB + (size_t)T * DM * 2);
constexpr size_t WS_HB = al256(WS_XF + (size_t)T * DM * 4);
constexpr size_t WS_RSS = al256(WS_HB + (size_t)T * HW * 2);
constexpr size_t WS_QB = al256(WS_RSS + (size_t)T * 12 * 4);
constexpr size_t WS_KB = al256(WS_QB + (size_t)T * 8 * 192 * 2);
constexpr size_t WS_VB = al256(WS_KB + (size_t)T * 8 * 192 * 2);
constexpr size_t WS_MIX = al256(WS_VB + (size_t)T * VSTR * 2);
constexpr size_t WS_Y1 = al256(WS_MIX + (size_t)T * DM * 2);
constexpr size_t WS_X1F = al256(WS_Y1 + (size_t)T * DM * 4);
constexpr size_t WS_RTR = WS_X1F;
constexpr size_t WS_X1B = al256(WS_X1F + (size_t)T * DM * 4);
constexpr size_t WS_EIDX = al256(WS_X1B + (size_t)T * XSTR * 2);
constexpr size_t WS_EW = al256(WS_EIDX + (size_t)T * 8 * 4);
constexpr size_t WS_ELR = al256(WS_EW + (size_t)T * 8 * 4);
constexpr size_t WS_HIST = al256(WS_ELR + (size_t)T * 8 * 4);
constexpr size_t WS_EOFF = al256(WS_HIST + (size_t)RT_UNITS * 64 * 4);
constexpr size_t WS_SLOT = al256(WS_EOFF + 160 * 4);
constexpr size_t WS_ROWIDX = al256(WS_SLOT + (size_t)T * 8 * 4);
constexpr size_t WS_GATEW = al256(WS_ROWIDX + (size_t)NSLOT * 4);
constexpr size_t WS_HMOE = al256(WS_GATEW + (size_t)NSLOT * 4);
constexpr int HSTR = EDIM + 64;
constexpr size_t WS_YMOE = al256(WS_HMOE + (size_t)NSLOT * HSTR * 2);
constexpr size_t WS_END = al256(WS_YMOE + (size_t)NSLOT * DM);
constexpr int CW_BAR = 4096;
constexpr int CW_QUEUE = 8192;
constexpr int CW_ERR = 9216;

constexpr int LDS_STAGE = 131072;
constexpr int LDS_MISC = LDS_STAGE;
constexpr int LDS_GIDX = LDS_MISC + 4096;
constexpr int LDS_BYTES = LDS_STAGE + 4096 + 16384;

enum { PH_PRO = 0, PH_L0 = 1, PHL_G1 = 0, PHL_G2 = 1, PHL_MIX = 2, PHL_WO = 3, PHL_LNR = 4, PHL_SLOT = 5, PHL_GU = 6, PHL_DN = 7, PHL_CMB = 8, PHL_N = 9, PH_END = 1 + 2 * PHL_N };
using pg8::Unit;
typedef const f32x4 (&AccRef)[2][2][4][2];

__device__ __forceinline__ u32x4 pack8(f32x4 v0, f32x4 v1) { u32x4 w; w.x = cvtpk(v0[0], v0[1]); w.y = cvtpk(v0[2], v0[3]); w.z = cvtpk(v1[0], v1[1]); w.w = cvtpk(v1[2], v1[3]); return w; }
__device__ __forceinline__ u32x2 pack4(f32x4 v) { u32x2 w; w.x = cvtpk(v[0], v[1]); w.y = cvtpk(v[2], v[3]); return w; }

struct Epi1 {
    static constexpr bool PERM = true;
    bf16_t* HB; float* RSS; bf16_t* KB; const float* rc; const float* rs;
    __device__ __forceinline__ void operator()(AccRef acc, const int r0, const int pn, const int half, int wr, int wc, int fr, int fq) const {
        const int row0 = r0 + wr * 64 + fr;
        if (pn == 13) {
            if (wc < 2) {
                const int i0 = 4 * (wc * 4 + fq);
#pragma unroll
                for (int ai = 0; ai < 2; ++ai) {
                    f32x4 cc[4], ss[4];
#pragma unroll
                    for (int m = 0; m < 4; ++m) { const int pos = (row0 + ai * 128 + m * 16) & (SEQ - 1); cc[m] = *(const f32x4*)(rc + pos * 32 + i0); ss[m] = *(const f32x4*)(rs + pos * 32 + i0); }
                    __builtin_amdgcn_sched_barrier(0);
#pragma unroll
                    for (int m = 0; m < 4; ++m) {
                        const int row = row0 + ai * 128 + m * 16;
                        const f32x4 c = cc[m], s = ss[m];
                        const f32x4 x1 = acc[ai][0][m][0], x2 = acc[ai][0][m][1];
                        const u32x2 y1 = pack4(x1 * c - x2 * s), y2 = pack4(x2 * c + x1 * s);
                        bf16_t* kp = KB + (size_t)row * (8 * 192) + 128 + i0;
#pragma unroll
                        for (int h = 0; h < 8; ++h) { *(u32x2*)(kp + h * 192) = y1; *(u32x2*)(kp + h * 192 + 32) = y2; }
                    } }
            }
            return;
        }
        const int mode = (pn <= 2) ? 0 : (pn <= 6) ? 1 : (pn <= 8) ? 2 : 3;
#pragma unroll
        for (int ai = 0; ai < 2; ++ai)
#pragma unroll
            for (int m = 0; m < 4; ++m) {
                const int row = row0 + ai * 128 + m * 16;
                bf16_t* rowp = HB + (size_t)row * HW + pn * 256 + wc * 32 + 8 * fq;
                float ss = 0.f;
#pragma unroll
                for (int bj = 0; bj < 2; ++bj) {
                    f32x4 v0 = acc[ai][bj][m][0], v1 = acc[ai][bj][m][1];
                    if (mode == 0) { ss += (v0[0] * v0[0] + v0[1] * v0[1]) + (v0[2] * v0[2] + v0[3] * v0[3]) + (v1[0] * v1[0] + v1[1] * v1[1]) + (v1[2] * v1[2] + v1[3] * v1[3]); }
                    if (mode == 1) {
#pragma unroll
                        for (int j = 0; j < 4; ++j) { v0[j] = gelu_tanh(v0[j]); v1[j] = gelu_tanh(v1[j]); } }
                    if (mode == 2) { v0 = v0 * (0.125f * LOG2E); v1 = v1 * (0.125f * LOG2E); }
                    *(u32x4*)(rowp + bj * 128) = pack8(v0, v1);
                }
                if (mode == 0) { ss += __shfl_xor(ss, 16); ss += __shfl_xor(ss, 32); if (fq == 0) RSS[(size_t)row * 12 + pn * 4 + wc] = ss; }
            }
    }
};

struct Epi2 {
    static constexpr bool PERM = true;
    int mode; const float* RSS; bf16_t *QB, *KB, *VB; const float* rc; const float* rs;
    __device__ __forceinline__ void operator()(AccRef acc, const int r0, const int pn, const int half, int wr, int wc, int fr, int fq) const {
        const int row0 = r0 + wr * 64 + fr;
#pragma unroll
        for (int ai = 0; ai < 2; ++ai) {
        float sc[2][4];
        if (mode == 0) { f32x4 pa[4], pb[4];
#pragma unroll
            for (int m = 0; m < 4; ++m) { const float* rp = RSS + (size_t)(row0 + ai * 128 + m * 16) * 12; pa[m] = *(const f32x4*)rp; pb[m] = *(const f32x4*)(rp + 4); }
            __builtin_amdgcn_sched_barrier(0);
#pragma unroll
            for (int m = 0; m < 4; ++m) { const f32x4 a = pa[m], b = pb[m]; const float ss = ((a[0] + a[1]) + (a[2] + a[3])) + ((b[0] + b[1]) + (b[2] + b[3]));
                sc[ai][m] = rsqrtf(ss * (1.0f / 512.0f) + 1e-6f) * (0.07216878364870322f * LOG2E); }
        } else { f32x4 pa[4];
#pragma unroll
            for (int m = 0; m < 4; ++m) pa[m] = *(const f32x4*)(RSS + (size_t)(row0 + ai * 128 + m * 16) * 12 + 8);
            __builtin_amdgcn_sched_barrier(0);
#pragma unroll
            for (int m = 0; m < 4; ++m) { const f32x4 a = pa[m]; const float ss = (a[0] + a[1]) + (a[2] + a[3]); sc[ai][m] = rsqrtf(ss * (1.0f / 256.0f) + 1e-6f); }
        }
#pragma unroll
            for (int bj = 0; bj < 2; ++bj) {
                if (mode == 0) {
                    const int col8 = pn * 256 + bj * 128 + wc * 32 + 8 * fq, head = col8 / 192, w = col8 - head * 192;
                    if (w < 128) {
#pragma unroll
                        for (int m = 0; m < 4; ++m) { const int row = row0 + ai * 128 + m * 16;
                            *(u32x4*)(QB + ((size_t)row * 8 + head) * 192 + w) = pack8(acc[ai][bj][m][0] * sc[ai][m], acc[ai][bj][m][1] * sc[ai][m]); }
                    } else { const int i0 = 4 * ((w - 128) >> 3);
                        f32x4 c[4], sn[4];
#pragma unroll
                        for (int m = 0; m < 4; ++m) { const int pos = (row0 + ai * 128 + m * 16) & (SEQ - 1); c[m] = *(const f32x4*)(rc + pos * 32 + i0); sn[m] = *(const f32x4*)(rs + pos * 32 + i0); }
#pragma unroll
                        for (int m = 0; m < 4; ++m) { const int row = row0 + ai * 128 + m * 16; bf16_t* qp = QB + ((size_t)row * 8 + head) * 192;
                            const f32x4 v0 = acc[ai][bj][m][0] * sc[ai][m], v1 = acc[ai][bj][m][1] * sc[ai][m];
                            *(u32x2*)(qp + 128 + i0) = pack4(v0 * c[m] - v1 * sn[m]); *(u32x2*)(qp + 160 + i0) = pack4(v1 * c[m] + v0 * sn[m]); } }
                } else {
#pragma unroll
                    for (int m = 0; m < 4; ++m) { const int row = row0 + ai * 128 + m * 16;
                        const u32x4 o = pack8(acc[ai][bj][m][0] * sc[ai][m], acc[ai][bj][m][1] * sc[ai][m]);
                        if (bj == 0) *(u32x4*)(KB + ((size_t)row * 8 + pn) * 192 + wc * 32 + 8 * fq) = o;
                        else         *(u32x4*)(VB + (size_t)row * VSTR + pn * 128 + wc * 32 + 8 * fq) = o; }
                }
            }
        }
    }
};

struct EpiWO {
    static constexpr bool PERM = true;
    bf16_t* Y1;
    __device__ __forceinline__ void operator()(AccRef acc, const int r0, const int pn, const int half, int wr, int wc, int fr, int fq) const {
        const int row0 = r0 + wr * 64 + fr, col0 = pn * 256 + wc * 32 + 8 * fq;
#pragma unroll
        for (int ai = 0; ai < 2; ++ai)
#pragma unroll
            for (int m = 0; m < 4; ++m) { const size_t o = (size_t)(row0 + ai * 128 + m * 16) * DM + col0;
#pragma unroll
                for (int bj = 0; bj < 2; ++bj) *(u32x4*)(Y1 + o + bj * 128) = pack8(acc[ai][bj][m][0], acc[ai][bj][m][1]); }
    }
};

struct EpiGU {
    static constexpr bool PERM = true;
    bf16_t* HM;
    __device__ __forceinline__ void operator()(AccRef acc, const int r0, const int pn, const int half, int wr, int wc, int fr, int fq) const {
        const int s0 = r0 + wr * 64 + fr;
#pragma unroll
        for (int ai = 0; ai < 2; ++ai) { if (ai == 1 && half) break;
#pragma unroll
            for (int m = 0; m < 4; ++m) {
                const int slot = s0 + ai * 128 + m * 16;
                f32x4 h0, h1;
#pragma unroll
                for (int j = 0; j < 4; ++j) { const float g0 = acc[ai][0][m][0][j], g1 = acc[ai][0][m][1][j];
                    h0[j] = g0 * sigmoidf_(g0) * acc[ai][1][m][0][j]; h1[j] = g1 * sigmoidf_(g1) * acc[ai][1][m][1][j]; }
                *(u32x4*)(HM + (size_t)slot * HSTR + pn * 128 + wc * 32 + 8 * fq) = pack8(h0, h1);
            } }
    }
};

__device__ __forceinline__ u32x2 pack8_fp8(f32x4 v0, f32x4 v1) { u32x2 w;
    int a, b; asm volatile("" : "=v"(a), "=v"(b));
    a = __builtin_amdgcn_cvt_pk_fp8_f32(v0[0], v0[1], a, false); a = __builtin_amdgcn_cvt_pk_fp8_f32(v0[2], v0[3], a, true);
    b = __builtin_amdgcn_cvt_pk_fp8_f32(v1[0], v1[1], b, false); b = __builtin_amdgcn_cvt_pk_fp8_f32(v1[2], v1[3], b, true);
    w.x = (unsigned)a; w.y = (unsigned)b; return w; }
struct EpiDN {
    static constexpr bool PERM = true;
    unsigned char* YM;
    __device__ __forceinline__ void operator()(AccRef acc, const int r0, const int pn, const int half, int wr, int wc, int fr, int fq) const {
        const int s0 = r0 + wr * 64 + fr;
#pragma unroll
        for (int ai = 0; ai < 2; ++ai) { if (ai == 1 && half) break;
#pragma unroll
            for (int m = 0; m < 4; ++m) { unsigned char* yp = YM + (size_t)(s0 + ai * 128 + m * 16) * DM + pn * 256 + wc * 32 + 8 * fq;
#pragma unroll
                for (int bj = 0; bj < 2; ++bj) *(u32x2*)(yp + bj * 128) = pack8_fp8(acc[ai][bj][m][0], acc[ai][bj][m][1]); } }
    }
};

struct SchedDense {
    int lda, K, nM, nN, pn0, Gs, c;
    __device__ __forceinline__ bool next(int i, Unit& u) const {
        if (c < 0 || c >= Gs) return false;
        int pm, pn; if (!pg8::dense_tile(i, Gs, c, nM, nN, pm, pn)) return false;
        pn += pn0;
        u.a = (unsigned)pm * 256u * (unsigned)lda * 2u; u.b = (unsigned)pn * 256u * (unsigned)K * 2u; u.r0 = pm * 256; u.pn = pn; u.half = 0; return true;
    }
};
struct SchedMoE {
    const LAS int* t2e; unsigned wstride; int rowbytes, K, NJ, nunits, G, v;
    __device__ __forceinline__ bool next(int i, Unit& u) const {
        const int L = i * G + ((i & 1) ? G - 1 - v : v); if (L >= nunits) return false;
        const int q = L / NJ, j = L - q * NJ, ent = t2e[MAXTILES + q], mt = ent & 0xffff, e = t2e[mt];
        u.a = (unsigned)mt * 256u * (unsigned)rowbytes; u.b = (unsigned)e * wstride + (unsigned)j * 256u * (unsigned)K * 2u; u.r0 = mt * 256; u.pn = j; u.half = ent >> 16; return true;
    }
};
__device__ __forceinline__ void tr_item(const float* colp, int ldn, const float* gain, bf16_t* dst, int K, int k0, int n0, LAS unsigned char* scr, int lane) {
    const int kq = lane >> 4, nq = lane & 15;
    f32x4 v[32];
#pragma unroll
    for (int i = 0; i < 32; ++i) { const int kk = 64 * (i >> 4) + 8 * ((i & 15) >> 1) + 2 * kq + (i & 1); v[i] = colp ? __builtin_nontemporal_load((const f32x4*)(colp + (size_t)(k0 + kk) * ldn)) : (f32x4){0.f, 0.f, 0.f, 0.f}; }
    if (gain) {
#pragma unroll
        for (int i = 0; i < 32; ++i) { const int kk = 64 * (i >> 4) + 8 * ((i & 15) >> 1) + 2 * kq + (i & 1); v[i] = v[i] * gain[k0 + kk]; } }
#pragma unroll
    for (int hb = 0; hb < 2; ++hb) {
#pragma unroll
        for (int m = 0; m < 8; ++m) { const int kk = 8 * m + 2 * kq;
#pragma unroll
            for (int c = 0; c < 4; ++c) *(LAS unsigned*)(scr + (4 * nq + c) * 128 + 4 * ((kk >> 1) ^ (4 * (nq & 7)))) = cvtpk(v[16 * hb + 2 * m][c], v[16 * hb + 2 * m + 1][c]); }
        LDS_WAIT(); asm volatile("" ::: "memory");
#pragma unroll
        for (int j = 0; j < 8; ++j) { const int n = 8 * j + (lane >> 3), c = lane & 7;
            const u32x4 o = *(const LAS u32x4*)(scr + n * 128 + 16 * (c ^ ((n >> 2) & 7)));
            __builtin_nontemporal_store(o, (u32x4*)(dst + (size_t)(n0 + n) * K + k0 + 64 * hb + 8 * c)); }
        LDS_WAIT(); asm volatile("" ::: "memory");
    }
}
__device__ __forceinline__ int rope_unperm(int p) { const int g = p >> 3, w = p & 7; return 4 * g + (w & 3) + ((w >= 4) ? 32 : 0); }

constexpr int IT_WIN = (DM / 128) * (HW / 64), IT_WUQ = (512 / 128) * (1536 / 64), IT_WUKV = (256 / 128) * (2048 / 64), IT_WO = (DM / 128) * (DM / 64),
              IT_WGU1 = (DM / 128) * (1024 / 64), IT_WD1 = (EDIM / 128) * (DM / 64);
constexpr int IT_LAYER = IT_WIN + IT_WUQ + IT_WUKV + IT_WO + NEXP1 * (IT_WGU1 + IT_WD1);

constexpr int IT_DENSE = IT_WIN + IT_WUQ + IT_WUKV + IT_WO;
constexpr int IT_EXPERT = NEXP1 * (IT_WGU1 + IT_WD1);
constexpr int CV_CHUNK = 128, CV_NCHUNK = IT_EXPERT / CV_CHUNK;
static_assert(IT_LAYER == IT_DENSE + IT_EXPERT && IT_EXPERT % CV_CHUNK == 0 && IT_WGU1 == 256 && IT_WD1 == 128 && (CV_CHUNK == 128 || CV_CHUNK == 64), "conversion chunks");
__device__ __forceinline__ void conv_item(KP_T P, unsigned char* ws, int l, int r, LAS unsigned char* scr, int lane) {
    const int ln = 4 * (lane & 15);
    if (r < IT_WIN) {
        const int nblk = HW / 64, kb = r / nblk, nb = r - kb * nblk, np = nb * 64 + ln;
        int oc; if (np < 768) oc = np; else if (np < HC_KR) oc = np + 64; else if (np < HC_KR + 64) oc = 768 + rope_unperm(np - HC_KR); else oc = -1;
        const float* cp = oc >= 0 ? P->w_in + (size_t)l * DM * IN_W + oc : nullptr;
        tr_item(cp, IN_W, nullptr, (bf16_t*)(ws + WS_WIN + l * SZ_WIN), DM, kb * 128, nb * 64, scr, lane); return; }
    r -= IT_WIN;
    if (r < IT_WUQ) {
        const int nblk = 1536 / 64, kb = r / nblk, nb = r - kb * nblk, np = nb * 64 + ln, head = np / 192, w = np - head * 192;
        const int oc = (w < 128) ? np : head * 192 + 128 + rope_unperm(w - 128);
        tr_item(P->mla_w_uq + (size_t)l * 512 * 1536 + oc, 1536, P->mla_q_norm + l * 512, (bf16_t*)(ws + WS_WUQ + l * SZ_WUQ), WQSTR, kb * 128, nb * 64, scr, lane); return; }
    r -= IT_WUQ;
    if (r < IT_WUKV) {
        const int nblk = 2048 / 64, kb = r / nblk, nb = r - kb * nblk, np = nb * 64 + ln;
        tr_item(P->mla_w_ukv + (size_t)l * 256 * 2048 + np, 2048, P->mla_kv_norm + l * 256, (bf16_t*)(ws + WS_WUKV + l * SZ_WUKV), WKSTR, kb * 128, nb * 64, scr, lane); return; }
    r -= IT_WUKV;
    if (r < IT_WO) {
        const int nblk = DM / 64, kb = r / nblk, nb = r - kb * nblk, np = nb * 64 + ln;
        tr_item(P->w_o + (size_t)l * DM * DM + np, DM, nullptr, (bf16_t*)(ws + WS_WO + l * SZ_WO), DM, kb * 128, nb * 64, scr, lane); return; }
    r -= IT_WO;
    if (r < NEXP1 * IT_WGU1) {
        const int e = r / IT_WGU1, rr = r - e * IT_WGU1, nblk = 1024 / 64, kb = rr / nblk, nb = rr - kb * nblk, np = nb * 64 + ln;
        const int tj = np >> 8, w = np & 255, col = tj * 128 + (w & 127); const bool up = w >= 128;
        const float* src = (e < NEXP) ? (up ? P->exp_w_up : P->exp_w_gate) + ((size_t)l * NEXP + e) * DM * EDIM : (up ? P->shared_w_up : P->shared_w_gate) + (size_t)l * DM * EDIM;
        tr_item(src + col, EDIM, nullptr, (bf16_t*)(ws + WS_WGU + l * SZ_WGU + e * SZ_WGU1), DM, kb * 128, nb * 64, scr, lane); return; }
    r -= NEXP1 * IT_WGU1;
    {
        const int e = r / IT_WD1, rr = r - e * IT_WD1, nblk = DM / 64, kb = rr / nblk, nb = rr - kb * nblk, np = nb * 64 + ln;
        const float* src = (e < NEXP) ? P->exp_w_down + ((size_t)l * NEXP + e) * EDIM * DM : P->shared_w_down + (size_t)l * EDIM * DM;
        tr_item(src + np, DM, nullptr, (bf16_t*)(ws + WS_WD + l * SZ_WD + e * SZ_WD1), EDIM, kb * 128, nb * 64, scr, lane); }
}
#ifndef CV_STORE
#define CV_STORE(v, p) __builtin_nontemporal_store(v, p)
#endif
struct CvDesc { const float* colp; bf16_t* dst; int ldn, K, k0, n0; float sc; };
__device__ __forceinline__ CvDesc conv_desc(KP_T P, unsigned char* ws, int l, int r, int lane) {
    const int ln = 4 * (lane & 15); CvDesc d;
    if (r < NEXP1 * IT_WGU1) {
        const int e = r / IT_WGU1, rr = r - e * IT_WGU1, nb = 8 * (rr >> 7) + (rr & 7), kb = (rr >> 3) & 15, np = nb * 64 + ln;
        const int tj = np >> 8, w = np & 255, col = tj * 128 + (w & 127); const bool up = w >= 128;
        const float* src = (e < NEXP) ? (up ? P->exp_w_up : P->exp_w_gate) + ((size_t)l * NEXP + e) * DM * EDIM : (up ? P->shared_w_up : P->shared_w_gate) + (size_t)l * DM * EDIM;
        d.colp = src + col; d.dst = (bf16_t*)(ws + WS_WGU + l * SZ_WGU + e * SZ_WGU1); d.ldn = EDIM; d.K = WGSTR; d.k0 = kb * 128; d.n0 = nb * 64; d.sc = 1.0f;
    } else { r -= NEXP1 * IT_WGU1;
        const int e = r / IT_WD1, rr = r - e * IT_WD1, nb = (rr & 7) + 8 * (rr >> 5), kb = (rr >> 3) & 3, np = nb * 64 + ln;
        const float* src = (e < NEXP) ? P->exp_w_down + ((size_t)l * NEXP + e) * EDIM * DM : P->shared_w_down + (size_t)l * EDIM * DM;
        d.colp = src + np; d.dst = (bf16_t*)(ws + WS_WD + l * SZ_WD + e * SZ_WD1); d.ldn = DM; d.K = WDSTR; d.k0 = kb * 128; d.n0 = nb * 64; d.sc = 8.0f; }
    return d;
}
__device__ __forceinline__ void tr_load16(const CvDesc& d, int hb, f32x4 (&v)[16], int lane) {
    const int kq = lane >> 4;
#pragma unroll
    for (int i = 0; i < 16; ++i) { const int kk = 64 * hb + 8 * (i >> 1) + 2 * kq + (i & 1); v[i] = __builtin_nontemporal_load((const f32x4*)(d.colp + (size_t)(d.k0 + kk) * d.ldn)); }
}
__device__ __forceinline__ void tr_store16(const CvDesc& d, int hb, const f32x4 (&v)[16], LAS unsigned char* scr, int lane) {
    const int kq = lane >> 4, nq = lane & 15, sw = 4 * (nq & 7);
#pragma unroll
    for (int m = 0; m < 8; ++m) {
#pragma unroll
        for (int c = 0; c < 4; ++c) *(LAS unsigned*)(scr + (4 * nq + c) * 128 + 4 * ((4 * m + kq) ^ sw)) = cvtpk(v[2 * m][c] * d.sc, v[2 * m + 1][c] * d.sc); }
    LDS_WAIT(); asm volatile("" ::: "memory");
#pragma unroll
    for (int j = 0; j < 8; ++j) { const int n = 8 * j + (lane >> 3), c = lane & 7;
        const u32x4 o = *(const LAS u32x4*)(scr + n * 128 + 16 * (c ^ ((n >> 2) & 7)));
        CV_STORE(o, (u32x4*)(d.dst + (size_t)(d.n0 + n) * d.K + d.k0 + 64 * hb + 8 * c)); }
    LDS_WAIT(); asm volatile("" ::: "memory");
}
__device__ __forceinline__ void convert_chunk(KP_T P, LAS unsigned char* lds, int l, int chunk) {
    const int tid = opq_tid(), lane = tid & 63, wave = __builtin_amdgcn_readfirstlane(tid >> 6);
    LAS unsigned char* scr = lds + wave * 16384; unsigned char* ws = P->ws;
    const int r0 = chunk * CV_CHUNK + wave;
    CvDesc d = conv_desc(P, ws, l, r0, lane);
    f32x4 va[16], vb[16];
    tr_load16(d, 0, va, lane);
#pragma unroll 1
    for (int i = 0; i < CV_CHUNK / NWAVES; ++i) {
        tr_load16(d, 1, vb, lane);
        tr_store16(d, 0, va, scr, lane);
        const bool more = i + 1 < CV_CHUNK / NWAVES;
        const CvDesc dn = more ? conv_desc(P, ws, l, r0 + NWAVES * (i + 1), lane) : d;
        if (more) tr_load16(dn, 0, va, lane);
        tr_store16(d, 1, vb, scr, lane);
        d = dn;
    }
}

__device__ __forceinline__ void prologue_phase(KP_T P, LAS unsigned char* lds, int vcu, int G) {
    const int tid = opq_tid(), lane = tid & 63, wave = __builtin_amdgcn_readfirstlane(tid >> 6);
    LAS unsigned char* scr = lds + wave * 16384;
    const int gw = vcu * NWAVES + wave, NGW = G * NWAVES;
    unsigned char* ws = P->ws;
    for (int it = gw; it < NLAYER * IT_DENSE; it += NGW) { const int l = it / IT_DENSE; conv_item(P, ws, l, it - l * IT_DENSE, scr, lane); }
    { u32x4* WH = (u32x4*)(ws + WS_RTR); u32x4* WL = WH + NLAYER * 16384;
      for (int idx = gw * 64 + lane; idx < NLAYER * 16384; idx += NGW * 64) { const int l = idx >> 14, rem = idx & 16383, ks = rem >> 8, n = (rem >> 6) & 3, ln = rem & 63, e = 4 * (ln & 15) + n;
          const float* p = P->router_w + ((size_t)l * DM + 32 * ks + 8 * (ln >> 4)) * NEXP + e;
          f32x4 a, b;
#pragma unroll
          for (int t = 0; t < 4; ++t) { a[t] = p[(size_t)t * NEXP]; b[t] = p[(size_t)(t + 4) * NEXP]; }
          const u32x4 hi = pack8(a, b);
          const f32x4 ra = a - (f32x4){bflo(hi.x), bfhi(hi.x), bflo(hi.y), bfhi(hi.y)}, rb = b - (f32x4){bflo(hi.z), bfhi(hi.z), bflo(hi.w), bfhi(hi.w)};
          WH[idx] = hi; WL[idx] = pack8(ra, rb); } }
    { bf16_t* XB = (bf16_t*)(ws + WS_XB);
      for (int ch = gw; ch < T * DM / 512; ch += 4 * NGW) { f32x4 a[4], b[4];
#pragma unroll
          for (int q = 0; q < 4; ++q) { const int c = ch + q * NGW; const size_t o = (size_t)(c < T * DM / 512 ? c : ch) * 512 + lane * 8; a[q] = *(const f32x4*)(P->x + o); b[q] = *(const f32x4*)(P->x + o + 4); }
#pragma unroll
          for (int q = 0; q < 4; ++q) { const int c = ch + q * NGW; if (c < T * DM / 512) *(u32x4*)(XB + (size_t)c * 512 + lane * 8) = pack8(a[q], b[q]); } } }
    { float* rc = (float*)(ws + WS_ROPE); float* rs = rc + SEQ * 32;
      for (int i = gw * 64 + lane; i < SEQ * 32; i += NGW * 64) { const int pos = i >> 5, f = i & 31;
          const float inv = exp2f(-(float)f * (1.0f / 32.0f) * 13.287712379549449f);
          const float ang = (float)pos * inv;
          const double q = (double)ang * 0.15915494309189535; const double fr = q - __builtin_rint(q);
          const float rad = (float)(fr * 6.283185307179586);
          rc[i] = __cosf(rad); rs[i] = __sinf(rad); } }
}
#define CVSEL8 13

typedef short v4i16_t __attribute__((ext_vector_type(4)));
__device__ __forceinline__ s16x4 vtr(const LAS char* p) { return __builtin_bit_cast(s16x4, __builtin_amdgcn_ds_read_tr16_b64_v4i16((LAS v4i16_t*)p)); }
#define FRAG8(lo, hi) ((bf16x8){(lo)[0], (lo)[1], (lo)[2], (lo)[3], (hi)[0], (hi)[1], (hi)[2], (hi)[3]})
constexpr int VROW = 320;
constexpr int KROW_M = 400;
constexpr int KROW_D = 272;
constexpr int ATT_TAB = 98304;
static_assert(4 * 66 * 64 * 4 <= ATT_TAB && ATT_TAB + 512 <= LDS_STAGE, "attention LDS map");

__device__ __forceinline__ float half_max(float x) { auto rr = __builtin_amdgcn_permlane32_swap(__float_as_uint(x), __float_as_uint(x), false, false); return fmaxf(__uint_as_float(rr[0]), __uint_as_float(rr[1])); }
__device__ __forceinline__ float half_sum(float x) { auto rr = __builtin_amdgcn_permlane32_swap(__float_as_uint(x), __float_as_uint(x), false, false); return __uint_as_float(rr[0]) + __uint_as_float(rr[1]); }
template <int NT>
__device__ __forceinline__ void smax_update(f32x16 (&S)[NT], float& m, float& l, f32x16 (&O)[4], bf16x8 (&pf)[NT][2]) {
    float mx = fmaxf(S[0][0], S[0][1]);
#pragma unroll
    for (int t = 0; t < NT; ++t)
#pragma unroll
        for (int r = (t == 0 ? 2 : 0); r < 16; r += 2) mx = fmaxf(mx, fmaxf(S[t][r], S[t][r + 1]));
    mx = half_max(mx);
    if (__any(mx > m + 8.0f)) {
        const float mn = fmaxf(m, mx), alpha = __builtin_amdgcn_exp2f(m - mn);
        m = mn; l *= alpha;
#pragma unroll
        for (int d = 0; d < 4; ++d) O[d] = O[d] * alpha;
    }
    float sum = 0.f;
#pragma unroll
    for (int t = 0; t < NT; ++t)
#pragma unroll
        for (int r = 0; r < 16; ++r) { const float p = __builtin_amdgcn_exp2f(S[t][r] - m); S[t][r] = p; sum += p; }
    l += sum;
#pragma unroll
    for (int t = 0; t < NT; ++t)
#pragma unroll
        for (int s = 0; s < 2; ++s) { u32x4 w; w.x = cvtpk(S[t][8 * s + 0], S[t][8 * s + 1]); w.y = cvtpk(S[t][8 * s + 2], S[t][8 * s + 3]); w.z = cvtpk(S[t][8 * s + 4], S[t][8 * s + 5]); w.w = cvtpk(S[t][8 * s + 6], S[t][8 * s + 7]);
            pf[t][s] = __builtin_bit_cast(bf16x8, w); }
}
__device__ __forceinline__ void pv_tile(f32x16 (&O)[4], const LAS char* vp, const bf16x8 (&pf)[2]) {
    s16x4 lo[4][2], hi[4][2];
#pragma unroll
    for (int dt = 0; dt < 4; ++dt)
#pragma unroll
        for (int s = 0; s < 2; ++s) { lo[dt][s] = vtr(vp + (16 * s) * VROW + dt * 64); hi[dt][s] = vtr(vp + (16 * s + 8) * VROW + dt * 64); }
    __builtin_amdgcn_sched_barrier(0);
#pragma unroll
    for (int dt = 0; dt < 4; ++dt)
#pragma unroll
        for (int s = 0; s < 2; ++s) O[dt] = __builtin_amdgcn_mfma_f32_32x32x16_bf16(FRAG8(lo[dt][s], hi[dt][s]), pf[s], O[dt], 0, 0, 0);
}

constexpr int MLA_KT = 64 * 384, MLA_SLOT = MLA_KT + 64 * 256;
constexpr int DIF_KT = 64 * 256, DIF_SLOT = DIF_KT + 64 * 256;
static_assert(3 * MLA_SLOT <= LDS_STAGE && 3 * DIF_SLOT <= ATT_TAB, "attention ring");
#define ATT_DMA(gp, ldsp) __builtin_amdgcn_global_load_lds((const unsigned*)(gp), (LAS unsigned*)(ldsp), 16, 0, 0)
__device__ __forceinline__ void pv_tile_sw(f32x16 (&O)[4], const LAS char* slotv, const int (&vb)[4], const bf16x8 (&pf)[2]) {
    s16x4 lo[4][2], hi[4][2];
    const unsigned sv = (unsigned)(__UINTPTR_TYPE__)slotv;
#pragma unroll
    for (int dt = 0; dt < 4; ++dt) { const unsigned a = sv + (unsigned)vb[dt];
        asm volatile("ds_read_b64_tr_b16 %0, %4\n\tds_read_b64_tr_b16 %1, %4 offset:2048\n\tds_read_b64_tr_b16 %2, %4 offset:4096\n\tds_read_b64_tr_b16 %3, %4 offset:6144"
                     : "=&v"(lo[dt][0]), "=&v"(hi[dt][0]), "=&v"(lo[dt][1]), "=&v"(hi[dt][1]) : "v"(a) : "memory"); }
    asm volatile("s_waitcnt lgkmcnt(0)" ::: "memory");
    __builtin_amdgcn_sched_barrier(0);
#pragma unroll
    for (int dt = 0; dt < 4; ++dt)
#pragma unroll
        for (int s = 0; s < 2; ++s) O[dt] = __builtin_amdgcn_mfma_f32_32x32x16_bf16(FRAG8(lo[dt][s], hi[dt][s]), pf[s], O[dt], 0, 0, 0);
}

__device__ __forceinline__ void mla_unit(KP_T P, LAS unsigned char* lds, int b, int h, int qb) {
    const int tid = opq_tid(), lane = tid & 63, wid = __builtin_amdgcn_readfirstlane(tid >> 6), rg = wid & 3, kg = wid >> 2, ql = lane & 31, hh = lane >> 5;
    const bf16_t* QB = (const bf16_t*)(P->ws + WS_QB); const bf16_t* KB = (const bf16_t*)(P->ws + WS_KB); const bf16_t* VB = (const bf16_t*)(P->ws + WS_VB); bf16_t* MIX = (bf16_t*)(P->ws + WS_MIX);
    const int q0 = qb * 128, nsteps = 2 * (qb + 1), rowmin = q0 + 32 * rg, row = rowmin + ql;
    int gk[3], gv[2];
#pragma unroll
    for (int t = 0; t < 3; ++t) { const int p16 = (3 * wid + t) * 64 + lane, r = p16 / 24, ph = p16 - r * 24, lg = (ph & ~7) | ((ph ^ (r >> 1)) & 7); gk[t] = r * (8 * 192 * 2) + lg * 16; }
#pragma unroll
    for (int t = 0; t < 2; ++t) { const int p16 = (2 * wid + t) * 64 + lane, r = p16 >> 4, ph = p16 & 15, lg = ph ^ ((r & 3) << 2); gv[t] = r * (VSTR * 2) + lg * 16; }
    const char* kg0 = (const char*)(KB + ((size_t)b * SEQ * 8 + h) * 192); const char* vg0 = (const char*)(VB + (size_t)b * SEQ * VSTR + h * 128);
#define MLA_DMA(j, slot) do { const char* kt_ = kg0 + (size_t)(j) * 64 * (8 * 192 * 2); const char* vt_ = vg0 + (size_t)(j) * 64 * (VSTR * 2); LAS unsigned char* sb_ = lds + (slot) * MLA_SLOT; \
        _Pragma("unroll") for (int t = 0; t < 3; ++t) ATT_DMA(kt_ + gk[t], sb_ + (3 * wid + t) * 1024); \
        _Pragma("unroll") for (int t = 0; t < 2; ++t) ATT_DMA(vt_ + gv[t], sb_ + MLA_KT + (2 * wid + t) * 1024); } while (0)
    bf16x8 qf[12];
    { const bf16_t* qp = QB + (((size_t)b * SEQ + row) * 8 + h) * 192 + 8 * hh;
#pragma unroll
      for (int ks = 0; ks < 12; ++ks) qf[ks] = *(const bf16x8*)(qp + 16 * ks); }
    MLA_DMA(0, 0); MLA_DMA(1, 1);
#pragma unroll
    for (int ks = 0; ks < 12; ++ks) asm volatile("" : "+v"(qf[ks]));
    f32x16 O[4];
#pragma unroll
    for (int d = 0; d < 4; ++d)
#pragma unroll
        for (int r = 0; r < 16; ++r) O[d][r] = 0.f;
    float m = -1e30f, l = 0.f;
    const int rk = 32 * kg + ql; int ko[4];
#pragma unroll
    for (int c = 0; c < 4; ++c) ko[c] = rk * 384 + 16 * ((2 * c + hh) ^ ((rk >> 1) & 7));
    const int q4 = (lane & 15) >> 2; int vb[4];
#pragma unroll
    for (int dt = 0; dt < 4; ++dt) vb[dt] = MLA_KT + (32 * kg + 4 * hh + q4) * 256 + 64 * (dt ^ q4) + 32 * ((lane >> 4) & 1) + 8 * (lane & 3);
    int slot = 0;
    for (int j = 0; j < nsteps; ++j) {
        if (j + 1 < nsteps) asm volatile("s_waitcnt vmcnt(5)" ::: "memory"); else asm volatile("s_waitcnt vmcnt(0)" ::: "memory");
        __builtin_amdgcn_s_barrier(); asm volatile("" ::: "memory");
        if (j + 2 < nsteps) { const int s2 = slot >= 1 ? slot - 1 : 2; MLA_DMA(j + 2, s2); }
        const int kbase = 64 * j + 32 * kg;
        if (kbase <= rowmin + 31) {
            const LAS unsigned char* buf = lds + slot * MLA_SLOT;
            f32x16 S[1];
#pragma unroll
            for (int r = 0; r < 16; ++r) S[0][r] = 0.f;
            { bf16x8 kf[12];
#pragma unroll
              for (int ks = 0; ks < 12; ++ks) kf[ks] = *(const LAS bf16x8*)(buf + ko[ks & 3] + 128 * (ks >> 2));
              __builtin_amdgcn_sched_barrier(0);
#pragma unroll
              for (int ks = 0; ks < 12; ++ks) S[0] = __builtin_amdgcn_mfma_f32_32x32x16_bf16(kf[ks], qf[ks], S[0], 0, 0, 0); }
            if (kbase + 31 > rowmin) {
#pragma unroll
                for (int r = 0; r < 16; ++r) { const int key = kbase + (r & 3) + 8 * (r >> 2) + 4 * hh; if (key > row) S[0][r] = -INFINITY; }
            }
            bf16x8 pf[1][2];
            smax_update<1>(S, m, l, O, pf);
            pv_tile_sw(O, (const LAS char*)buf, vb, pf[0]);
        }
        slot = slot == 2 ? 0 : slot + 1;
    }
    __syncthreads();
    LAS float* xb = (LAS float*)lds + rg * (66 * 64) + lane;
    if (kg == 1) {
#pragma unroll
        for (int d = 0; d < 4; ++d)
#pragma unroll
            for (int r = 0; r < 16; ++r) xb[(d * 16 + r) * 64] = O[d][r];
        xb[64 * 64] = m; xb[65 * 64] = l;
    }
    __syncthreads();
    if (kg == 0) {
        const float m1 = xb[64 * 64], l1 = xb[65 * 64];
        const float mt = fmaxf(m, m1), a0 = __builtin_amdgcn_exp2f(m - mt), a1 = __builtin_amdgcn_exp2f(m1 - mt);
        float lt = l * a0 + l1 * a1; lt = half_sum(lt);
        const float inv = 1.0f / lt;
        bf16_t* op = MIX + ((size_t)b * SEQ + row) * DM + h * 128 + 4 * hh;
#pragma unroll
        for (int d = 0; d < 4; ++d)
#pragma unroll
            for (int g4 = 0; g4 < 4; ++g4) { f32x4 v;
#pragma unroll
                for (int j = 0; j < 4; ++j) { const int r = 4 * g4 + j; v[j] = (O[d][r] * a0 + xb[(d * 16 + r) * 64] * a1) * inv; }
                *(u32x2*)(op + 32 * d + 8 * g4) = pack4(v); }
    }
    __syncthreads();
#undef MLA_DMA
}

__device__ __forceinline__ void diff_unit(KP_T P, LAS unsigned char* lds, int lyr, int b, int h, int qb, float lam_init) {
    const int tid = opq_tid(), lane = tid & 63, wid = __builtin_amdgcn_readfirstlane(tid >> 6), rg = wid & 3, mp = wid >> 2, ql = lane & 31, hh = lane >> 5;
    const bf16_t* HB = (const bf16_t*)(P->ws + WS_HB); bf16_t* MIX = (bf16_t*)(P->ws + WS_MIX);
    const int q0 = qb * 128, nsteps = 2 * (qb + 1), rowmin = q0 + 32 * rg, row = rowmin + ql;
    LAS float* tab = (LAS float*)(lds + ATT_TAB);
    if (tid < 128) { const int n = tid; int bk;
        if (n < 16) bk = n; else { bk = 16 + (int)(logf((float)n * (1.0f / 16.0f)) / 2.0794415416798357f * 16.0f); bk = bk > 31 ? 31 : bk; }
        tab[n] = P->rel_bias[bk * 4 + h] * LOG2E; }
    if (tid >= 128 && tid < 160) *(LAS f32x4*)(lds + ATT_TAB + 512 + 16 * (tid - 128)) = *(const f32x4*)(P->diff_subln + lyr * 128 + 4 * (tid - 128));
    float lam;
    { const float a = P->diff_lq1[lyr * 64 + lane] * P->diff_lk1[lyr * 64 + lane], c = P->diff_lq2[lyr * 64 + lane] * P->diff_lk2[lyr * 64 + lane];
      lam = expf(wave_sum(a)) - expf(wave_sum(c)) + lam_init; }
    int gk[2], gv[2];
#pragma unroll
    for (int t = 0; t < 2; ++t) { const int p16 = (2 * wid + t) * 64 + lane, r = p16 >> 4, ph = p16 & 15;
        gk[t] = r * (HW * 2) + HC_DK * 2 + (ph ^ (r & 15)) * 16; gv[t] = r * (HW * 2) + HC_DV * 2 + (ph ^ ((r & 3) << 2)) * 16; }
    const char* hg0 = (const char*)(HB + (size_t)b * SEQ * HW + h * 128);
#define DIF_DMA(j, slot) do { const char* t_ = hg0 + (size_t)(j) * 64 * (HW * 2); LAS unsigned char* sb_ = lds + (slot) * DIF_SLOT; \
        _Pragma("unroll") for (int t = 0; t < 2; ++t) ATT_DMA(t_ + gk[t], sb_ + (2 * wid + t) * 1024); \
        _Pragma("unroll") for (int t = 0; t < 2; ++t) ATT_DMA(t_ + gv[t], sb_ + DIF_KT + (2 * wid + t) * 1024); } while (0)
    bf16x8 qf[4];
    { const bf16_t* qp = HB + ((size_t)b * SEQ + row) * HW + HC_DQ + h * 128 + mp * 64 + 8 * hh;
#pragma unroll
      for (int ks = 0; ks < 4; ++ks) qf[ks] = *(const bf16x8*)(qp + 16 * ks); }
    DIF_DMA(0, 0); DIF_DMA(1, 1);
#pragma unroll
    for (int ks = 0; ks < 4; ++ks) asm volatile("" : "+v"(qf[ks]));
    asm volatile("" : "+v"(lam));
    f32x16 O[4];
#pragma unroll
    for (int d = 0; d < 4; ++d)
#pragma unroll
        for (int r = 0; r < 16; ++r) O[d][r] = 0.f;
    float m = -1e30f, l = 0.f;
    int ko[4];
#pragma unroll
    for (int c = 0; c < 4; ++c) ko[c] = ql * 256 + 16 * ((8 * mp + 2 * c + hh) ^ (ql & 15));
    const int q4 = (lane & 15) >> 2; int vb[4];
#pragma unroll
    for (int dt = 0; dt < 4; ++dt) vb[dt] = DIF_KT + (4 * hh + q4) * 256 + 64 * (dt ^ q4) + 32 * ((lane >> 4) & 1) + 8 * (lane & 3);
    float c31 = 0.f; int slot = 0;
    for (int j = 0; j < nsteps; ++j) {
        if (j + 1 < nsteps) asm volatile("s_waitcnt vmcnt(4)" ::: "memory"); else asm volatile("s_waitcnt vmcnt(0)" ::: "memory");
        asm volatile("s_waitcnt lgkmcnt(0)" ::: "memory"); __builtin_amdgcn_s_barrier(); asm volatile("" ::: "memory");
        if (j == 0) c31 = tab[127];
        if (j + 2 < nsteps) { const int s2 = slot >= 1 ? slot - 1 : 2; DIF_DMA(j + 2, s2); }
        const int kbase = 64 * j;
        if (kbase <= rowmin + 31) {
            const LAS unsigned char* buf = lds + slot * DIF_SLOT;
            f32x16 S[2];
            { bf16x8 kf[2][4];
#pragma unroll
              for (int t = 0; t < 2; ++t)
#pragma unroll
                  for (int ks = 0; ks < 4; ++ks) kf[t][ks] = *(const LAS bf16x8*)(buf + ko[ks] + t * 32 * 256);
              __builtin_amdgcn_sched_barrier(0);
#pragma unroll
              for (int t = 0; t < 2; ++t) {
#pragma unroll
                  for (int r = 0; r < 16; ++r) S[t][r] = 0.f;
#pragma unroll
                  for (int ks = 0; ks < 4; ++ks) S[t] = __builtin_amdgcn_mfma_f32_32x32x16_bf16(kf[t][ks], qf[ks], S[t], 0, 0, 0); } }
            if (rowmin - (kbase + 63) >= 127) {
#pragma unroll
                for (int t = 0; t < 2; ++t)
#pragma unroll
                    for (int r = 0; r < 16; ++r) S[t][r] += c31;
            } else {
#pragma unroll
                for (int t = 0; t < 2; ++t)
#pragma unroll
                    for (int r = 0; r < 16; ++r) { const int key = kbase + 32 * t + (r & 3) + 8 * (r >> 2) + 4 * hh; int n = row - key; const bool ok = n >= 0; n = n < 0 ? 0 : (n > 127 ? 127 : n);
                        S[t][r] = ok ? S[t][r] + tab[n] : -INFINITY; }
            }
            bf16x8 pf[2][2];
            smax_update<2>(S, m, l, O, pf);
            pv_tile_sw(O, (const LAS char*)buf, vb, pf[0]);
            pv_tile_sw(O, (const LAS char*)buf + 32 * 256, vb, pf[1]);
        }
        slot = slot == 2 ? 0 : slot + 1;
    }
    __syncthreads();
    { float lt = half_sum(l); const float inv = 1.0f / lt;
#pragma unroll
      for (int d = 0; d < 4; ++d) O[d] = O[d] * inv; }
    LAS float* xb = (LAS float*)lds + rg * (64 * 64) + lane;
    if (mp == 1) {
#pragma unroll
        for (int d = 0; d < 4; ++d)
#pragma unroll
            for (int r = 0; r < 16; ++r) xb[(d * 16 + r) * 64] = O[d][r];
    }
    __syncthreads();
    if (mp == 0) {
        float ss = 0.f;
#pragma unroll
        for (int d = 0; d < 4; ++d)
#pragma unroll
            for (int r = 0; r < 16; ++r) { const float o = O[d][r] - lam * xb[(d * 16 + r) * 64]; O[d][r] = o; ss += o * o; }
        ss = half_sum(ss);
        const float rs = rsqrtf(ss * (1.0f / 128.0f) + 1e-6f) * (1.0f - lam_init);
        bf16_t* op = MIX + ((size_t)b * SEQ + row) * DM + 1536 + h * 128 + 4 * hh;
        const LAS unsigned char* gp = lds + ATT_TAB + 512 + 16 * hh;
#pragma unroll
        for (int d = 0; d < 4; ++d)
#pragma unroll
            for (int g4 = 0; g4 < 4; ++g4) { const f32x4 g = *(const LAS f32x4*)(gp + 4 * (32 * d + 8 * g4)); f32x4 v;
#pragma unroll
                for (int j = 0; j < 4; ++j) v[j] = O[d][4 * g4 + j] * rs * g[j];
                *(u32x2*)(op + 32 * d + 8 * g4) = pack4(v); }
    }
    __syncthreads();
#undef DIF_DMA
}

constexpr int GM_W = 0, GM_V = 128 * KROW_D, GM_ST = GM_V + 128 * VROW;
__device__ __forceinline__ void gmlp_unit(KP_T P, LAS unsigned char* lds, int lyr, int b, int c) {
    const int tid = opq_tid(), lane = tid & 63, wid = __builtin_amdgcn_readfirstlane(tid >> 6), ql = lane & 31, hh = lane >> 5;
    const bf16_t* HB = (const bf16_t*)(P->ws + WS_HB); bf16_t* MIX = (bf16_t*)(P->ws + WS_MIX);
    const size_t R0 = (size_t)b * SEQ + c * 128;
    LAS f32x2* stats = (LAS f32x2*)(lds + GM_ST);
    { const int r = 16 * wid + (lane >> 2), q = lane & 3; const bf16_t* vp = HB + (R0 + r) * HW + HC_GV + 128 * q;
      u32x4 w[16];
#pragma unroll
      for (int i = 0; i < 16; ++i) w[i] = *(const u32x4*)(vp + 8 * i);
      float s = 0.f;
#pragma unroll
      for (int i = 0; i < 16; ++i) s += ((bflo(w[i].x) + bfhi(w[i].x)) + (bflo(w[i].y) + bfhi(w[i].y))) + ((bflo(w[i].z) + bfhi(w[i].z)) + (bflo(w[i].w) + bfhi(w[i].w)));
      s += __shfl_xor(s, 1); s += __shfl_xor(s, 2);
      const float mean = s * (1.0f / 512.0f); float qv = 0.f;
#pragma unroll
      for (int i = 0; i < 16; ++i) { const float d0 = bflo(w[i].x) - mean, d1 = bfhi(w[i].x) - mean, d2 = bflo(w[i].y) - mean, d3 = bfhi(w[i].y) - mean, d4 = bflo(w[i].z) - mean, d5 = bfhi(w[i].z) - mean, d6 = bflo(w[i].w) - mean, d7 = bfhi(w[i].w) - mean;
          qv += ((d0 * d0 + d1 * d1) + (d2 * d2 + d3 * d3)) + ((d4 * d4 + d5 * d5) + (d6 * d6 + d7 * d7)); }
      qv += __shfl_xor(qv, 1); qv += __shfl_xor(qv, 2);
      if (q == 0) stats[r] = (f32x2){mean, rsqrtf(qv * (1.0f / 512.0f) + 1e-5f)}; }
    const int tt = wid & 3, dp = wid >> 2;
    const int woff = GM_W + (32 * tt + ql) * KROW_D + 16 * hh;
    const int voff = GM_V + (8 * hh + ((lane & 15) >> 2)) * VROW + (16 * ((lane >> 4) & 1) + 4 * (lane & 3)) * 2;
    f32x4 wa[4], wb[4]; u32x4 vv[4];
#define GM_FETCH(g) do { _Pragma("unroll") for (int i = 0; i < 4; ++i) { const int cid = tid + 512 * i, t = cid >> 4, s0 = (cid & 15) * 8; \
        const float* wp = P->gmlp_w_s + (((size_t)lyr * 4 + (g)) * 128 + t) * 128 + s0; wa[i] = *(const f32x4*)wp; wb[i] = *(const f32x4*)(wp + 4); \
        vv[i] = *(const u32x4*)(HB + (R0 + t) * HW + HC_GV + (g) * 128 + s0); } } while (0)
    GM_FETCH(0);
    __syncthreads();
    for (int g = 0; g < 4; ++g) {
#pragma unroll
        for (int i = 0; i < 4; ++i) { const int cid = tid + 512 * i, t = cid >> 4, s0 = (cid & 15) * 8;
            f32x4 a2, b2;
#pragma unroll
            for (int j = 0; j < 4; ++j) { a2[j] = (s0 + j <= t) ? wa[i][j] : 0.f; b2[j] = (s0 + 4 + j <= t) ? wb[i][j] : 0.f; }
            *(LAS u32x4*)(lds + GM_W + t * KROW_D + s0 * 2) = pack8(a2, b2);
            const f32x2 ms = stats[t]; const u32x4 w = vv[i];
            const float* gp = P->gmlp_ln_g + lyr * 512 + g * 128 + s0; const float* bp = P->gmlp_ln_b + lyr * 512 + g * 128 + s0;
            const f32x4 g0 = *(const f32x4*)gp, g1 = *(const f32x4*)(gp + 4), b0 = *(const f32x4*)bp, b1 = *(const f32x4*)(bp + 4);
            f32x4 v0 = {bflo(w.x), bfhi(w.x), bflo(w.y), bfhi(w.y)}, v1 = {bflo(w.z), bfhi(w.z), bflo(w.w), bfhi(w.w)};
            v0 = (v0 - ms.x) * ms.y * g0 + b0; v1 = (v1 - ms.x) * ms.y * g1 + b1;
            *(LAS u32x4*)(lds + GM_V + t * VROW + s0 * 2) = pack8(v0, v1); }
        const int t = 32 * tt + ql; const float bs = P->gmlp_b_s[((size_t)lyr * 4 + g) * 128 + t];
        const bf16_t* up = HB + (R0 + t) * HW + HC_GU + g * 128 + 4 * hh; u32x2 uw[2][4];
#pragma unroll
        for (int dd = 0; dd < 2; ++dd)
#pragma unroll
            for (int g4 = 0; g4 < 4; ++g4) uw[dd][g4] = *(const u32x2*)(up + 32 * (2 * dp + dd) + 8 * g4);
        if (g < 3) GM_FETCH(g + 1);
        __syncthreads();
        f32x16 acc[2];
#pragma unroll
        for (int dd = 0; dd < 2; ++dd)
#pragma unroll
            for (int r = 0; r < 16; ++r) acc[dd][r] = 0.f;
#pragma unroll
        for (int kp = 0; kp < 4; ++kp) {
            if (kp <= tt) {
                bf16x8 bw[2]; s16x4 lo[2][2], hi[2][2];
#pragma unroll
                for (int q = 0; q < 2; ++q) { const int ks = 2 * kp + q; bw[q] = *(const LAS bf16x8*)(lds + woff + 32 * ks);
#pragma unroll
                    for (int dd = 0; dd < 2; ++dd) { const int dt = 2 * dp + dd; lo[q][dd] = vtr((const LAS char*)(lds + voff + (16 * ks) * VROW + dt * 64)); hi[q][dd] = vtr((const LAS char*)(lds + voff + (16 * ks + 4) * VROW + dt * 64)); } }
#pragma unroll
                for (int q = 0; q < 2; ++q)
#pragma unroll
                    for (int dd = 0; dd < 2; ++dd) acc[dd] = __builtin_amdgcn_mfma_f32_32x32x16_bf16(FRAG8(lo[q][dd], hi[q][dd]), bw[q], acc[dd], 0, 0, 0);
            }
        }
        { bf16_t* op = MIX + (R0 + t) * DM + 1024 + g * 128 + 4 * hh;
#pragma unroll
          for (int dd = 0; dd < 2; ++dd)
#pragma unroll
              for (int g4 = 0; g4 < 4; ++g4) { const int d0 = 32 * (2 * dp + dd) + 8 * g4; const u32x2 u2 = uw[dd][g4];
                  f32x4 v; v[0] = bflo(u2.x) * (acc[dd][4 * g4 + 0] + bs); v[1] = bfhi(u2.x) * (acc[dd][4 * g4 + 1] + bs); v[2] = bflo(u2.y) * (acc[dd][4 * g4 + 2] + bs); v[3] = bfhi(u2.y) * (acc[dd][4 * g4 + 3] + bs);
                  *(u32x2*)(op + d0) = pack4(v); } }
        __syncthreads();
    }
#undef GM_FETCH
}

__device__ __forceinline__ int queue_pop(unsigned* q, volatile LAS unsigned* slot) {
    if (opq_tid() == 0) *slot = __hip_atomic_fetch_add(q, 1u, __ATOMIC_RELAXED, __HIP_MEMORY_SCOPE_AGENT);
    __syncthreads();
    const int v = (int)*slot;
    __syncthreads();
    return v;
}
__device__ __forceinline__ void mixer_phase(KP_T P, LAS unsigned char* lds, int lyr, unsigned long long& st_dur) {
    unsigned* ctl = (unsigned*)(P->ws + WS_CTL);
    volatile LAS unsigned* slot = (volatile LAS unsigned*)(lds + LDS_MISC + 8);
    const float lam_init = lyr == 0 ? P->lam_init0 : P->lam_init1;
#ifndef MK_MX
#define MK_MX 7
#endif
#ifdef MK_STAMP
    unsigned long long t0_ = __builtin_amdgcn_s_memrealtime();
#define SUBST(id) do { const unsigned long long t1_ = __builtin_amdgcn_s_memrealtime(); if (MK_STAMP == (id)) st_dur += t1_ - t0_; t0_ = t1_; } while (0)
#define AGG(id) do { const unsigned long long t1_ = __builtin_amdgcn_s_memrealtime(); if (MK_STAMP == (id) && threadIdx.x == 0) __hip_atomic_fetch_add(ctl + CW_ERR + 16, (unsigned)(t1_ - t0_), __ATOMIC_RELAXED, __HIP_MEMORY_SCOPE_AGENT); t0_ = t1_; } while (0)
#else
#define SUBST(id) do {} while (0)
#define AGG(id) do {} while (0)
#endif
    unsigned* cvq = ctl + CW_QUEUE + 384 + 64 * lyr;
    if ((int)(4 * ((blockIdx.x >> 3) & 7) + ((blockIdx.x >> 6) & 3)) < CVSEL8) for (;;) { const int i = queue_pop(cvq, slot); if (i >= CV_NCHUNK) break; convert_chunk(P, lds, lyr, i); }
    AGG(34);
    for (;;) { const int i = queue_pop(ctl + CW_QUEUE + 192 * lyr, slot); if (i >= 64 + 256 + 512) break;
        if (i < 64) gmlp_unit(P, lds, lyr, i >> 5, i & 31);
        else if (i < 320) { const int k = i - 64; diff_unit(P, lds, lyr, (k & 7) >> 2, k & 3, 31 - (k >> 3), lam_init); }
        else { const int k = i - 320; mla_unit(P, lds, (k & 15) >> 3, k & 7, 31 - (k >> 4)); } }
    AGG(37);
    for (;;) { const int i = queue_pop(cvq, slot); if (i >= CV_NCHUNK) break; convert_chunk(P, lds, lyr, i); }
    AGG(34);
}
__device__ __forceinline__ void lnr_phase(KP_T P, LAS unsigned char* lds, int lyr, int vcu, int G, unsigned long long& st_dur) {
#ifdef MK_STAMP
    unsigned long long t0_ = __builtin_amdgcn_s_memrealtime();
#define LSUB(id) do { const unsigned long long t1_ = __builtin_amdgcn_s_memrealtime(); if (MK_STAMP == (id)) st_dur += t1_ - t0_; t0_ = t1_; } while (0)
#else
#define LSUB(id) do {} while (0)
#endif
    const int tid = opq_tid(), lane = tid & 63, wid = __builtin_amdgcn_readfirstlane(tid >> 6);
    const bf16_t* Y1 = (const bf16_t*)(P->ws + WS_Y1); const bf16_t* XBr = (const bf16_t*)(P->ws + WS_XB); bf16_t* X1B = (bf16_t*)(P->ws + WS_X1B);
    int* EIDX = (int*)(P->ws + WS_EIDX); float* EW = (float*)(P->ws + WS_EW); int* ELR = (int*)(P->ws + WS_ELR); int* HIST = (int*)(P->ws + WS_HIST);
    LAS float* xs = (LAS float*)lds;
    volatile LAS unsigned long long* selm = (volatile LAS unsigned long long*)(lds + LDS_MISC + 256);
    const float* g1 = P->ln1_g + lyr * DM; const float* b1 = P->ln1_b + lyr * DM;
    const float* rw = P->router_w + (size_t)lyr * DM * NEXP;
    const float rbias = P->router_bias[lyr * NEXP + lane];
    { *(LAS f32x4*)(lds + LDS_GIDX + 16 * tid) = *(const f32x4*)(g1 + 4 * tid); *(LAS f32x4*)(lds + LDS_GIDX + 8192 + 16 * tid) = *(const f32x4*)(b1 + 4 * tid); }
    __syncthreads();
    for (int u = vcu; u < RT_UNITS; u += G) {
        const int tok0 = u * RT_TOK;
        LSUB(44);
        const unsigned char* sbh = P->ws + WS_RTR + ((size_t)(lyr * 64 + 8 * wid) * 4) * 1024; asm volatile("" : "+s"(sbh));
        const unsigned char* sbl = sbh + (size_t)NLAYER * 16384 * 16; const unsigned lo16 = (unsigned)lane * 16u;
#define RT_LDH(q_) (*(const u32x4*)(sbh + (q_) * 1024 + lo16))
#define RT_LDL(q_) (*(const u32x4*)(sbl + (q_) * 1024 + lo16))
        u32x4 qh[8], ql[8];
#pragma unroll
        for (int q = 0; q < 8; ++q) { qh[q] = RT_LDH(q); ql[q] = RT_LDL(q); }
        u32x4 yin[2][4], xin[2][4];
#pragma unroll
        for (int rr = 0; rr < 2; ++rr)
#pragma unroll
            for (int j = 0; j < 4; ++j) { const size_t row = (size_t)(tok0 + 2 * wid + rr); yin[rr][j] = *(const u32x4*)(Y1 + row * DM + 8 * lane + 512 * j); xin[rr][j] = *(const u32x4*)(XBr + row * DM + 8 * lane + 512 * j); }
        __builtin_amdgcn_sched_barrier(0);
#pragma unroll
        for (int rr = 0; rr < 2; ++rr) { const int mrow = 2 * wid + rr; const size_t row = (size_t)(tok0 + mrow);
            f32x4 v[4][2]; float s = 0.f;
#pragma unroll
            for (int j = 0; j < 4; ++j) { const u32x4 w = yin[rr][j], xw = xin[rr][j];
                v[j][0] = (f32x4){bflo(w.x), bfhi(w.x), bflo(w.y), bfhi(w.y)} + (f32x4){bflo(xw.x), bfhi(xw.x), bflo(xw.y), bfhi(xw.y)} * DN_ALPHA;
                v[j][1] = (f32x4){bflo(w.z), bfhi(w.z), bflo(w.w), bfhi(w.w)} + (f32x4){bflo(xw.z), bfhi(xw.z), bflo(xw.w), bfhi(xw.w)} * DN_ALPHA;
                s += ((v[j][0][0] + v[j][0][1]) + (v[j][0][2] + v[j][0][3])) + ((v[j][1][0] + v[j][1][1]) + (v[j][1][2] + v[j][1][3])); }
            const float mean = wave_sum(s) * (1.0f / DM); float q = 0.f;
#pragma unroll
            for (int j = 0; j < 4; ++j)
#pragma unroll
                for (int h = 0; h < 2; ++h) { v[j][h] = v[j][h] - mean; q += (v[j][h][0] * v[j][h][0] + v[j][h][1] * v[j][h][1]) + (v[j][h][2] * v[j][h][2] + v[j][h][3] * v[j][h][3]); }
            const float rstd = rsqrtf(wave_sum(q) * (1.0f / DM) + 1e-5f);
#pragma unroll
            for (int j = 0; j < 4; ++j) { const int col = 8 * lane + 512 * j;
                const LAS unsigned char* gb = lds + LDS_GIDX + 4 * col;
                const f32x4 o0 = v[j][0] * rstd * *(const LAS f32x4*)gb + *(const LAS f32x4*)(gb + 8192), o1 = v[j][1] * rstd * *(const LAS f32x4*)(gb + 16) + *(const LAS f32x4*)(gb + 8192 + 16);
                const u32x4 hi = pack8(o0, o1);
                *(u32x4*)(X1B + row * XSTR + col) = hi;
                const f32x4 r0 = o0 - (f32x4){bflo(hi.x), bfhi(hi.x), bflo(hi.y), bfhi(hi.y)}, r1 = o1 - (f32x4){bflo(hi.z), bfhi(hi.z), bflo(hi.w), bfhi(hi.w)};
                const int ch = (col >> 3) ^ (mrow & 7);
                *(LAS u32x4*)(lds + mrow * 4096 + 16 * ch) = hi; *(LAS u32x4*)(lds + 65536 + mrow * 4096 + 16 * ch) = pack8(r0, r1); } }
        __syncthreads();
        LSUB(41);
        f32x4 acc[4];
#pragma unroll
        for (int n = 0; n < 4; ++n) acc[n] = (f32x4){0.f, 0.f, 0.f, 0.f};
        { const int i = lane & 15, g = lane >> 4, sw = i & 7;
          const LAS unsigned char* ah = lds + i * 4096; const LAS unsigned char* al = ah + 65536;
#pragma unroll
          for (int s = 0; s < 8; ++s) {
              const bf16x8 Ah = *(const LAS bf16x8*)(ah + 16 * ((4 * (8 * wid + s) + g) ^ sw)), Al = *(const LAS bf16x8*)(al + 16 * ((4 * (8 * wid + s) + g) ^ sw));
              bf16x8 Bh[4], Bl[4];
#pragma unroll
              for (int n = 0; n < 4; ++n) { const int q = (s & 1) * 4 + n; Bh[n] = __builtin_bit_cast(bf16x8, qh[q]); Bl[n] = __builtin_bit_cast(bf16x8, ql[q]);
                  if (s < 6) { qh[q] = RT_LDH((s + 2) * 4 + n); ql[q] = RT_LDL((s + 2) * 4 + n); } }
#pragma unroll
              for (int n = 0; n < 4; ++n) acc[n] = __builtin_amdgcn_mfma_f32_16x16x32_bf16(Ah, Bh[n], acc[n], 0, 0, 0);
#pragma unroll
              for (int n = 0; n < 4; ++n) acc[n] = __builtin_amdgcn_mfma_f32_16x16x32_bf16(Ah, Bl[n], acc[n], 0, 0, 0);
#pragma unroll
              for (int n = 0; n < 4; ++n) acc[n] = __builtin_amdgcn_mfma_f32_16x16x32_bf16(Al, Bh[n], acc[n], 0, 0, 0);
              __builtin_amdgcn_sched_barrier(0); } }
#undef RT_LDH
#undef RT_LDL
        __syncthreads();
        LSUB(42);
        { LAS float* part = xs + wid * (16 * 64);
#pragma unroll
          for (int n = 0; n < 4; ++n)
#pragma unroll
              for (int r = 0; r < 4; ++r) part[(4 * (lane >> 4) + r) * 64 + 4 * (lane & 15) + n] = acc[n][r]; }
        __syncthreads();
#pragma unroll
        for (int rr = 0; rr < 2; ++rr) { const int tk = 2 * wid + rr; float logit = 0.f;
#pragma unroll
            for (int w = 0; w < 8; ++w) logit += xs[w * (16 * 64) + tk * 64 + lane];
            const float score = 1.0f / (1.0f + expf(-logit));
            const float biased = score + rbias;
            float t1 = -INFINITY, t2 = -INFINITY;
#pragma unroll
            for (int j = 0; j < 8; ++j) { const float o = __shfl(biased, (lane & ~7) + j); const float lo = fminf(t1, o); t1 = fmaxf(t1, o); t2 = fmaxf(t2, lo); }
            const float gs = t1 + t2; int grank = 0;
#pragma unroll
            for (int gp = 0; gp < 8; ++gp) { const float o = __int_as_float(__builtin_amdgcn_readlane(__float_as_int(gs), 8 * gp)); grank += (o > gs || (o == gs && gp < (lane >> 3))) ? 1 : 0; }
            const float v = (grank < 4) ? biased : -INFINITY;
            int rank = 0;
#pragma unroll
            for (int e = 0; e < 64; ++e) { const float o = __int_as_float(__builtin_amdgcn_readlane(__float_as_int(v), e)); rank += (o > v || (o == v && e < lane)) ? 1 : 0; }
            const bool chosen = rank < TOPK;
            const unsigned long long sm = __ballot(chosen);
            const float ssum = wave_sum(chosen ? score : 0.f);
            const int kpos = __builtin_popcountll(sm & ((1ull << lane) - 1ull));
            if (chosen) { EIDX[(size_t)(tok0 + tk) * 8 + kpos] = lane; EW[(size_t)(tok0 + tk) * 8 + kpos] = score / ssum * 2.5f; }
            if (lane == 0) selm[tk] = sm; }
        __syncthreads();
        { int bit[RT_TOK];
#pragma unroll
          for (int t2 = 0; t2 < RT_TOK; ++t2) bit[t2] = (int)((((const LAS unsigned long long*)(lds + LDS_MISC + 256))[t2] >> lane) & 1ull);
#pragma unroll
          for (int rr = 0; rr < 2; ++rr) { const int tk = 2 * wid + rr; const unsigned long long sm = ((const LAS unsigned long long*)(lds + LDS_MISC + 256))[tk];
              int lr = 0;
#pragma unroll
              for (int t2 = 0; t2 < RT_TOK; ++t2) lr += (t2 < tk) ? bit[t2] : 0;
              if ((sm >> lane) & 1ull) ELR[(size_t)(tok0 + tk) * 8 + __builtin_popcountll(sm & ((1ull << lane) - 1ull))] = lr; }
          if (wid == 0) { int hc = 0;
#pragma unroll
              for (int t2 = 0; t2 < RT_TOK; ++t2) hc += bit[t2];
              HIST[(size_t)u * 64 + lane] = hc; } }
        __syncthreads();
        LSUB(43);
    }
}

__device__ __forceinline__ int moe_tables_build(LAS unsigned char* lds) {
    LAS int* eo = (LAS int*)(lds + LDS_MISC + 384);
    LAS int* t2e = (LAS int*)(lds + LDS_MISC + 1024);
    const int tid = opq_tid();
    const int ntiles = eo[66];
    for (int mt = tid; mt < ntiles; mt += NTHREADS) { int e = 0; for (int k = 1; k <= NEXP; ++k) e = (mt * 256 >= eo[k]) ? k : e; t2e[mt] = e; }
    __syncthreads();
    { const int lane = tid & 63, w = tid >> 6; const bool act = tid < ntiles; int valid = 0;
      if (act) { const int e = t2e[tid]; valid = (e == NEXP ? T : eo[80 + e]) - (tid * 256 - eo[e]); }
      const bool heavy = act && valid > 128, light = act && valid <= 128;
      const unsigned long long hb = __ballot(heavy), lb = __ballot(light);
      LAS int* wc = (LAS int*)(lds + LDS_MISC + 64);
      if (lane == 0) { wc[w] = __builtin_popcountll(hb); wc[8 + w] = __builtin_popcountll(lb); }
      __syncthreads();
      int ph = 0, pl = 0, nh = 0;
#pragma unroll
      for (int k = 0; k < 8; ++k) { const int ch = wc[k], cl = wc[8 + k]; nh += ch; if (k < w) { ph += ch; pl += cl; } }
      const unsigned long long lt = (1ull << lane) - 1ull;
      if (heavy) t2e[MAXTILES + ph + __builtin_popcountll(hb & lt)] = tid;
      if (light) t2e[MAXTILES + nh + pl + __builtin_popcountll(lb & lt)] = tid | (1 << 16); }
    __syncthreads();
    return ntiles;
}

__device__ __forceinline__ int moe_tables(KP_T P, LAS unsigned char* lds) {
    const int* EOFF = (const int*)(P->ws + WS_EOFF);
    LAS int* eo = (LAS int*)(lds + LDS_MISC + 384);
    LAS int* t2e = (LAS int*)(lds + LDS_MISC + 1024);
    const int tid = opq_tid();
    if (tid < 67) eo[tid] = EOFF[tid];
    if (tid >= 128 && tid < 192) eo[80 + tid - 128] = EOFF[80 + tid - 128];
    __syncthreads();
    return moe_tables_build(lds);
}

__device__ __forceinline__ void slot_phase(KP_T P, LAS unsigned char* lds, int vcu, int G) {
    const int tid = opq_tid(), lane = tid & 63, wid = __builtin_amdgcn_readfirstlane(tid >> 6);
    const int* HIST = (const int*)(P->ws + WS_HIST); const int* EIDX = (const int*)(P->ws + WS_EIDX); const float* EW = (const float*)(P->ws + WS_EW); const int* ELR = (const int*)(P->ws + WS_ELR);
    int* EOFF = (int*)(P->ws + WS_EOFF); int* SLOT = (int*)(P->ws + WS_SLOT); int* ROWIDX = (int*)(P->ws + WS_ROWIDX); float* GATEW = (float*)(P->ws + WS_GATEW);
    LAS int* tmp = (LAS int*)lds;
    LAS int* tot = tmp + 512;
    LAS int* off = tot + 64;
    LAS int* base = off + 72;
    LAS int* pre = base + 64;
    const int ua = vcu, ub = vcu + G;
    { int s = 0, sa = 0, sb = 0;
#pragma unroll 16
      for (int u = wid; u < RT_UNITS; u += 8) { const int hv = HIST[(size_t)u * 64 + lane]; s += hv; sa += (u < ua) ? hv : 0; sb += (u < ub) ? hv : 0; }
      tmp[wid * 64 + lane] = s; pre[wid * 64 + lane] = sa; pre[512 + wid * 64 + lane] = sb; }
    __syncthreads();
    if (tid < 64) { int s = 0;
#pragma unroll
        for (int w = 0; w < 8; ++w) s += tmp[w * 64 + tid]; tot[tid] = s; }
    __syncthreads();
    if (tid == 0) { int o = 0; for (int e = 0; e < NEXP; ++e) { off[e] = o; o += (tot[e] + 255) & ~255; } off[64] = o; off[65] = o + T; }
    __syncthreads();
    if (vcu == 0 && tid < 67) EOFF[tid] = tid < 66 ? off[tid] : off[65] / 256;
    if (vcu == 0 && tid >= 128 && tid < 192) EOFF[80 + tid - 128] = tot[tid - 128];
    for (int u = vcu, ui = 0; u < RT_UNITS; u += G, ++ui) {
        const LAS int* pp = ui < 2 ? pre + ui * 512 : tmp;
        if (ui >= 2) {
            int s = 0;
#pragma unroll 16
            for (int u2 = wid; u2 < RT_UNITS; u2 += 8) { const int hv = HIST[(size_t)u2 * 64 + lane]; s += (u2 < u) ? hv : 0; }
            tmp[wid * 64 + lane] = s;
            __syncthreads(); }
        if (tid < 64) { int s = off[tid];
#pragma unroll
            for (int w = 0; w < 8; ++w) s += pp[w * 64 + tid]; base[tid] = s; }
        __syncthreads();
        if (tid < RT_TOK * 8) { const size_t i = (size_t)u * (RT_TOK * 8) + tid; const int e = EIDX[i], slot = base[e] + ELR[i];
            SLOT[i] = slot; ROWIDX[slot] = (int)(i >> 3); }
        __syncthreads();
    }
    for (int e = vcu; e < NEXP; e += G) for (int s = off[e] + tot[e] + tid; s < off[e + 1]; s += NTHREADS) ROWIDX[s] = 0;
    for (int t = vcu * NTHREADS + tid; t < T; t += G * NTHREADS) ROWIDX[off[64] + t] = t;
    { LAS int* eo = (LAS int*)(lds + LDS_MISC + 384);
      if (tid < 67) eo[tid] = tid < 66 ? off[tid] : off[65] / 256;
      if (tid >= 128 && tid < 192) eo[80 + tid - 128] = tot[tid - 128];
      __syncthreads();
      (void)moe_tables_build(lds); }
}


__device__ __forceinline__ void combine_phase(KP_T P, LAS unsigned char* lds, int lyr, int vcu, int G) {
    const int tid = opq_tid(), lane = tid & 63, wid = __builtin_amdgcn_readfirstlane(tid >> 6);
    const bf16_t* X1B = (const bf16_t*)(P->ws + WS_X1B); const unsigned char* YM = (const unsigned char*)(P->ws + WS_YMOE); const int* SLOT = (const int*)(P->ws + WS_SLOT); const int* EOFF = (const int*)(P->ws + WS_EOFF);
    bf16_t* XB = (bf16_t*)(P->ws + WS_XB);
    const float* g2 = P->ln2_g + lyr * DM; const float* b2 = P->ln2_b + lyr * DM; const float* EW = (const float*)(P->ws + WS_EW);
    const int shoff = EOFF[64];
    { *(LAS f32x4*)(lds + 16 * tid) = *(const f32x4*)(g2 + 4 * tid); *(LAS f32x4*)(lds + 8192 + 16 * tid) = *(const f32x4*)(b2 + 4 * tid); }
    __syncthreads();
    int nslot[8]; float ngw[8];
    { const int t0 = vcu * NWAVES + wid;
#pragma unroll
      for (int k = 0; k < 8; ++k) { nslot[k] = SLOT[(size_t)t0 * 8 + k]; ngw[k] = EW[(size_t)t0 * 8 + k]; } }
    for (int tok = vcu * NWAVES + wid; tok < T; tok += G * NWAVES) {
        int slot[9]; float gw[9];
#pragma unroll
        for (int k = 0; k < 8; ++k) { slot[k] = nslot[k]; gw[k] = ngw[k] * 0.125f; }
        slot[8] = shoff + tok; gw[8] = 0.125f;
        u32x4 yw[9][2];
#pragma unroll
        for (int k = 0; k < 9; ++k)
#pragma unroll
            for (int j = 0; j < 2; ++j) yw[k][j] = *(const u32x4*)(YM + (size_t)slot[k] * DM + 16 * lane + 1024 * j);
        { const int tn = tok + G * NWAVES < T ? tok + G * NWAVES : tok;
#pragma unroll
          for (int k = 0; k < 8; ++k) { nslot[k] = SLOT[(size_t)tn * 8 + k]; ngw[k] = EW[(size_t)tn * 8 + k]; } }
        f32x4 v[2][4];
#pragma unroll
        for (int j = 0; j < 2; ++j) { const bf16_t* xp = X1B + (size_t)tok * XSTR + 16 * lane + 1024 * j; const u32x4 w0 = *(const u32x4*)xp, w1 = *(const u32x4*)(xp + 8);
            v[j][0] = (f32x4){bflo(w0.x), bfhi(w0.x), bflo(w0.y), bfhi(w0.y)} * DN_ALPHA; v[j][1] = (f32x4){bflo(w0.z), bfhi(w0.z), bflo(w0.w), bfhi(w0.w)} * DN_ALPHA;
            v[j][2] = (f32x4){bflo(w1.x), bfhi(w1.x), bflo(w1.y), bfhi(w1.y)} * DN_ALPHA; v[j][3] = (f32x4){bflo(w1.z), bfhi(w1.z), bflo(w1.w), bfhi(w1.w)} * DN_ALPHA; }
#pragma unroll
        for (int k = 0; k < 9; ++k)
#pragma unroll
            for (int j = 0; j < 2; ++j) { const u32x4 w = yw[k][j]; const float g = gw[k];
                v[j][0] += (f32x4){__builtin_amdgcn_cvt_f32_fp8((int)w.x, 0), __builtin_amdgcn_cvt_f32_fp8((int)w.x, 1), __builtin_amdgcn_cvt_f32_fp8((int)w.x, 2), __builtin_amdgcn_cvt_f32_fp8((int)w.x, 3)} * g;
                v[j][1] += (f32x4){__builtin_amdgcn_cvt_f32_fp8((int)w.y, 0), __builtin_amdgcn_cvt_f32_fp8((int)w.y, 1), __builtin_amdgcn_cvt_f32_fp8((int)w.y, 2), __builtin_amdgcn_cvt_f32_fp8((int)w.y, 3)} * g;
                v[j][2] += (f32x4){__builtin_amdgcn_cvt_f32_fp8((int)w.z, 0), __builtin_amdgcn_cvt_f32_fp8((int)w.z, 1), __builtin_amdgcn_cvt_f32_fp8((int)w.z, 2), __builtin_amdgcn_cvt_f32_fp8((int)w.z, 3)} * g;
                v[j][3] += (f32x4){__builtin_amdgcn_cvt_f32_fp8((int)w.w, 0), __builtin_amdgcn_cvt_f32_fp8((int)w.w, 1), __builtin_amdgcn_cvt_f32_fp8((int)w.w, 2), __builtin_amdgcn_cvt_f32_fp8((int)w.w, 3)} * g; }
        float s = 0.f;
#pragma unroll
        for (int j = 0; j < 2; ++j)
#pragma unroll
            for (int q = 0; q < 4; ++q) s += (v[j][q][0] + v[j][q][1]) + (v[j][q][2] + v[j][q][3]);
        const float mean = wave_sum(s) * (1.0f / DM); float qq = 0.f;
#pragma unroll
        for (int j = 0; j < 2; ++j)
#pragma unroll
            for (int q = 0; q < 4; ++q) { v[j][q] = v[j][q] - mean; qq += (v[j][q][0] * v[j][q][0] + v[j][q][1] * v[j][q][1]) + (v[j][q][2] * v[j][q][2] + v[j][q][3] * v[j][q][3]); }
        const float rstd = rsqrtf(wave_sum(qq) * (1.0f / DM) + 1e-5f);
#pragma unroll
        for (int j = 0; j < 2; ++j) { const int col = 16 * lane + 1024 * j; f32x4 o[4];
#pragma unroll
            for (int q = 0; q < 4; ++q) o[q] = v[j][q] * rstd * *(const LAS f32x4*)(lds + 4 * (col + 4 * q)) + *(const LAS f32x4*)(lds + 8192 + 4 * (col + 4 * q));
            if (lyr == NLAYER - 1) {
#pragma unroll
                for (int q = 0; q < 4; ++q) *(f32x4*)(P->out + (size_t)tok * DM + col + 4 * q) = o[q]; }
            else { *(u32x4*)(XB + (size_t)tok * DM + col) = pack8(o[0], o[1]); *(u32x4*)(XB + (size_t)tok * DM + col + 8) = pack8(o[2], o[3]); } }
    }
}
#ifndef MK_EN
#define MK_EN 0x3ff
#endif
#define EN(k) ((MK_EN >> (k)) & 1)
__global__ void __launch_bounds__(NTHREADS, 2) fwd(Params Parg) {
    extern __shared__ __attribute__((aligned(16))) unsigned char lds_raw[];
    LAS unsigned char* lds0 = (LAS unsigned char*)lds_raw;
    KP_T KP = (KP_T)__builtin_amdgcn_kernarg_segment_ptr();
    const int tid = threadIdx.x, G0 = gridDim.x, bx0 = blockIdx.x;
    const int vcu0 = (G0 % 8 == 0) ? (bx0 % 8) * (G0 / 8) + bx0 / 8 : bx0;
    for (int i = tid; i < (LDS_BYTES - LDS_MISC) / 4; i += NTHREADS) ((LAS unsigned*)(lds0 + LDS_MISC))[i] = 0u;
    __syncthreads();
    const int ph_lo = KP->ph_lo, ph_hi = KP->ph_hi, use_bar = KP->use_bar;
    XcdBarrier bar; bar.bar = (unsigned*)(KP->ws + WS_CTL) + CW_BAR; bar.x = 0; bar.st = (volatile LAS unsigned*)(lds0 + LDS_MISC);
    if (use_bar) bar = xcd_barrier_post(bar.bar, (volatile LAS unsigned*)(lds0 + LDS_MISC));
#define IN(k) (ph_lo <= (k) && (k) < ph_hi)
#define PHASE_BEGIN() KP_T P = KP; int G = G0, bx = bx0, vcu = vcu0, l = l0; unsigned lo_ = 0u; asm volatile("" : "+s"(P), "+s"(G), "+s"(bx), "+s"(vcu), "+s"(lo_), "+s"(l)); LAS unsigned char* lds = lds0 + lo_; (void)G; (void)bx; (void)vcu; (void)lds; (void)l
#define SEAM(k) do { if (IN(k) && IN((k) + 1) && use_bar) xcd_barrier(bar); } while (0)
#ifdef MK_STAMP
    unsigned long long st_dur = 0ull, st_t0 = 0ull;
    unsigned long long st_c0 = 0ull, st_dc = 0ull, st_dr = 0ull;
#define ST_BEGIN(ty) do { if ((ty) == MK_STAMP) st_t0 = __builtin_amdgcn_s_memrealtime(); if (MK_STAMP == 77 && (ty) == 7) { st_t0 = __builtin_amdgcn_s_memrealtime(); st_c0 = __builtin_amdgcn_s_memtime(); } } while (0)
#define ST_END(ty) do { if ((ty) == MK_STAMP) st_dur += __builtin_amdgcn_s_memrealtime() - st_t0; if (MK_STAMP == 77 && (ty) == 7) { st_dr += __builtin_amdgcn_s_memrealtime() - st_t0; st_dc += __builtin_amdgcn_s_memtime() - st_c0; } } while (0)
#else
    unsigned long long st_dur = 0ull;
#define ST_BEGIN(ty) do {} while (0)
#define ST_END(ty) do {} while (0)
#endif

    unsigned long long gstv[2] = {0ull, 0ull}; unsigned long long* gstp = nullptr;
#ifdef MK_STAMP
    if (MK_STAMP == 61 || MK_STAMP == 62) gstp = gstv;
#endif
    ST_BEGIN(0);
    { const int l0 = 0; if (EN(0) && IN(PH_PRO)) { PHASE_BEGIN(); prologue_phase(P, lds, vcu, G); } }
    SEAM(PH_PRO);
    ST_END(0);
    for (int l0 = 0; l0 < NLAYER; ++l0) {
        const int pb = PH_L0 + PHL_N * l0;
        ST_BEGIN(1);
        if (EN(1) && IN(pb + PHL_G1)) {
            PHASE_BEGIN(); unsigned char* ws = P->ws;
            SchedDense S{DM, DM, T / 256, 8, 0, G, bx};
            Epi1 E{(bf16_t*)(ws + WS_HB), (float*)(ws + WS_RSS), (bf16_t*)(ws + WS_KB), (const float*)(ws + WS_ROPE), (const float*)(ws + WS_ROPE) + SEQ * 32};
            pg8::gemm_phase<Epi1, SchedDense, false>(nullptr, lds, (const char*)(ws + WS_XB), (const char*)(ws + WS_WIN + l * SZ_WIN), nullptr, DM, DM, DM, S, E);
        }
        SEAM(pb + PHL_G1);
        ST_END(1);
        ST_BEGIN(2);
        if (EN(2) && IN(pb + PHL_G2)) {
            PHASE_BEGIN(); unsigned char* ws = P->ws;
            { SchedDense S{DM, DM, T / 256, 6, 8, 192, bx};
              Epi1 E{(bf16_t*)(ws + WS_HB), (float*)(ws + WS_RSS), (bf16_t*)(ws + WS_KB), (const float*)(ws + WS_ROPE), (const float*)(ws + WS_ROPE) + SEQ * 32};
              pg8::gemm_phase<Epi1, SchedDense, false>(nullptr, lds, (const char*)(ws + WS_XB), (const char*)(ws + WS_WIN + l * SZ_WIN), nullptr, DM, DM, DM, S, E); }
            { SchedDense S{HW, WQSTR, T / 256, 1536 / 256, 0, 64, bx - 192};
              Epi2 E{0, (const float*)(ws + WS_RSS), (bf16_t*)(ws + WS_QB), (bf16_t*)(ws + WS_KB), (bf16_t*)(ws + WS_VB), (const float*)(ws + WS_ROPE), (const float*)(ws + WS_ROPE) + SEQ * 32};
              pg8::gemm_phase<Epi2, SchedDense, false>(nullptr, lds, (const char*)(ws + WS_HB) + HC_CQ * 2, (const char*)(ws + WS_WUQ + l * SZ_WUQ), nullptr, 512, HW, WQSTR, S, E); }
            { SchedDense S{HW, WKSTR, T / 256, 2048 / 256, 0, G, bx};
              Epi2 E{1, (const float*)(ws + WS_RSS), (bf16_t*)(ws + WS_QB), (bf16_t*)(ws + WS_KB), (bf16_t*)(ws + WS_VB), (const float*)(ws + WS_ROPE), (const float*)(ws + WS_ROPE) + SEQ * 32};
              pg8::gemm_phase<Epi2, SchedDense, false>(nullptr, lds, (const char*)(ws + WS_HB) + HC_CKV * 2, (const char*)(ws + WS_WUKV + l * SZ_WUKV), nullptr, 256, HW, WKSTR, S, E); }
        }
        SEAM(pb + PHL_G2);
        ST_END(2);
        ST_BEGIN(3);
        if (EN(3) && IN(pb + PHL_MIX)) { PHASE_BEGIN(); mixer_phase(P, lds, l, st_dur); }
        SEAM(pb + PHL_MIX);
        ST_END(3);
        ST_BEGIN(4);
        if (EN(4) && IN(pb + PHL_WO)) {
            PHASE_BEGIN(); unsigned char* ws = P->ws;
            SchedDense S{DM, DM, T / 256, DM / 256, 0, G, bx};
            EpiWO E{(bf16_t*)(ws + WS_Y1)};
            pg8::gemm_phase<EpiWO, SchedDense, false>(nullptr, lds, (const char*)(ws + WS_MIX), (const char*)(ws + WS_WO + l * SZ_WO), nullptr, DM, DM, DM, S, E);
        }
        SEAM(pb + PHL_WO);
        ST_END(4);
        ST_BEGIN(5);
        if (EN(5) && IN(pb + PHL_LNR)) { PHASE_BEGIN(); lnr_phase(P, lds, l, vcu, G, st_dur); }
        SEAM(pb + PHL_LNR);
        ST_END(5);
        ST_BEGIN(6);
        if (EN(6) && IN(pb + PHL_SLOT)) { PHASE_BEGIN(); slot_phase(P, lds, vcu, G); }
        SEAM(pb + PHL_SLOT);
        ST_END(6);
        ST_BEGIN(7);
        if (EN(7) && IN(pb + PHL_GU)) {
            PHASE_BEGIN(); unsigned char* ws = P->ws;
            const int ntiles = use_bar ? ((const LAS int*)(lds + LDS_MISC + 384))[66] : moe_tables(P, lds);
            SchedMoE S{(const LAS int*)(lds + LDS_MISC + 1024), (unsigned)SZ_WGU1, 0, WGSTR, 4, ntiles * 4, G, vcu};
            EpiGU E{(bf16_t*)(ws + WS_HMOE)};
            LAS int* gidx = (LAS int*)(lds + LDS_GIDX);
            { const int* RI = (const int*)(ws + WS_ROWIDX); const int t_ = opq_tid(), hi_ = t_ >> 8, row_ = t_ & 255; int iv_[4];
#pragma unroll
              for (int s_ = 0; s_ < 4; ++s_) { pg8::Unit u_; iv_[s_] = S.next(2 * s_ + hi_, u_) ? RI[u_.r0 + row_] : 0; }
#pragma unroll
              for (int s_ = 0; s_ < 4; ++s_) gidx[(2 * s_ + hi_) * 256 + row_] = iv_[s_];
              __syncthreads(); }
            pg8::gemm_phase<EpiGU, SchedMoE, true>(gstp, lds, (const char*)(ws + WS_X1B), (const char*)(ws + WS_WGU + l * SZ_WGU), gidx, DM, XSTR, WGSTR, S, E);
        }
        SEAM(pb + PHL_GU);
        ST_END(7);
        ST_BEGIN(8);
        if (EN(8) && IN(pb + PHL_DN)) {
            PHASE_BEGIN(); unsigned char* ws = P->ws;
            const int ntiles = use_bar ? ((const LAS int*)(lds + LDS_MISC + 384))[66] : moe_tables(P, lds);
            SchedMoE S{(const LAS int*)(lds + LDS_MISC + 1024), (unsigned)SZ_WD1, HSTR * 2, WDSTR, 8, ntiles * 8, G, vcu};
            EpiDN E{(unsigned char*)(ws + WS_YMOE)};
            pg8::gemm_phase<EpiDN, SchedMoE, false>(nullptr, lds, (const char*)(ws + WS_HMOE), (const char*)(ws + WS_WD + l * SZ_WD), nullptr, EDIM, HSTR, WDSTR, S, E);
        }
        SEAM(pb + PHL_DN);
        ST_END(8);
        ST_BEGIN(9);
        if (EN(9) && IN(pb + PHL_CMB)) { PHASE_BEGIN(); combine_phase(P, lds, l, vcu, G); }
        SEAM(pb + PHL_CMB);
        ST_END(9);
    }
#ifdef MK_STAMP
    if (MK_STAMP == 61) st_dur = gstv[0]; if (MK_STAMP == 62) st_dur = gstv[1];
    if (MK_STAMP >= 34 && MK_STAMP <= 37) st_dur = __hip_atomic_load((unsigned*)(KP->ws + WS_CTL) + CW_ERR + 16, __ATOMIC_RELAXED, __HIP_MEMORY_SCOPE_AGENT) / 256u;
    if (MK_STAMP == 77) st_dur = st_dr ? 2500ull * st_dc / st_dr : 0ull;
    if (bx0 == 0 && threadIdx.x == 0) { const unsigned long long te = __builtin_amdgcn_s_memrealtime(); while (__builtin_amdgcn_s_memrealtime() - te < 4ull * st_dur) __builtin_amdgcn_s_sleep(8); }
#endif
#undef IN
#undef SEAM
}
#ifndef MK_MULTI
#define MK_MULTI 0
#endif
extern "C" void kernel_launch(void* const* d_in, const int* in_sizes, int n_in, void* d_out, int out_size, void* d_ws, size_t ws_size, hipStream_t stream) {
    static int grid = 0;
    if (grid == 0) {
        if (n_in != 29 || out_size != T * DM || ws_size < WS_END) { fprintf(stderr, "kernel_launch: unexpected shapes (n_in %d, out %d, ws %zu < %zu)\n", n_in, out_size, ws_size, (size_t)WS_END); grid = -1; return; }
        int dev = 0, cus = 0, per_cu = 0;
        if (hipGetDevice(&dev) != hipSuccess || hipDeviceGetAttribute(&cus, hipDeviceAttributeMultiprocessorCount, dev) != hipSuccess) { grid = -1; return; }
        if (hipFuncSetAttribute((const void*)fwd, hipFuncAttributeMaxDynamicSharedMemorySize, LDS_BYTES) != hipSuccess) { fprintf(stderr, "kernel_launch: hipFuncSetAttribute failed\n"); grid = -1; return; }
        if (hipOccupancyMaxActiveBlocksPerMultiprocessor(&per_cu, (const void*)fwd, NTHREADS, LDS_BYTES) != hipSuccess || per_cu < 1) { fprintf(stderr, "kernel_launch: occupancy query says %d\n", per_cu); }
        (void)hipGetLastError();
        grid = cus;
    }
    if (grid < 0) return;
    (void)hipMemsetAsync((char*)d_ws + WS_CTL, 0, CTL_ZERO_BYTES, stream);
    Params p{};
    const float** f = (const float**)&p;
    for (int i = 0; i < 29; ++i) f[i] = (const float*)d_in[i];
    p.out = (float*)d_out; p.ws = (unsigned char*)d_ws; p.dbg = 0;
    p.lam_init0 = (float)(0.8 - 0.6 * exp(-0.3 * 0.0)); p.lam_init1 = (float)(0.8 - 0.6 * exp(-0.3 * 1.0));
#if MK_MULTI
    for (int ph = 0; ph < PH_END; ++ph) {
        p.ph_lo = ph; p.ph_hi = ph + 1; p.use_bar = 0;
        hipLaunchKernelGGL(fwd, dim3(grid), dim3(NTHREADS), LDS_BYTES, stream, p);
#if MK_DBG
        dbg_after_phase(p, ph, stream);
#endif
    }
#if MK_DBG
    hipLaunchKernelGGL(dbg_report, dim3(256), dim3(256), 0, stream, p);
#endif
#else
    p.ph_lo = 0; p.ph_hi = PH_END; p.use_bar = 1;
    hipLaunchKernelGGL(fwd, dim3(grid), dim3(NTHREADS), LDS_BYTES, stream, p);
#endif
}
```
